# Optimizing an MI355X kernel written in HIP

```python
import jax
import jax.numpy as jnp
from jax import lax
import numpy as np

D_MODEL = 2048
BATCH = 4
SEQ = 2048
DEPTH = 4

A_HEADS = 8
A_KV_HEADS = 2
A_HEAD_DIM = 128
IDX_HEADS = 16
IDX_DIM = 64
TOPK_MAX = 256
M_HEADS = 8
M_Q_LORA = 512
M_KV_LORA = 256
M_NOPE = 128
M_ROPE = 64
M_V = 128
D_FF = 5632
CONV_W = 3
ROPE_THETA = 500000.0
ROT_FRACTION = 4
EPS = 1e-6
Q_BLOCK = 128
N_ADA = 6
IN_SIZES = (A_HEADS * A_HEAD_DIM, A_KV_HEADS * A_HEAD_DIM, A_KV_HEADS * A_HEAD_DIM,
            IDX_HEADS * IDX_DIM, IDX_DIM, IDX_HEADS,
            M_Q_LORA, M_KV_LORA, M_ROPE,
            D_MODEL, D_MODEL)
IN_DIM = sum(IN_SIZES)
IDX_W_SCALE = (IDX_HEADS * IDX_DIM) ** -0.5

kernel_name = 'hybrid_dsa_mla_convffn_adaln'


def rms_norm(t, g):
    tf = t.astype(jnp.float32)
    y = tf * lax.rsqrt(jnp.mean(tf * tf, axis=-1, keepdims=True) + EPS)
    return (y * g.astype(jnp.float32)).astype(t.dtype)


def rope_tables(pos, rot_dim):
    inv = ROPE_THETA ** (-jnp.arange(0, rot_dim, 2, dtype=jnp.float32) / rot_dim)
    ang = pos[..., None] * inv
    return jnp.cos(ang)[:, :, None, :], jnp.sin(ang)[:, :, None, :]


def apply_rope(t, cos, sin):
    r = cos.shape[-1] * 2
    tf = t[..., :r].astype(jnp.float32)
    t1, t2 = tf[..., : r // 2], tf[..., r // 2:]
    rot = jnp.concatenate([t1 * cos - t2 * sin, t2 * cos + t1 * sin], axis=-1).astype(t.dtype)
    return jnp.concatenate([rot, t[..., r:]], axis=-1)


def split_cols(t, sizes):
    offsets = np.cumsum(sizes)[:-1]
    return jnp.split(t, [int(o) for o in offsets], axis=-1)


def to_blocks(t, nb):
    b = t.shape[0]
    return jnp.moveaxis(t.reshape((b, nb, Q_BLOCK) + t.shape[2:]), 1, 0)


def from_blocks(t):
    nb, b, tq = t.shape[:3]
    return jnp.moveaxis(t, 0, 1).reshape((b, nb * tq) + t.shape[3:])


def dsa_attention(q, k, v, qi, ki, wi):
    B, S, H, dh = q.shape
    G = k.shape[2]
    n_sel = min(TOPK_MAX, S // 4)
    nb = S // Q_BLOCK
    key_pos = jnp.arange(S)
    scale = dh ** -0.5

    def block(args):
        q_b, qi_b, wi_b, start = args
        q_pos = start + jnp.arange(Q_BLOCK)
        causal = key_pos[None, :] <= q_pos[:, None]
        dots = jnp.einsum('bthd,bsd->bths', qi_b, ki, preferred_element_type=jnp.float32)
        score = jnp.einsum('bths,bth->bts', jax.nn.relu(dots), wi_b.astype(jnp.float32))
        score = jnp.where(causal[None], score, -jnp.inf)
        _, sel = lax.top_k(score, n_sel)
        valid = sel <= q_pos[None, :, None]
        k_sel = jax.vmap(lambda kk, ii: kk[ii])(k, sel)
        v_sel = jax.vmap(lambda vv, ii: vv[ii])(v, sel)
        qg = q_b.reshape(B, Q_BLOCK, G, H // G, dh)
        logits = jnp.einsum('btgrd,btkgd->btgrk', qg, k_sel,
                            preferred_element_type=jnp.float32) * scale
        logits = jnp.where(valid[:, :, None, None, :], logits, -jnp.inf)
        p = jax.nn.softmax(logits, axis=-1).astype(v.dtype)
        o = jnp.einsum('btgrk,btkgd->btgrd', p, v_sel)
        return o.reshape(B, Q_BLOCK, H * dh)

    starts = jnp.arange(nb) * Q_BLOCK
    out = lax.map(block, (to_blocks(q, nb), to_blocks(qi, nb), to_blocks(wi, nb), starts))
    return from_blocks(out)


def causal_dense_attention(q, k, v):
    B, S, H, dqk = q.shape
    dv = v.shape[-1]
    nb = S // Q_BLOCK
    key_pos = jnp.arange(S)
    scale = dqk ** -0.5

    def block(args):
        q_b, start = args
        q_pos = start + jnp.arange(Q_BLOCK)
        causal = key_pos[None, :] <= q_pos[:, None]
        logits = jnp.einsum('bthd,bshd->bhts', q_b, k, preferred_element_type=jnp.float32) * scale
        logits = jnp.where(causal[None, None], logits, -jnp.inf)
        p = jax.nn.softmax(logits, axis=-1).astype(v.dtype)
        return jnp.einsum('bhts,bshd->bthd', p, v).reshape(B, Q_BLOCK, H * dv)

    starts = jnp.arange(nb) * Q_BLOCK
    out = lax.map(block, (to_blocks(q, nb), starts))
    return from_blocks(out)


def parallel_mixers(h, w_in, g_qa, g_ka, g_mq_lat, w_mq_up, g_mkv_lat, w_mkv_up,
                    g_qm, g_km, w_pa, w_pb, w_o, rope_a, rope_i, rope_m):
    B, S, _ = h.shape
    proj = h @ w_in
    (qa, ka, va, qi, ki, wi, mq_lat, mkv_lat, mk_rope, gate_a, gate_b) = split_cols(proj, IN_SIZES)

    qa = apply_rope(rms_norm(qa.reshape(B, S, A_HEADS, A_HEAD_DIM), g_qa), *rope_a)
    ka = apply_rope(rms_norm(ka.reshape(B, S, A_KV_HEADS, A_HEAD_DIM), g_ka), *rope_a)
    va = va.reshape(B, S, A_KV_HEADS, A_HEAD_DIM)
    qi = apply_rope(qi.reshape(B, S, IDX_HEADS, IDX_DIM), *rope_i)
    ki = apply_rope(ki[:, :, None, :], *rope_i)[:, :, 0, :]
    o_a = dsa_attention(qa, ka, va, qi, ki, wi * IDX_W_SCALE)

    mq = (rms_norm(mq_lat, g_mq_lat) @ w_mq_up).reshape(B, S, M_HEADS, M_NOPE + M_ROPE)
    mkv = (rms_norm(mkv_lat, g_mkv_lat) @ w_mkv_up).reshape(B, S, M_HEADS, M_NOPE + M_V)
    mk_nope, mv = mkv[..., :M_NOPE], mkv[..., M_NOPE:]
    mk_r = jnp.broadcast_to(mk_rope[:, :, None, :], (B, S, M_HEADS, M_ROPE))
    mk = rms_norm(jnp.concatenate([mk_nope, mk_r], axis=-1), g_km)
    mq = rms_norm(mq, g_qm)
    mq = jnp.concatenate([mq[..., :M_NOPE], apply_rope(mq[..., M_NOPE:], *rope_m)], axis=-1)
    mk = jnp.concatenate([mk[..., :M_NOPE], apply_rope(mk[..., M_NOPE:], *rope_m)], axis=-1)
    o_b = causal_dense_attention(mq, mk, mv)

    merged = jax.nn.sigmoid(gate_a) * (o_a @ w_pa) + jax.nn.sigmoid(gate_b) * (o_b @ w_pb)
    return merged @ w_o


def conv_ffn(h, w_up, w_conv, b_conv, w_down):
    S = h.shape[1]
    u = h @ w_up
    up = jnp.pad(u, ((0, 0), (CONV_W - 1, 0), (0, 0)))
    conv = b_conv
    for j in range(CONV_W):
        conv = conv + w_conv[j] * up[:, j:j + S]
    gate, val = jnp.split(conv, 2, axis=-1)
    return (jax.nn.silu(gate) * val) @ w_down


def setup_inputs(seed: int = 0) -> dict:
    key = jax.random.key(seed)
    ks = jax.random.split(key, 24)
    f32 = jnp.float32

    def nrm(k, shape, scale):
        return jax.random.normal(k, shape, f32) * scale

    def gain(k, shape):
        return 1.0 + 0.02 * jax.random.normal(k, shape, f32)

    L, D = DEPTH, D_MODEL
    x = nrm(ks[0], (BATCH, SEQ, D), 1.0)
    c = nrm(ks[1], (BATCH, D), 1.0)
    offset = jax.random.randint(ks[2], (BATCH, 1), 0, 1024, dtype=jnp.int32)
    positions = (jnp.arange(SEQ, dtype=jnp.int32)[None, :] + offset).astype(jnp.int32)
    return {
        'x': x,
        'c': c,
        'positions': positions,
        'g_attn': gain(ks[3], (L, D)),
        'g_ffn': gain(ks[4], (L, D)),
        'w_ada': nrm(ks[5], (L, D, N_ADA * D), 0.5 * D ** -0.5),
        'b_ada': nrm(ks[6], (L, N_ADA * D), 0.01),
        'w_in': nrm(ks[7], (L, D, IN_DIM), D ** -0.5),
        'g_qa': gain(ks[8], (L, A_HEAD_DIM)),
        'g_ka': gain(ks[9], (L, A_HEAD_DIM)),
        'g_mq_lat': gain(ks[10], (L, M_Q_LORA)),
        'w_mq_up': nrm(ks[11], (L, M_Q_LORA, M_HEADS * (M_NOPE + M_ROPE)), M_Q_LORA ** -0.5),
        'g_mkv_lat': gain(ks[12], (L, M_KV_LORA)),
        'w_mkv_up': nrm(ks[13], (L, M_KV_LORA, M_HEADS * (M_NOPE + M_V)), M_KV_LORA ** -0.5),
        'g_qm': gain(ks[14], (L, M_NOPE + M_ROPE)),
        'g_km': gain(ks[15], (L, M_NOPE + M_ROPE)),
        'w_pa': nrm(ks[16], (L, A_HEADS * A_HEAD_DIM, D), (A_HEADS * A_HEAD_DIM) ** -0.5),
        'w_pb': nrm(ks[17], (L, M_HEADS * M_V, D), (M_HEADS * M_V) ** -0.5),
        'w_o': nrm(ks[18], (L, D, D), D ** -0.5),
        'w_up': nrm(ks[19], (L, D, 2 * D_FF), D ** -0.5),
        'w_conv': nrm(ks[20], (L, CONV_W, 2 * D_FF), CONV_W ** -0.5),
        'b_conv': nrm(ks[21], (L, 2 * D_FF), 0.01),
        'w_down': nrm(ks[22], (L, D_FF, D), D_FF ** -0.5),
    }


def reference(x, c, positions, g_attn, g_ffn, w_ada, b_ada, w_in, g_qa, g_ka,
              g_mq_lat, w_mq_up, g_mkv_lat, w_mkv_up, g_qm, g_km, w_pa, w_pb, w_o,
              w_up, w_conv, b_conv, w_down):
    pos = positions.astype(jnp.float32)
    rope_a = rope_tables(pos, A_HEAD_DIM // ROT_FRACTION)
    rope_i = rope_tables(pos, IDX_DIM // ROT_FRACTION)
    rope_m = rope_tables(pos, M_ROPE)
    c_act = jax.nn.silu(c)
    for l in range(DEPTH):
        mod = (c_act @ w_ada[l] + b_ada[l])[:, None, :]
        sh_a, sc_a, gt_a, sh_f, sc_f, gt_f = jnp.split(mod, N_ADA, axis=-1)
        h = rms_norm(x, g_attn[l]) * (1.0 + sc_a) + sh_a
        y = parallel_mixers(h, w_in[l], g_qa[l], g_ka[l], g_mq_lat[l], w_mq_up[l],
                            g_mkv_lat[l], w_mkv_up[l], g_qm[l], g_km[l], w_pa[l], w_pb[l],
                            w_o[l], rope_a, rope_i, rope_m)
        x = x + gt_a * y
        h = rms_norm(x, g_ffn[l]) * (1.0 + sc_f) + sh_f
        x = x + gt_f * conv_ffn(h, w_up[l], w_conv[l], b_conv[l], w_down[l])
    return x
```

```cpp
#include <hip/hip_runtime.h>
#include <cstdio>
#include <cstdint>
#include <cmath>

#define GAS __attribute__((address_space(1)))
#define LAS __attribute__((address_space(3)))
typedef unsigned short bf16_t;
typedef short bf16x8 __attribute__((ext_vector_type(8)));
typedef short bf16x4 __attribute__((ext_vector_type(4)));
typedef float f32x4 __attribute__((ext_vector_type(4)));
typedef float f32x16 __attribute__((ext_vector_type(16)));
typedef unsigned u32x4 __attribute__((ext_vector_type(4)));
typedef unsigned u32x2 __attribute__((ext_vector_type(2)));

constexpr int DM = 2048, NBATCH = 4, SEQ = 2048, DEPTH = 4, MROWS = NBATCH * SEQ;
constexpr int IN_DIM = 7568, NPROJ = 7680, DFF = 5632, NUP = 2 * DFF, NADA = 6 * DM;
constexpr int PC_QA = 0, PC_KA = 1024, PC_VA = 1280, PC_QI = 1536, PC_KI = 2560, PC_WI = 2624, PC_MKR = 2640, PC_MQL = 2816, PC_MKVL = 3328, PC_GA = 3584, PC_GB = 5632;
constexpr float EPS = 1e-6f;
constexpr float LOG2E = 1.4426950408889634f;
constexpr int NPH_LAYER = 11, NPHASES = 1 + DEPTH * NPH_LAYER;
#ifndef MK_ONE_LAUNCH
#define MK_ONE_LAUNCH 1
#endif

constexpr size_t MiB = 1u << 20;
constexpr size_t WS_CTL = 0, CTL_ZERO_BYTES = 1 * MiB;
constexpr size_t WS_MOD = 1 * MiB;
constexpr size_t WS_ROPE = 2 * MiB;
constexpr size_t WS_WIN = 8 * MiB;
constexpr size_t WS_WMQ = 128 * MiB;
constexpr size_t WS_WMKV = 134 * MiB;
constexpr size_t WS_WPAB = 138 * MiB;
constexpr size_t WS_WO = 170 * MiB;
constexpr size_t WS_WUP = 202 * MiB;
constexpr size_t WS_WDN = 378 * MiB;
constexpr size_t WS_H = 466 * MiB;
constexpr size_t WS_PROJ = 498 * MiB;
constexpr size_t WS_QA = 618 * MiB;
constexpr size_t WS_KA = 634 * MiB;
constexpr size_t WS_VAT = 638 * MiB;
constexpr size_t WS_QI = 642 * MiB;
constexpr size_t WS_KI = 658 * MiB;
constexpr size_t WS_WI = 659 * MiB;
constexpr size_t WS_MQL = 660 * MiB;
constexpr size_t WS_MKVL = 668 * MiB;
constexpr size_t WS_MQ = 672 * MiB;
constexpr size_t WS_MKV = 696 * MiB;
constexpr size_t WS_QM = 728 * MiB;
constexpr size_t WS_KM = 752 * MiB;
constexpr size_t WS_VMT = 776 * MiB;
constexpr size_t WS_MASK = 792 * MiB;
constexpr size_t WS_OAB = 794 * MiB;
constexpr size_t WS_MERGED = 826 * MiB;
constexpr size_t WS_U = 858 * MiB;
constexpr size_t WS_ACT = 1034 * MiB;
constexpr size_t WS_UHEAD = 1122 * MiB;
constexpr size_t WS_UTAIL = 1126 * MiB;
constexpr size_t WS_END = 1130 * MiB;

constexpr int LDS_BYTES = 147456;
constexpr int LDS_MISC = 135168;
constexpr int LDS_XB = 139264;

__device__ __forceinline__ unsigned cvt_pk_bf16(float lo, float hi) { unsigned r; asm("v_cvt_pk_bf16_f32 %0, %1, %2" : "=v"(r) : "v"(lo), "v"(hi)); return r; }
__device__ __forceinline__ float bf_lo(unsigned w) { return __uint_as_float(w << 16); }
__device__ __forceinline__ float bf_hi(unsigned w) { return __uint_as_float(w & 0xffff0000u); }
__device__ __forceinline__ float bf1(bf16_t v) { return __uint_as_float(((unsigned)v) << 16); }
template <int K> __device__ __forceinline__ float swz_xor(float v) { return __int_as_float(__builtin_amdgcn_ds_swizzle(__float_as_int(v), 0x1f | (K << 10))); }
__device__ __forceinline__ float pair32_sum(float v) { auto rr = __builtin_amdgcn_permlane32_swap(__float_as_uint(v), __float_as_uint(v), false, false); return __uint_as_float(rr[0]) + __uint_as_float(rr[1]); }
__device__ __forceinline__ float pair32_max(float v) { auto rr = __builtin_amdgcn_permlane32_swap(__float_as_uint(v), __float_as_uint(v), false, false); return fmaxf(__uint_as_float(rr[0]), __uint_as_float(rr[1])); }
__device__ __forceinline__ float pair32_other(float v, bool upper) { auto rr = __builtin_amdgcn_permlane32_swap(__float_as_uint(v), __float_as_uint(v), false, false); return __uint_as_float(upper ? rr[0] : rr[1]); }
__device__ __forceinline__ float wave_sum(float v) {
    v += swz_xor<1>(v); v += swz_xor<2>(v); v += swz_xor<4>(v); v += swz_xor<8>(v); v += swz_xor<16>(v);
    return pair32_sum(v);
}
__device__ __forceinline__ float fast_rsq(float x) { return __builtin_amdgcn_rsqf(x); }
__device__ __forceinline__ float fast_rcp(float x) { return __builtin_amdgcn_rcpf(x); }
__device__ __forceinline__ float fast_exp2(float x) { return __builtin_amdgcn_exp2f(x); }
__device__ __forceinline__ float sigmoidf_(float x) { return fast_rcp(1.0f + fast_exp2(-x * LOG2E)); }

#define XB_TMO      128
#define XB_XCNT(j)  (256  + 64 * (j))
#define XB_XSUB(j)  (1280 + 64 * (j))
#define XB_XGEN(j)  (2304 + 64 * (j))
#define XB_TOP      3328
#define XB_TOPGEN   3392
#define XCD_BAR_WORDS 3456
#define XB_SPIN_CAP (1u << 20)

__device__ __forceinline__ unsigned xb_ld(unsigned* p)              { return __hip_atomic_load(p, __ATOMIC_RELAXED, __HIP_MEMORY_SCOPE_AGENT); }
__device__ __forceinline__ unsigned xb_add(unsigned* p, unsigned v) { return __hip_atomic_fetch_add(p, v, __ATOMIC_RELAXED, __HIP_MEMORY_SCOPE_AGENT); }
__device__ __forceinline__ unsigned xb_xcc_id() { return (unsigned)__builtin_amdgcn_s_getreg((3 << 11) | 20) & 0xFu; }
#define XB_SPIN(cond, bar) do { unsigned _sp = 0; while (cond) { __builtin_amdgcn_s_sleep(1); \
    if ((++_sp & 255u) == 0u) { if (xb_ld(&(bar)[XB_TMO])) break; if (_sp > XB_SPIN_CAP) { atomicAdd(&(bar)[XB_TMO], 1u); break; } } } } while (0)

struct XcdBarrier { unsigned* bar; unsigned x; volatile LAS unsigned* st; };

__device__ __forceinline__ XcdBarrier xcd_barrier_post(unsigned* bar, volatile LAS unsigned* st) {
    XcdBarrier b; b.bar = bar; b.x = xb_xcc_id(); b.st = st;
    if (threadIdx.x == 0) (void)xb_add(&bar[XB_XCNT(b.x)], 1u);
    return b;
}
__device__ __forceinline__ void xcd_barrier_complete(unsigned* bar, unsigned x, unsigned& nloc, unsigned& nx) {
    const unsigned G = gridDim.x * gridDim.y * gridDim.z;
    unsigned sum, cnt, mine, sp = 0u;
    for (;;) {
        sum = 0u; cnt = 0u; mine = 0u;
#pragma unroll
        for (unsigned j = 0; j < 16; ++j) { const unsigned c = xb_ld(&bar[XB_XCNT(j)]); sum += c; cnt += (c > 0u) ? 1u : 0u; mine = (j == x) ? c : mine; }
        if (sum == G) break;
        __builtin_amdgcn_s_sleep(1);
        if ((++sp & 255u) == 0u) { if (xb_ld(&bar[XB_TMO])) break; if (sp > XB_SPIN_CAP) { atomicAdd(&bar[XB_TMO], 1u); break; } }
    }
    nloc = mine > 0u ? mine : 1u; nx = cnt > 0u ? cnt : 1u;
}
__device__ __forceinline__ void xcd_barrier(const XcdBarrier& b) {
    asm volatile("s_waitcnt vmcnt(0)" ::: "memory");
    __syncthreads();
    if (threadIdx.x == 0) {
        unsigned* bar = b.bar;
        __builtin_amdgcn_s_waitcnt(0);
        unsigned nloc = b.st[0], nx = b.st[1];
        if (nloc == 0u) { xcd_barrier_complete(bar, b.x, nloc, nx); b.st[0] = nloc; b.st[1] = nx; }
        const unsigned old = xb_add(&bar[XB_XSUB(b.x)], 1u);
        const unsigned gen = old / nloc;
        if (old + 1u == (gen + 1u) * nloc) {
            __builtin_amdgcn_fence(__ATOMIC_RELEASE, "agent");
            asm volatile("s_waitcnt vmcnt(0)" ::: "memory");
            const unsigned og = xb_add(&bar[XB_TOP], 1u);
            const unsigned tg = og / nx;
            if (og + 1u == (tg + 1u) * nx) xb_add(&bar[XB_TOPGEN], 1u);
            else XB_SPIN(xb_ld(&bar[XB_TOPGEN]) == tg, bar);
            __builtin_amdgcn_fence(__ATOMIC_ACQUIRE, "agent");
            xb_add(&bar[XB_XGEN(b.x)], 1u);
            asm volatile("s_waitcnt vmcnt(0)" ::: "memory");
        } else {
            XB_SPIN(xb_ld(&bar[XB_XGEN(b.x)]) == gen, bar);
            __builtin_amdgcn_fence(__ATOMIC_ACQUIRE, "agent");
            asm volatile("s_waitcnt vmcnt(0)" ::: "memory");
        }
    }
    __syncthreads();
}

namespace pg8 {
constexpr int BM = 256, BK = 64, HALF = 128, HTB = HALF * BK * 2, STAGE_BYTES = 8 * HTB, NXCD = 8, WGM = 8;
__host__ __device__ __forceinline__ int lds_byte(int r, int c) { const int st = (r >> 4) * 2 + (c >> 5), rr = r & 15, cc = c & 31, ob = rr * 64 + cc * 2; return st * 1024 + (ob ^ (((ob >> 9) & 1) << 5)); }
__host__ __device__ __forceinline__ void stage_rc(int b, int& R, int& C) { const int st = b / 1024, sb = b % 1024, swz = sb ^ (((sb >> 9) & 1) << 5); R = (st >> 1) * 16 + swz / 64; C = (st & 1) * 32 + (swz % 64) / 2; }
__host__ __device__ __forceinline__ int perm32(int rho) { const int n = rho >> 4, i = rho & 15; return 8 * (i >> 2) + 4 * n + (i & 3); }

struct Unit { int pm, pn, z; };
struct Gemm { const bf16_t* A; const bf16_t* Bt; int lda, ldb, K; size_t azs, bzs; };

struct StaticOrder {
    int nM, nN, nwg, G, c;
    __host__ __device__ void init(int M, int N, int G_, int c_) { nM = M / BM; nN = N / BM; nwg = nM * nN; G = G_; c = c_; }
    __host__ __device__ bool next(int i, Unit& u) const {
        const long L = (long)i * G + c; if (L >= nwg) return false;
        int wgid = (int)L; { const int q = nwg / NXCD, r = nwg % NXCD, xcd = wgid % NXCD, off = wgid / NXCD; wgid = (xcd < r ? xcd * (q + 1) : r * (q + 1) + (xcd - r) * q) + off; }
        const int nig = WGM * nN, gid = wgid / nig, fm = gid * WGM, gsz = (nM - fm) < WGM ? (nM - fm) : WGM;
        u.pm = fm + ((wgid % nig) % gsz); u.pn = (wgid % nig) / gsz; u.z = 0; return true;
    }
};
struct PairOrder {
    StaticOrder s;
    __host__ __device__ bool next(int i, Unit& u) const { if (!s.next(i >> 1, u)) return false; u.z = i & 1; return true; }
};

template <class Epi, class Sched, bool ALIGN_EPI = true, bool SP2 = true>
__device__ __forceinline__ void gemm_phase(LAS unsigned char* lds, const int tid, const Gemm g, const Sched& S, const Epi& E) {
    const int wid = __builtin_amdgcn_readfirstlane(tid >> 6), lane = tid & 63, wr = wid >> 2, wc = wid & 3, fr = lane & 15, fq = lane >> 4;
    const int K = g.K, nt = K / BK;
    unsigned voffA[2], voffB[2];
#pragma unroll
    for (int i = 0; i < 2; ++i) { int R, C; stage_rc(tid * 16 + i * 8192, R, C); const int Rb = Epi::PERM ? ((R & ~31) + perm32(R & 31)) : R;
        voffA[i] = (unsigned)(R * g.lda + C) * 2u; voffB[i] = (unsigned)(Rb * g.ldb + C) * 2u; }
    const size_t kstep = (size_t)(BK * 2);
    const size_t hstepA = (size_t)HALF * g.lda * 2, hstepB = (size_t)HALF * g.ldb * 2;
    const size_t tstepA = 2 * hstepA, tstepB = 2 * hstepB;
    const unsigned ldsw = (unsigned)wid * 1024u;
    const int aoff = lds_byte(wr * 64 + fr, fq * 8), boff = lds_byte(wc * 32 + fr, fq * 8);
#define PG8_SA(b, h) (((b) * 2 + (h)) * HTB)
#define PG8_SB(b, h) ((4 + (b) * 2 + (h)) * HTB)
#define PG8_STAGE(bufoff, gbase, voff) do { _Pragma("unroll") for (int _i = 0; _i < 2; ++_i) \
        __builtin_amdgcn_global_load_lds((const unsigned*)((const char*)(gbase) + (voff)[_i]), (LAS unsigned*)(lds + (bufoff) + ldsw + _i * 8192), 16, 0, 0); } while (0)
#define PG8_LDA(dst, b, h) do { _Pragma("unroll") for (int m = 0; m < 4; ++m) _Pragma("unroll") for (int k = 0; k < 2; ++k) dst[m][k] = *(const LAS bf16x8*)(lds + PG8_SA(b, h) + aoff + m * 2048 + k * 1024); } while (0)
#define PG8_LDB(dst, b, h) do { _Pragma("unroll") for (int n = 0; n < 2; ++n) _Pragma("unroll") for (int k = 0; k < 2; ++k) dst[n][k] = *(const LAS bf16x8*)(lds + PG8_SB(b, h) + boff + n * 2048 + k * 1024); } while (0)
#define PG8_MMA(ai, bj, At, Bt) do { __builtin_amdgcn_s_setprio(1); _Pragma("unroll") for (int m = 0; m < 4; ++m) _Pragma("unroll") for (int n = 0; n < 2; ++n) _Pragma("unroll") for (int k = 0; k < 2; ++k) \
        acc[ai][bj][m][n] = __builtin_amdgcn_mfma_f32_16x16x32_bf16(Bt[n][k], At[m][k], acc[ai][bj][m][n], 0, 0, 0); __builtin_amdgcn_s_setprio(0); } while (0)
#define PG8_WAIT_V(n) asm volatile("s_waitcnt vmcnt(" #n ")" ::: "memory")
#define PG8_WAIT_L(n) asm volatile("s_waitcnt lgkmcnt(" #n ")" ::: "memory")
#define PG8_BAR __builtin_amdgcn_s_barrier()
#define PG8_SCHED __builtin_amdgcn_sched_barrier(0)
    Unit cur, nxt; int ui = 0;
    if (!S.next(0, cur)) return;
    f32x4 acc[2][2][4][2];
#pragma unroll
    for (int a = 0; a < 2; ++a)
#pragma unroll
        for (int b = 0; b < 2; ++b)
#pragma unroll
            for (int m = 0; m < 4; ++m)
#pragma unroll
                for (int n = 0; n < 2; ++n) acc[a][b][m][n] = (f32x4){0.f, 0.f, 0.f, 0.f};
    bf16x8 At[4][2], B0[2][2], B1[2][2];
    const char* cA = (const char*)g.A + (size_t)cur.z * g.azs + (size_t)cur.pm * tstepA; const char* cB = (const char*)g.Bt + (size_t)cur.z * g.bzs + (size_t)cur.pn * tstepB;
    if constexpr (SP2) {
        PG8_STAGE(PG8_SB(0, 0), cB, voffB); PG8_STAGE(PG8_SB(0, 1), cB + hstepB, voffB); PG8_STAGE(PG8_SA(0, 0), cA, voffA); PG8_STAGE(PG8_SA(0, 1), cA + hstepA, voffA);
        if (wr == 1) PG8_BAR;
        PG8_WAIT_V(2); PG8_BAR;
        PG8_STAGE(PG8_SB(1, 0), cB + kstep, voffB); PG8_STAGE(PG8_SA(1, 0), cA + kstep, voffA); PG8_STAGE(PG8_SB(1, 1), cB + hstepB + kstep, voffB);
        PG8_WAIT_V(6); PG8_BAR;
    } else {
        PG8_STAGE(PG8_SB(0, 0), cB, voffB); PG8_STAGE(PG8_SA(0, 0), cA, voffA); PG8_STAGE(PG8_SB(0, 1), cB + hstepB, voffB); PG8_STAGE(PG8_SA(0, 1), cA + hstepA, voffA);
        if (wr == 1) PG8_BAR;
        PG8_WAIT_V(4); PG8_BAR;
        PG8_STAGE(PG8_SB(1, 0), cB + kstep, voffB); PG8_STAGE(PG8_SA(1, 0), cA + kstep, voffA); PG8_STAGE(PG8_SB(1, 1), cB + hstepB + kstep, voffB);
        PG8_WAIT_V(6); PG8_BAR;
    }
    for (;;) {
        const bool has_next = S.next(ui + 1, nxt);
        const char* nA = has_next ? (const char*)g.A + (size_t)nxt.z * g.azs + (size_t)nxt.pm * tstepA : cA; const char* nB = has_next ? (const char*)g.Bt + (size_t)nxt.z * g.bzs + (size_t)nxt.pn * tstepB : cB;
        for (int t = 0; t < nt; t += 2) {
            const bool last = (t == nt - 2);
            const char* a1 = cA + (size_t)(t + 1) * kstep;
            const char* a2 = last ? nA : cA + (size_t)(t + 2) * kstep; const char* b2 = last ? nB : cB + (size_t)(t + 2) * kstep;
            const char* a3 = a2 + kstep; const char* b3 = b2 + kstep;
            if constexpr (SP2) {
            PG8_LDB(B0, 0, 0); PG8_LDB(B1, 0, 1); PG8_SCHED; PG8_LDA(At, 0, 0); PG8_STAGE(PG8_SA(1, 1), a1 + hstepA, voffA);
            PG8_WAIT_V(8); PG8_WAIT_L(0); PG8_BAR; PG8_MMA(0, 0, At, B0); PG8_MMA(0, 1, At, B1); PG8_BAR; PG8_SCHED;
            PG8_LDA(At, 0, 1); PG8_STAGE(PG8_SB(0, 0), b2, voffB); PG8_STAGE(PG8_SB(0, 1), b2 + hstepB, voffB); PG8_STAGE(PG8_SA(0, 0), a2, voffA);
            PG8_WAIT_V(8); PG8_WAIT_L(0); PG8_BAR; PG8_MMA(1, 0, At, B0); PG8_MMA(1, 1, At, B1); PG8_BAR; PG8_SCHED;
            PG8_LDB(B0, 1, 0); PG8_LDB(B1, 1, 1); PG8_SCHED; PG8_LDA(At, 1, 0); PG8_STAGE(PG8_SA(0, 1), a2 + hstepA, voffA);
            PG8_WAIT_V(8); PG8_WAIT_L(0); PG8_BAR; PG8_MMA(0, 0, At, B0); PG8_MMA(0, 1, At, B1); PG8_BAR; PG8_SCHED;
            PG8_LDA(At, 1, 1); PG8_STAGE(PG8_SB(1, 0), b3, voffB); PG8_STAGE(PG8_SB(1, 1), b3 + hstepB, voffB); PG8_STAGE(PG8_SA(1, 0), a3, voffA);
            PG8_WAIT_V(8); PG8_WAIT_L(0); PG8_BAR; PG8_MMA(1, 0, At, B0); PG8_MMA(1, 1, At, B1); PG8_BAR; PG8_SCHED;
            } else {
            PG8_LDB(B0, 0, 0); PG8_SCHED; PG8_LDA(At, 0, 0); PG8_STAGE(PG8_SA(1, 1), a1 + hstepA, voffA);
            PG8_WAIT_L(8); PG8_BAR; PG8_WAIT_L(0); PG8_MMA(0, 0, At, B0); PG8_BAR; PG8_SCHED;
            PG8_LDB(B1, 0, 1); PG8_STAGE(PG8_SB(0, 0), b2, voffB);
            PG8_BAR; PG8_WAIT_L(0); PG8_MMA(0, 1, At, B1); PG8_BAR;
            PG8_LDA(At, 0, 1); PG8_STAGE(PG8_SA(0, 0), a2, voffA);
            PG8_BAR; PG8_WAIT_L(0); PG8_MMA(1, 0, At, B0); PG8_BAR; PG8_SCHED;
            PG8_STAGE(PG8_SB(0, 1), b2 + hstepB, voffB);
            PG8_WAIT_V(6); PG8_BAR; PG8_MMA(1, 1, At, B1); PG8_BAR;
            PG8_LDB(B0, 1, 0); PG8_SCHED; PG8_LDA(At, 1, 0); PG8_STAGE(PG8_SA(0, 1), a2 + hstepA, voffA);
            PG8_WAIT_L(8); PG8_BAR; PG8_WAIT_L(0); PG8_MMA(0, 0, At, B0); PG8_BAR; PG8_SCHED;
            PG8_LDB(B1, 1, 1); PG8_STAGE(PG8_SB(1, 0), b3, voffB);
            PG8_BAR; PG8_WAIT_L(0); PG8_MMA(0, 1, At, B1); PG8_BAR;
            PG8_LDA(At, 1, 1); PG8_STAGE(PG8_SA(1, 0), a3, voffA);
            PG8_BAR; PG8_WAIT_L(0); PG8_MMA(1, 0, At, B0); PG8_BAR; PG8_SCHED;
            PG8_STAGE(PG8_SB(1, 1), b3 + hstepB, voffB);
            PG8_WAIT_V(6); PG8_BAR; PG8_MMA(1, 1, At, B1); PG8_BAR;
            }
        }
        if constexpr (ALIGN_EPI) { if (wr == 0) PG8_BAR; }
        E(acc, cur, wr, wc, fr, fq);
        if (!has_next) break;
#pragma unroll
        for (int a = 0; a < 2; ++a)
#pragma unroll
            for (int b = 0; b < 2; ++b)
#pragma unroll
                for (int m = 0; m < 4; ++m)
#pragma unroll
                    for (int n = 0; n < 2; ++n) acc[a][b][m][n] = (f32x4){0.f, 0.f, 0.f, 0.f};
        cur = nxt; cA = nA; cB = nB; ++ui;
        if constexpr (ALIGN_EPI) { if (wr == 1) PG8_BAR; }
    }
    PG8_WAIT_V(0);
    if constexpr (!ALIGN_EPI) { if (wr == 0) PG8_BAR; }
    PG8_BAR;
#undef PG8_SA
#undef PG8_SB
#undef PG8_STAGE
#undef PG8_LDA
#undef PG8_LDB
#undef PG8_MMA
#undef PG8_WAIT_V
#undef PG8_WAIT_L
#undef PG8_BAR
#undef PG8_SCHED
}

struct EpiStoreBf16 {
    static constexpr bool PERM = true;
    bf16_t* O; int ldc;
    __device__ __forceinline__ void operator()(const f32x4 (&acc)[2][2][4][2], const Unit& u, int wr, int wc, int fr, int fq) const {
        const int row0 = u.pm * BM + wr * 64 + fr, col0 = u.pn * BM + wc * 32 + 8 * fq;
#pragma unroll
        for (int ai = 0; ai < 2; ++ai)
#pragma unroll
            for (int m = 0; m < 4; ++m) { bf16_t* rowp = O + (size_t)(row0 + ai * HALF + m * 16) * ldc + col0;
#pragma unroll
                for (int bj = 0; bj < 2; ++bj) { const f32x4 v0 = acc[ai][bj][m][0], v1 = acc[ai][bj][m][1];
                    u32x4 w; w.x = cvt_pk_bf16(v0[0], v0[1]); w.y = cvt_pk_bf16(v0[2], v0[3]); w.z = cvt_pk_bf16(v1[0], v1[1]); w.w = cvt_pk_bf16(v1[2], v1[3]);
                    *(u32x4*)(rowp + bj * HALF) = w; } }
    }
};
struct EpiPab {
    static constexpr bool PERM = true;
    const bf16_t* proj; bf16_t* merged;
    __device__ __forceinline__ void operator()(const f32x4 (&acc)[2][2][4][2], const Unit& u, int wr, int wc, int fr, int fq) const {
        const int row0 = u.pm * BM + wr * 64 + fr, col0 = u.pn * BM + wc * 32 + 8 * fq;
        const int gcol = (u.z ? PC_GB : PC_GA) + col0;
#pragma unroll
        for (int ai = 0; ai < 2; ++ai)
#pragma unroll
            for (int m = 0; m < 4; ++m) { const size_t r = (size_t)(row0 + ai * HALF + m * 16);
#pragma unroll
                for (int bj = 0; bj < 2; ++bj) {
                    const u32x4 gw = *(const u32x4*)(proj + r * NPROJ + gcol + bj * HALF);
                    const f32x4 v0 = acc[ai][bj][m][0], v1 = acc[ai][bj][m][1];
                    float o[8];
                    o[0] = sigmoidf_(bf_lo(gw.x)) * v0[0]; o[1] = sigmoidf_(bf_hi(gw.x)) * v0[1]; o[2] = sigmoidf_(bf_lo(gw.y)) * v0[2]; o[3] = sigmoidf_(bf_hi(gw.y)) * v0[3];
                    o[4] = sigmoidf_(bf_lo(gw.z)) * v1[0]; o[5] = sigmoidf_(bf_hi(gw.z)) * v1[1]; o[6] = sigmoidf_(bf_lo(gw.w)) * v1[2]; o[7] = sigmoidf_(bf_hi(gw.w)) * v1[3];
                    bf16_t* dst = merged + r * DM + col0 + bj * HALF;
                    if (u.z) { const u32x4 pw = *(const u32x4*)dst;
                        o[0] += bf_lo(pw.x); o[1] += bf_hi(pw.x); o[2] += bf_lo(pw.y); o[3] += bf_hi(pw.y); o[4] += bf_lo(pw.z); o[5] += bf_hi(pw.z); o[6] += bf_lo(pw.w); o[7] += bf_hi(pw.w); }
                    u32x4 w; w.x = cvt_pk_bf16(o[0], o[1]); w.y = cvt_pk_bf16(o[2], o[3]); w.z = cvt_pk_bf16(o[4], o[5]); w.w = cvt_pk_bf16(o[6], o[7]);
                    *(u32x4*)dst = w; } }
    }
};
struct EpiResid {
    static constexpr bool PERM = false;
    const float* xsrc; float* out; const float* gate;
    __device__ __forceinline__ void operator()(const f32x4 (&acc)[2][2][4][2], const Unit& u, int wr, int wc, int fr, int fq) const {
        const int row0 = u.pm * BM + wr * 64 + fr, col0 = u.pn * BM + wc * 32 + 4 * fq;
        const float* gp = gate + (size_t)(u.pm >> 3) * NADA + col0;
        f32x4 gv[2][2];
#pragma unroll
        for (int bj = 0; bj < 2; ++bj)
#pragma unroll
            for (int n = 0; n < 2; ++n) gv[bj][n] = *(const f32x4*)(gp + bj * HALF + n * 16);
#pragma unroll
        for (int ai = 0; ai < 2; ++ai)
#pragma unroll
            for (int m = 0; m < 4; ++m) { const size_t off = (size_t)(row0 + ai * HALF + m * 16) * DM + col0;
#pragma unroll
                for (int bj = 0; bj < 2; ++bj)
#pragma unroll
                    for (int n = 0; n < 2; ++n) { const f32x4 xv = *(const f32x4*)(xsrc + off + bj * HALF + n * 16);
                        *(f32x4*)(out + off + bj * HALF + n * 16) = xv + gv[bj][n] * acc[ai][bj][m][n]; }
                if (m & 1) asm volatile("" ::: "memory"); }
    }
};

template <int CTRL> __device__ __forceinline__ float dpp_f(float v) { return __int_as_float(__builtin_amdgcn_update_dpp(0, __float_as_int(v), CTRL, 0xf, 0xf, false)); }
struct EpiUpConv {
    static constexpr bool PERM = true;
    const float* wconv; const float* bconv; bf16_t* act; float* uhead; float* utail; LAS float* xb;
    __device__ __forceinline__ static int xidx(int ai, int rr, int wr, int wc, int bj, int n, int fq) { return ((((((ai * 2 + rr) * 2 + wr) * 4 + wc) * 2 + bj) * 2 + n) * 4 + fq) * 4; }
    __device__ __forceinline__ void operator()(const f32x4 (&acc)[2][2][4][2], const Unit& u, int wr, int wc, int fr, int fq) const {
        const int colp = u.pn * BM + wc * 32 + 8 * fq;
        const int ch0 = u.pn * HALF + wc * 32 + 8 * fq;
        if (fr >= 14) {
#pragma unroll
            for (int ai = 0; ai < 2; ++ai)
#pragma unroll
                for (int bj = 0; bj < 2; ++bj)
#pragma unroll
                    for (int n = 0; n < 2; ++n) *(LAS f32x4*)(xb + xidx(ai, fr - 14, wr, wc, bj, n, fq)) = acc[ai][bj][3][n];
            if (wr == 1) {
#pragma unroll
                for (int bj = 0; bj < 2; ++bj)
#pragma unroll
                    for (int n = 0; n < 2; ++n) *(f32x4*)(utail + (size_t)(u.pm * 2 + (fr - 14)) * NUP + colp + bj * HALF + 4 * n) = acc[1][bj][3][n];
            }
        }
        if (fr < 2 && wr == 0) {
#pragma unroll
            for (int bj = 0; bj < 2; ++bj)
#pragma unroll
                for (int n = 0; n < 2; ++n) *(f32x4*)(uhead + (size_t)(u.pm * 2 + fr) * NUP + colp + bj * HALF + 4 * n) = acc[0][bj][0][n];
        }
        asm volatile("s_waitcnt lgkmcnt(0)" ::: "memory"); __builtin_amdgcn_s_barrier(); asm volatile("" ::: "memory");
        const bool skip01 = (wr == 0) && (fr < 2) && ((u.pm & 7) != 0);
#pragma unroll
        for (int n = 0; n < 2; ++n) {
            f32x4 wg[3], wv[3];
#pragma unroll
            for (int k = 0; k < 3; ++k) { wg[k] = *(const f32x4*)(wconv + (size_t)k * NUP + ch0 + 4 * n); wv[k] = *(const f32x4*)(wconv + (size_t)k * NUP + DFF + ch0 + 4 * n); }
            const f32x4 bg = *(const f32x4*)(bconv + ch0 + 4 * n), bv = *(const f32x4*)(bconv + DFF + ch0 + 4 * n);
#pragma unroll
            for (int ai = 0; ai < 2; ++ai) {
                f32x4 p1[2], p2[2], c1[2], c2[2];
#pragma unroll
                for (int bj = 0; bj < 2; ++bj) { p1[bj] = (f32x4){0.f, 0.f, 0.f, 0.f}; p2[bj] = p1[bj]; c1[bj] = p1[bj]; c2[bj] = p1[bj]; }
                if (wr == 1 || ai == 1) {
                    const int sai = (wr == 1) ? ai : 0, swr = (wr == 1) ? 0 : 1;
#pragma unroll
                    for (int bj = 0; bj < 2; ++bj) { p2[bj] = *(const LAS f32x4*)(xb + xidx(sai, 0, swr, wc, bj, n, fq)); p1[bj] = *(const LAS f32x4*)(xb + xidx(sai, 1, swr, wc, bj, n, fq)); }
                }
#pragma unroll
                for (int m = 0; m < 4; ++m) {
                    f32x4 cv[2];
#pragma unroll
                    for (int bj = 0; bj < 2; ++bj) {
                        const f32x4 v = acc[ai][bj][m][n]; f32x4 r1, r2, q1, q2;
#pragma unroll
                        for (int e = 0; e < 4; ++e) { r1[e] = dpp_f<0x121>(v[e]); r2[e] = dpp_f<0x122>(v[e]); }
                        if (m == 0) {
#pragma unroll
                            for (int e = 0; e < 4; ++e) { q1[e] = (fr >= 1) ? r1[e] : p1[bj][e]; q2[e] = (fr >= 2) ? r2[e] : ((fr == 1) ? p1[bj][e] : p2[bj][e]); }
                        } else {
#pragma unroll
                            for (int e = 0; e < 4; ++e) { q1[e] = (fr >= 1) ? r1[e] : c1[bj][e]; q2[e] = (fr >= 2) ? r2[e] : c2[bj][e]; }
                        }
                        c1[bj] = r1; c2[bj] = r2;
                        const f32x4 w0 = bj ? wv[0] : wg[0], w1 = bj ? wv[1] : wg[1], w2 = bj ? wv[2] : wg[2], bb = bj ? bv : bg;
                        cv[bj] = bb + w0 * q2 + w1 * q1 + w2 * v;
                    }
                    float o[4];
#pragma unroll
                    for (int e = 0; e < 4; ++e) { const float g = cv[0][e]; o[e] = g * sigmoidf_(g) * cv[1][e]; }
                    u32x2 ow; ow.x = cvt_pk_bf16(o[0], o[1]); ow.y = cvt_pk_bf16(o[2], o[3]);
                    const int row = u.pm * BM + ai * HALF + wr * 64 + m * 16 + fr;
                    if (!(skip01 && ai == 0 && m == 0)) *(u32x2*)(act + (size_t)row * DFF + ch0 + 4 * n) = ow;
                }
            }
        }
    }
};
}

struct Args { const void* in[23]; float* out; unsigned char* ws; float inv_a[16]; float inv_i[8]; float inv_m[32]; int ph_lo, ph_hi; };
static_assert(sizeof(Args) == 23 * 8 + 16 + 56 * 4 + 8, "Args has no padding");

typedef const __attribute__((address_space(4))) struct Args* ArgsCP;
struct Frame {
    LAS unsigned char* lds; int tid, lane, wave, G, bid;
    unsigned char* ws; ArgsCP a;
};

__device__ __forceinline__ void sincos_d(double a, float& s, float& c) {
    const double q = __builtin_rint(a * 0.63661977236758134308);
    double r = __builtin_fma(-q, 1.57079632673412561417e+00, a);
    r = __builtin_fma(-q, 6.07710050650619224932e-11, r);
    const double r2 = r * r;
    double sp = -7.6471637318198164759e-13; sp = sp * r2 + 1.6059043836821614599e-10; sp = sp * r2 - 2.5052108385441718775e-08; sp = sp * r2 + 2.7557319223985890653e-06;
    sp = sp * r2 - 1.9841269841269841270e-04; sp = sp * r2 + 8.3333333333333333333e-03; sp = sp * r2 - 1.6666666666666666667e-01; const double sr = r + r * r2 * sp;
    double cp = 4.7794773323873852974e-14; cp = cp * r2 - 1.1470745597729724714e-11; cp = cp * r2 + 2.0876756987868098979e-09; cp = cp * r2 - 2.7557319223985890653e-07;
    cp = cp * r2 + 2.4801587301587301587e-05; cp = cp * r2 - 1.3888888888888888889e-03; cp = cp * r2 + 4.1666666666666666667e-02; cp = cp * r2 - 0.5; const double cr = 1.0 + r2 * cp;
    const int qi = ((int)q) & 3;
    const double sv = (qi == 0) ? sr : (qi == 1) ? cr : (qi == 2) ? -sr : -cr;
    const double cv = (qi == 0) ? cr : (qi == 1) ? -sr : (qi == 2) ? -cr : sr;
    s = (float)sv; c = (float)cv;
}

__device__ __forceinline__ int cmap_in(int n) {
    if (n < 2640) return n;
    if (n < 2704) return 3408 + (n - 2640);
    if (n < 2816) return -1;
    if (n < 3328) return 2640 + (n - 2816);
    if (n < 3584) return 3152 + (n - 3328);
    return 3472 + (n - 3584);
}
__device__ __forceinline__ int cmap_up(int n) { const int j = n >> 8, w = n & 255; return (w < 128) ? (128 * j + w) : (DFF + 128 * j + (w - 128)); }

template <int MODE>
__device__ __forceinline__ void transpose_tile(const Frame& F, const float* src, int ldsrc, int K, bf16_t* dst, int k0, int n0) {
    LAS float* T = (LAS float*)F.lds;
    f32x4 v[8];
#pragma unroll
    for (int i = 0; i < 8; ++i) { const int idx = F.tid + 512 * i, kk = idx >> 5, n4 = idx & 31; const int n = n0 + 4 * n4;
        const int c = (MODE == 0) ? n : (MODE == 1) ? cmap_in(n) : cmap_up(n);
        v[i] = (c >= 0) ? *(const f32x4*)(src + (size_t)(k0 + kk) * ldsrc + c) : (f32x4){0.f, 0.f, 0.f, 0.f}; }
    __syncthreads();
#pragma unroll
    for (int i = 0; i < 8; ++i) { const int idx = F.tid + 512 * i, kk = idx >> 5, n4 = idx & 31; *(LAS f32x4*)(T + kk * 132 + 4 * n4) = v[i]; }
    __syncthreads();
    const int n = F.tid & 127, kq = F.tid >> 7;
    bf16_t* dp = dst + (size_t)(n0 + n) * K + k0 + kq * 32;
#pragma unroll
    for (int j = 0; j < 4; ++j) { float e[8];
#pragma unroll
        for (int i = 0; i < 8; ++i) e[i] = T[(kq * 32 + j * 8 + i) * 132 + n];
        u32x4 w; w.x = cvt_pk_bf16(e[0], e[1]); w.y = cvt_pk_bf16(e[2], e[3]); w.z = cvt_pk_bf16(e[4], e[5]); w.w = cvt_pk_bf16(e[6], e[7]);
        *(u32x4*)(dp + j * 8) = w; }
}

__device__ __forceinline__ void p0_prologue(const Frame& F) {
    ArgsCP ap = F.a;
    unsigned char* ws = F.ws;
    {
        LAS float* CAct = (LAS float*)F.lds;
        LAS float* RED = (LAS float*)(F.lds + 32768);
        const float* c = (const float*)ap->in[1];
        for (int i = F.tid; i < NBATCH * DM; i += 512) { const float x = c[i]; CAct[i] = x * sigmoidf_(x); }
        __syncthreads();
        const float* w_ada = (const float*)ap->in[5]; const float* b_ada = (const float*)ap->in[6];
        float* mod = (float*)(ws + WS_MOD);
        const int rg = F.lane >> 4, cq = F.lane & 15;
        for (int it = F.bid; it < DEPTH * (NADA / 64); it += F.G) {
            const int l = it / (NADA / 64), n0 = (it % (NADA / 64)) * 64;
            const float* wp = w_ada + (size_t)l * DM * NADA + n0 + 4 * cq;
            const int kb = F.wave * 256 + rg * 64;
            f32x4 acc[4];
#pragma unroll
            for (int b = 0; b < 4; ++b) acc[b] = (f32x4){0.f, 0.f, 0.f, 0.f};
            for (int i0 = 0; i0 < 64; i0 += 16) {
                f32x4 wv[16];
#pragma unroll
                for (int i = 0; i < 16; ++i) wv[i] = *(const f32x4*)(wp + (size_t)(kb + i0 + i) * NADA);
#pragma unroll
                for (int i = 0; i < 16; ++i) {
#pragma unroll
                    for (int b = 0; b < 4; ++b) acc[b] += CAct[b * DM + kb + i0 + i] * wv[i]; }
            }
#pragma unroll
            for (int b = 0; b < 4; ++b)
#pragma unroll
                for (int j = 0; j < 4; ++j) { float v = acc[b][j]; v += swz_xor<16>(v); v = pair32_sum(v); acc[b][j] = v; }
            if (rg == 0) {
#pragma unroll
                for (int b = 0; b < 4; ++b) *(LAS f32x4*)(RED + (F.wave * 4 + b) * 64 + 4 * cq) = acc[b]; }
            __syncthreads();
            if (F.tid < 256) { const int b = F.tid >> 6, col = F.tid & 63; float s = b_ada[(size_t)l * NADA + n0 + col];
#pragma unroll
                for (int w = 0; w < 8; ++w) s += RED[(w * 4 + b) * 64 + col];
                mod[((size_t)l * NBATCH + b) * NADA + n0 + col] = s; }
            __syncthreads();
        }
    }
    {
        const int* pos = (const int*)ap->in[2];
        float* CA = (float*)(ws + WS_ROPE); float* SA = CA + MROWS * 16; float* CI = SA + MROWS * 16; float* SI = CI + MROWS * 8; float* CM = SI + MROWS * 8; float* SM = CM + MROWS * 32;
        for (int i = F.bid * 512 + F.tid; i < MROWS * 56; i += F.G * 512) {
            const int r = i / 56, j = i % 56;
            const float p = (float)pos[r];
            float inv; float* cd; float* sd;
            if (j < 16) { inv = ap->inv_a[j]; cd = CA + r * 16 + j; sd = SA + r * 16 + j; }
            else if (j < 24) { inv = ap->inv_i[j - 16]; cd = CI + r * 8 + (j - 16); sd = SI + r * 8 + (j - 16); }
            else { inv = ap->inv_m[j - 24]; cd = CM + r * 32 + (j - 24); sd = SM + r * 32 + (j - 24); }
            const float ang = p * inv;
            float s, c; sincos_d((double)ang, s, c);
            *cd = c; *sd = s;
        }
    }
    {
        constexpr int T_IN = 960, T_MQ = 48, T_MKV = 32, T_PA = 128, T_PB = 128, T_WO = 256, T_UP = 1408, T_DN = 704;
        constexpr int C1 = T_IN, C2 = C1 + T_MQ, C3 = C2 + T_MKV, C4 = C3 + T_PA, C5 = C4 + T_PB, C6 = C5 + T_WO, C7 = C6 + T_UP, C8 = C7 + T_DN;
        for (int it = F.bid; it < DEPTH * C8; it += F.G) {
            const int l = it / C8, r = it % C8;
            if (r < C1) { const int ti = r; transpose_tile<1>(F, (const float*)ap->in[7] + (size_t)l * DM * IN_DIM, IN_DIM, DM, (bf16_t*)(ws + WS_WIN) + (size_t)l * NPROJ * DM, (ti / 60) * 128, (ti % 60) * 128); }
            else if (r < C2) { const int ti = r - C1; transpose_tile<0>(F, (const float*)ap->in[11] + (size_t)l * 512 * 1536, 1536, 512, (bf16_t*)(ws + WS_WMQ) + (size_t)l * 1536 * 512, (ti / 12) * 128, (ti % 12) * 128); }
            else if (r < C3) { const int ti = r - C2; transpose_tile<0>(F, (const float*)ap->in[13] + (size_t)l * 256 * 2048, 2048, 256, (bf16_t*)(ws + WS_WMKV) + (size_t)l * 2048 * 256, (ti / 16) * 128, (ti % 16) * 128); }
            else if (r < C4) { const int ti = r - C3; transpose_tile<0>(F, (const float*)ap->in[16] + (size_t)l * 1024 * 2048, 2048, 1024, (bf16_t*)(ws + WS_WPAB) + (size_t)l * 4096 * 1024, (ti / 16) * 128, (ti % 16) * 128); }
            else if (r < C5) { const int ti = r - C4; transpose_tile<0>(F, (const float*)ap->in[17] + (size_t)l * 1024 * 2048, 2048, 1024, (bf16_t*)(ws + WS_WPAB) + (size_t)l * 4096 * 1024 + (size_t)2048 * 1024, (ti / 16) * 128, (ti % 16) * 128); }
            else if (r < C6) { const int ti = r - C5; transpose_tile<0>(F, (const float*)ap->in[18] + (size_t)l * 2048 * 2048, 2048, 2048, (bf16_t*)(ws + WS_WO) + (size_t)l * 2048 * 2048, (ti / 16) * 128, (ti % 16) * 128); }
            else if (r < C7) { const int ti = r - C6; transpose_tile<2>(F, (const float*)ap->in[19] + (size_t)l * DM * NUP, NUP, DM, (bf16_t*)(ws + WS_WUP) + (size_t)l * NUP * DM, (ti / 88) * 128, (ti % 88) * 128); }
            else { const int ti = r - C7; transpose_tile<0>(F, (const float*)ap->in[22] + (size_t)l * DFF * DM, DM, DFF, (bf16_t*)(ws + WS_WDN) + (size_t)l * DM * DFF, (ti / 16) * 128, (ti % 16) * 128); }
        }
        __syncthreads();
    }
}

__device__ __forceinline__ void phase_norm(const Frame& F, const float* x, const float* g, const float* modl  , int sh_off, int sc_off, bf16_t* h) {
    const int stride = F.G * 8;
    for (int row0 = F.bid * 8 + F.wave; row0 < MROWS; row0 += 4 * stride) {
        f32x4 v[4][8];
#pragma unroll
        for (int k = 0; k < 4; ++k) { const int row = row0 + k * stride;
            if (row < MROWS) {
#pragma unroll
                for (int i = 0; i < 8; ++i) v[k][i] = *(const f32x4*)(x + (size_t)row * DM + (i * 64 + F.lane) * 4); } }
#pragma unroll
        for (int k = 0; k < 4; ++k) { const int row = row0 + k * stride;
            if (row < MROWS) {
                const int b = row >> 11;
                float ss = 0.f;
#pragma unroll
                for (int i = 0; i < 8; ++i) ss += v[k][i][0] * v[k][i][0] + v[k][i][1] * v[k][i][1] + v[k][i][2] * v[k][i][2] + v[k][i][3] * v[k][i][3];
                ss = wave_sum(ss);
                const float rs = fast_rsq(ss * (1.0f / DM) + EPS);
                const float* mp = modl + (size_t)b * NADA;
#pragma unroll
                for (int i = 0; i < 8; ++i) { const int c = (i * 64 + F.lane) * 4;
                    const f32x4 gv = *(const f32x4*)(g + c), sc = *(const f32x4*)(mp + sc_off + c), sh = *(const f32x4*)(mp + sh_off + c);
                    const f32x4 y = (v[k][i] * rs) * gv * (sc + 1.0f) + sh;
                    u32x2 w; w.x = cvt_pk_bf16(y[0], y[1]); w.y = cvt_pk_bf16(y[2], y[3]);
                    *(u32x2*)(h + (size_t)row * DM + c) = w; }
            } }
    }
}

__device__ __forceinline__ void vt_tile(const Frame& F, const bf16_t* src  , int lds_, bf16_t* dst  ) {
    LAS bf16_t* T = (LAS bf16_t*)F.lds;
    const int sl = F.tid >> 3, dq = F.tid & 7;
    const u32x4 a0 = *(const u32x4*)(src + (size_t)sl * lds_ + dq * 16), a1 = *(const u32x4*)(src + (size_t)sl * lds_ + dq * 16 + 8);
    __syncthreads();
    *(LAS u32x4*)(T + sl * 136 + dq * 16) = a0; *(LAS u32x4*)(T + sl * 136 + dq * 16 + 8) = a1;
    __syncthreads();
    const int d = F.tid >> 2, sq = F.tid & 3;
    unsigned w[8];
#pragma unroll
    for (int i = 0; i < 8; ++i) { const int p = 2 * i, sa = (p & 3) | ((p & 4) << 1) | ((p & 8) >> 1);
        const unsigned lo = T[(sq * 16 + sa) * 136 + d], hi = T[(sq * 16 + sa + 1) * 136 + d]; w[i] = lo | (hi << 16); }
    bf16_t* dp = dst + (size_t)d * SEQ + sq * 16;
    *(u32x4*)dp = (u32x4){w[0], w[1], w[2], w[3]}; *(u32x4*)(dp + 8) = (u32x4){w[4], w[5], w[6], w[7]};
}

__device__ __forceinline__ void phase_post1(const Frame& F, int l) {
    ArgsCP ap = F.a; unsigned char* ws = F.ws;
    const bf16_t* proj = (const bf16_t*)(ws + WS_PROJ);
    bf16_t* QA = (bf16_t*)(ws + WS_QA); bf16_t* KA = (bf16_t*)(ws + WS_KA); bf16_t* QI = (bf16_t*)(ws + WS_QI); bf16_t* KI = (bf16_t*)(ws + WS_KI);
    float* WI = (float*)(ws + WS_WI); bf16_t* MQL = (bf16_t*)(ws + WS_MQL); bf16_t* MKVL = (bf16_t*)(ws + WS_MKVL);
    const float* CA = (const float*)(ws + WS_ROPE); const float* SA = CA + MROWS * 16; const float* CI = SA + MROWS * 16; const float* SI = CI + MROWS * 8;
    const float* g_qa = (const float*)ap->in[8] + l * 128; const float* g_ka = (const float*)ap->in[9] + l * 128;
    const float* g_mq = (const float*)ap->in[10] + l * 512; const float* g_mkv = (const float*)ap->in[12] + l * 256;
    const int L = F.lane;
    const float qscale = 0.08838834764831845f * LOG2E;
#pragma unroll 2
    for (int r = F.bid * 8 + F.wave; r < MROWS; r += F.G * 8) {
        const bf16_t* p = proj + (size_t)r * NPROJ;
        const float gq0 = g_qa[2 * L], gq1 = g_qa[2 * L + 1], gk0 = g_ka[2 * L], gk1 = g_ka[2 * L + 1];
        float c0 = 0.f, c1 = 0.f, s0 = 0.f, s1 = 0.f;
        if (L < 16) { const int dd = 2 * (L & 7); c0 = CA[r * 16 + dd]; c1 = CA[r * 16 + dd + 1]; s0 = SA[r * 16 + dd]; s1 = SA[r * 16 + dd + 1]; }
#pragma unroll
        for (int hh = 0; hh < 10; ++hh) {
            const unsigned w = *(const unsigned*)(p + hh * 128 + 2 * L);
            const float a0 = bf_lo(w), a1 = bf_hi(w);
            const float ss = wave_sum(a0 * a0 + a1 * a1);
            const float rs = fast_rsq(ss * (1.0f / 128.0f) + EPS);
            float y0 = a0 * rs * (hh < 8 ? gq0 : gk0), y1 = a1 * rs * (hh < 8 ? gq1 : gk1);
            const float o0 = swz_xor<8>(y0), o1 = swz_xor<8>(y1);
            if (L < 8) { y0 = y0 * c0 - o0 * s0; y1 = y1 * c1 - o1 * s1; }
            else if (L < 16) { y0 = y0 * c0 + o0 * s0; y1 = y1 * c1 + o1 * s1; }
            if (hh < 8) *(unsigned*)(QA + (size_t)r * 1024 + hh * 128 + 2 * L) = cvt_pk_bf16(y0 * qscale, y1 * qscale);
            else *(unsigned*)(KA + (size_t)r * 256 + (hh - 8) * 128 + 2 * L) = cvt_pk_bf16(y0, y1);
        }
        {
            const int Lh = L & 31;
            float ci0 = 0.f, ci1 = 0.f, si0 = 0.f, si1 = 0.f;
            if (Lh < 8) { const int dd = 2 * (Lh & 3); ci0 = CI[r * 8 + dd]; ci1 = CI[r * 8 + dd + 1]; si0 = SI[r * 8 + dd]; si1 = SI[r * 8 + dd + 1]; }
#pragma unroll
            for (int ch = 0; ch < 9; ++ch) {
                unsigned w = 0u;
                if (ch < 8 || L < 32) w = *(const unsigned*)(p + PC_QI + ch * 128 + 2 * L);
                float y0 = bf_lo(w), y1 = bf_hi(w);
                const float o0 = swz_xor<4>(y0), o1 = swz_xor<4>(y1);
                if (Lh < 4) { y0 = y0 * ci0 - o0 * si0; y1 = y1 * ci1 - o1 * si1; }
                else if (Lh < 8) { y0 = y0 * ci0 + o0 * si0; y1 = y1 * ci1 + o1 * si1; }
                if (ch < 8) *(unsigned*)(QI + (size_t)r * 1024 + ch * 128 + 2 * L) = cvt_pk_bf16(y0, y1);
                else if (L < 32) *(unsigned*)(KI + (size_t)r * 64 + 2 * L) = cvt_pk_bf16(y0, y1);
            }
        }
        if (L < 16) WI[(size_t)r * 16 + L] = bf1(p[PC_WI + L]) * 0.03125f;
        {
            const u32x4 w = *(const u32x4*)(p + PC_MQL + 8 * L);
            float e[8] = {bf_lo(w.x), bf_hi(w.x), bf_lo(w.y), bf_hi(w.y), bf_lo(w.z), bf_hi(w.z), bf_lo(w.w), bf_hi(w.w)};
            float ss = 0.f;
#pragma unroll
            for (int j = 0; j < 8; ++j) ss += e[j] * e[j];
            ss = wave_sum(ss);
            const float rs = fast_rsq(ss * (1.0f / 512.0f) + EPS);
            const f32x4 g0 = *(const f32x4*)(g_mq + 8 * L), g1 = *(const f32x4*)(g_mq + 8 * L + 4);
            u32x4 o; o.x = cvt_pk_bf16(e[0] * rs * g0[0], e[1] * rs * g0[1]); o.y = cvt_pk_bf16(e[2] * rs * g0[2], e[3] * rs * g0[3]);
            o.z = cvt_pk_bf16(e[4] * rs * g1[0], e[5] * rs * g1[1]); o.w = cvt_pk_bf16(e[6] * rs * g1[2], e[7] * rs * g1[3]);
            *(u32x4*)(MQL + (size_t)r * 512 + 8 * L) = o;
        }
        {
            const u32x2 w = *(const u32x2*)(p + PC_MKVL + 4 * L);
            float e[4] = {bf_lo(w.x), bf_hi(w.x), bf_lo(w.y), bf_hi(w.y)};
            float ss = wave_sum(e[0] * e[0] + e[1] * e[1] + e[2] * e[2] + e[3] * e[3]);
            const float rs = fast_rsq(ss * (1.0f / 256.0f) + EPS);
            const f32x4 g0 = *(const f32x4*)(g_mkv + 4 * L);
            u32x2 o; o.x = cvt_pk_bf16(e[0] * rs * g0[0], e[1] * rs * g0[1]); o.y = cvt_pk_bf16(e[2] * rs * g0[2], e[3] * rs * g0[3]);
            *(u32x2*)(MKVL + (size_t)r * 256 + 4 * L) = o;
        }
    }
    bf16_t* VAT = (bf16_t*)(ws + WS_VAT);
    for (int it = F.bid; it < NBATCH * 2 * (SEQ / 64); it += F.G) {
        const int sb = it % (SEQ / 64), g = (it / (SEQ / 64)) & 1, b = it / (2 * (SEQ / 64));
        vt_tile(F, proj + (size_t)(b * SEQ + sb * 64) * NPROJ + PC_VA + g * 128, NPROJ, VAT + (size_t)(b * 2 + g) * 128 * SEQ + sb * 64);
    }
    __syncthreads();
}

__device__ __forceinline__ void phase_post2(const Frame& F, int l) {
    ArgsCP ap = F.a; unsigned char* ws = F.ws;
    const bf16_t* proj = (const bf16_t*)(ws + WS_PROJ); const bf16_t* MQ = (const bf16_t*)(ws + WS_MQ); const bf16_t* MKV = (const bf16_t*)(ws + WS_MKV);
    bf16_t* QM = (bf16_t*)(ws + WS_QM); bf16_t* KM = (bf16_t*)(ws + WS_KM);
    const float* CM = (const float*)(ws + WS_ROPE) + MROWS * 48; const float* SM = CM + MROWS * 32;
    const float* g_qm = (const float*)ap->in[14] + l * 192; const float* g_km = (const float*)ap->in[15] + l * 192;
    const int L = F.lane;
    const float qscale = 0.07216878364870322f * LOG2E;
    const float gq0 = g_qm[L], gq1 = g_qm[64 + L], gq2 = g_qm[128 + L], gk0 = g_km[L], gk1 = g_km[64 + L], gk2 = g_km[128 + L];
#pragma unroll 2
    for (int r = F.bid * 8 + F.wave; r < MROWS; r += F.G * 8) {
        const float cm = CM[r * 32 + (L & 31)], sm = SM[r * 32 + (L & 31)];
        const float kr = bf1(proj[(size_t)r * NPROJ + PC_MKR + L]);
#pragma unroll
        for (int h = 0; h < 8; ++h) {
            {
                const bf16_t* qp = MQ + (size_t)r * 1536 + h * 192;
                const float e0 = bf1(qp[L]), e1 = bf1(qp[64 + L]), e2 = bf1(qp[128 + L]);
                const float ss = wave_sum(e0 * e0 + e1 * e1 + e2 * e2);
                const float rs = fast_rsq(ss * (1.0f / 192.0f) + EPS);
                const float y0 = e0 * rs * gq0, y1 = e1 * rs * gq1; float y2 = e2 * rs * gq2;
                const float o2 = pair32_other(y2, L >= 32);
                y2 = (L < 32) ? (y2 * cm - o2 * sm) : (y2 * cm + o2 * sm);
                bf16_t* dp = QM + (size_t)r * 1536 + h * 192;
                dp[L] = (bf16_t)(cvt_pk_bf16(y0 * qscale, 0.f) & 0xffffu); dp[64 + L] = (bf16_t)(cvt_pk_bf16(y1 * qscale, 0.f) & 0xffffu); dp[128 + L] = (bf16_t)(cvt_pk_bf16(y2 * qscale, 0.f) & 0xffffu);
            }
            {
                const bf16_t* kp = MKV + (size_t)r * 2048 + h * 256;
                const float e0 = bf1(kp[L]), e1 = bf1(kp[64 + L]), e2 = kr;
                const float ss = wave_sum(e0 * e0 + e1 * e1 + e2 * e2);
                const float rs = fast_rsq(ss * (1.0f / 192.0f) + EPS);
                const float y0 = e0 * rs * gk0, y1 = e1 * rs * gk1; float y2 = e2 * rs * gk2;
                const float o2 = pair32_other(y2, L >= 32);
                y2 = (L < 32) ? (y2 * cm - o2 * sm) : (y2 * cm + o2 * sm);
                bf16_t* dp = KM + (size_t)r * 1536 + h * 192;
                dp[L] = (bf16_t)(cvt_pk_bf16(y0, 0.f) & 0xffffu); dp[64 + L] = (bf16_t)(cvt_pk_bf16(y1, 0.f) & 0xffffu); dp[128 + L] = (bf16_t)(cvt_pk_bf16(y2, 0.f) & 0xffffu);
            }
        }
    }
    bf16_t* VMT = (bf16_t*)(ws + WS_VMT);
    for (int it = F.bid; it < NBATCH * 8 * (SEQ / 64); it += F.G) {
        const int sb = it % (SEQ / 64), h = (it / (SEQ / 64)) & 7, b = it / (8 * (SEQ / 64));
        vt_tile(F, MKV + (size_t)(b * SEQ + sb * 64) * 2048 + h * 256 + 128, 2048, VMT + (size_t)(b * 8 + h) * 128 * SEQ + sb * 64);
    }
    __syncthreads();
}

constexpr int SC_STRIDE = 2052, RD = 4;
__device__ __forceinline__ void idx_unit(const Frame& F, int b, int tb) {
    unsigned char* ws = F.ws;
    const bf16_t* QI = (const bf16_t*)(ws + WS_QI); const bf16_t* KI = (const bf16_t*)(ws + WS_KI); const float* WI = (const float*)(ws + WS_WI);
    unsigned* MASK = (unsigned*)(ws + WS_MASK);
    LAS float* SC = (LAS float*)F.lds;
    const int L = F.lane, q = L & 15, hq = L >> 4;
    const int t0 = tb * 16; const size_t row0 = (size_t)b * SEQ + t0;
    __syncthreads();
    const int nkt = tb + 1;
    const bf16_t* kbase = KI + ((size_t)b * SEQ + q) * 64 + hq * 8;
    const int nmy = (nkt - F.wave + 7) >> 3;
#ifndef IDX_REP_SCORE
#define IDX_REP_SCORE 1
#endif
#ifndef IDX_REP_SEL
#define IDX_REP_SEL 1
#endif
#pragma unroll 1
    for (int hp = 0; hp < 2 * IDX_REP_SCORE; ++hp) {
        bf16x8 qf[8][2]; float wv[8];
#pragma unroll
        for (int hh = 0; hh < 8; ++hh) {
#pragma unroll
            for (int ks = 0; ks < 2; ++ks) qf[hh][ks] = *(const bf16x8*)(QI + (row0 + q) * 1024 + ((hp & 1) * 8 + hh) * 64 + ks * 32 + hq * 8);
            wv[hh] = WI[(row0 + q) * 16 + (hp & 1) * 8 + hh]; }
        bf16x8 kr[RD][2];
#pragma unroll
        for (int s8 = 0; s8 < RD; ++s8) { kr[s8][0] = (bf16x8){0, 0, 0, 0, 0, 0, 0, 0}; kr[s8][1] = kr[s8][0];
            if (s8 < nmy) { const bf16_t* kp = kbase + (size_t)(F.wave + 8 * s8) * 16 * 64; kr[s8][0] = *(const bf16x8*)kp; kr[s8][1] = *(const bf16x8*)(kp + 32); } }
#pragma unroll 1
        for (int base = 0; base < nmy; base += RD) {
#pragma unroll
            for (int s8 = 0; s8 < RD; ++s8) {
                const int i = base + s8;
                if (i < nmy) {
                    const int kt = F.wave + 8 * i;
                    const bf16x8 k0 = kr[s8][0], k1 = kr[s8][1];
                    if (i + RD < nmy) { const bf16_t* kp = kbase + (size_t)(kt + 8 * RD) * 16 * 64; kr[s8][0] = *(const bf16x8*)kp; kr[s8][1] = *(const bf16x8*)(kp + 32); }
                    f32x4 sc = (f32x4){0.f, 0.f, 0.f, 0.f};
#pragma unroll
                    for (int hh = 0; hh < 8; ++hh) {
                        f32x4 d = __builtin_amdgcn_mfma_f32_16x16x32_bf16(k0, qf[hh][0], (f32x4){0.f, 0.f, 0.f, 0.f}, 0, 0, 0);
                        d = __builtin_amdgcn_mfma_f32_16x16x32_bf16(k1, qf[hh][1], d, 0, 0, 0);
#pragma unroll
                        for (int j = 0; j < 4; ++j) { const int di = __float_as_int(d[j]); sc[j] = __builtin_fmaf(wv[hh], __int_as_float(di > 0 ? di : 0), sc[j]); }
                    }
                    LAS f32x4* sp = (LAS f32x4*)(SC + q * SC_STRIDE + kt * 16 + 4 * hq);
                    if (hp & 1) sc += *sp;
                    *sp = sc;
                }
            }
        }
    }
    __syncthreads();
#pragma unroll 1
    for (int qq = 0; qq < 2 * IDX_REP_SEL; ++qq) {
        const int qr = F.wave * 2 + (qq & 1), t = t0 + qr;
        unsigned key[32];
#pragma unroll
        for (int j = 0; j < 32; ++j) { const int s = j * 64 + L; unsigned u = __float_as_uint(SC[qr * SC_STRIDE + s]);
            u = (u & 0x80000000u) ? ~u : (u | 0x80000000u); key[j] = (s <= t) ? u : 0u; }
        unsigned T = 1u; int need = 1 << 30;
        if (t >= 256) {
            T = 0u;
#pragma unroll 1
            for (int bit = 31; bit >= 0; --bit) {
                const unsigned cand = __builtin_amdgcn_readfirstlane(T | (1u << bit)); int cnt = 0;
#pragma unroll
                for (int jb = 0; jb < 32; jb += 8) {
                    unsigned long long mk[8];
#pragma unroll
                    for (int j = 0; j < 8; ++j) asm volatile("v_cmp_ge_u32_e64 %0, %1, %2" : "=s"(mk[j]) : "v"(key[jb + j]), "s"(cand));
                    __builtin_amdgcn_sched_barrier(0);
#pragma unroll
                    for (int j = 0; j < 8; ++j) cnt += __builtin_popcountll(mk[j]);
                    __builtin_amdgcn_sched_barrier(0);
                }
                cnt = __builtin_amdgcn_readfirstlane(cnt);
                if (cnt >= 256) T = cand;
                if (cnt == 256) break;
            }
            int gt = 0;
#pragma unroll
            for (int j = 0; j < 32; ++j) gt += __builtin_popcountll(__ballot(key[j] > T));
            need = 256 - gt;
        }
        int run = 0; unsigned long long mymask = 0ull;
#pragma unroll
        for (int j = 0; j < 32; ++j) {
            const unsigned long long eq = __ballot(key[j] == T);
            const int rank = run + (int)__builtin_amdgcn_mbcnt_hi((unsigned)(eq >> 32), __builtin_amdgcn_mbcnt_lo((unsigned)eq, 0u));
            const bool sel = (key[j] > T) || (key[j] == T && rank < need);
            run += __builtin_popcountll(eq);
            const unsigned long long m = __ballot(sel);
            if (L == j) mymask = m;
        }
        if (L < 32) *(unsigned long long*)(MASK + (row0 + qr) * 64 + 2 * L) = mymask;
    }
}
__device__ __forceinline__ void phase_idx(const Frame& F) {
    for (int u = F.bid; u < 256; u += F.G) { const int b = u >> 6, i = u & 63; idx_unit(F, b, i); idx_unit(F, b, 127 - i); }
    __syncthreads();
}

template <int DQK, bool DSA>
__device__ __forceinline__ void attn_unit(const Frame& F, const bf16_t* Q, int ldq, const bf16_t* Kg, int ldk, const bf16_t* Vt, const unsigned* maskb, bf16_t* O, int ldo, int q0) {
    constexpr int NST = DQK / 16;
    constexpr int KA_BYTES = 64 * 256, KB_BYTES = (DQK == 192) ? 64 * 128 : 0, V_OFF = KA_BYTES + KB_BYTES, STAGE = V_OFF + 128 * 128;
    const int L = F.lane, r = L & 31, hf = L >> 5, w = F.wave;
    const int qw0 = q0 + 32 * w, tq = qw0 + r;
    const int ntiles = (q0 + 256) / 64;
    auto issue = [&](int kt, int buf) {
        LAS unsigned char* sb = F.lds + buf * STAGE;
#pragma unroll
        for (int i = 0; i < 2; ++i) { const int chunk = w + 8 * i, row = chunk * 4 + (L >> 4), slot = L & 15, piece = slot ^ (row & 15);
            __builtin_amdgcn_global_load_lds((const unsigned*)(Kg + (size_t)(kt * 64 + row) * ldk + piece * 8), (LAS unsigned*)(sb + chunk * 1024), 16, 0, 0); }
        if (DQK == 192) { const int row = w * 8 + (L >> 3), slot = L & 7, piece = 16 + (slot ^ ((row >> 1) & 7));
            __builtin_amdgcn_global_load_lds((const unsigned*)(Kg + (size_t)(kt * 64 + row) * ldk + piece * 8), (LAS unsigned*)(sb + KA_BYTES + w * 1024), 16, 0, 0); }
#pragma unroll
        for (int i = 0; i < 2; ++i) { const int chunk = w + 8 * i, row = chunk * 8 + (L >> 3), slot = L & 7, piece = slot ^ ((row >> 1) & 7);
            __builtin_amdgcn_global_load_lds((const unsigned*)(Vt + (size_t)row * SEQ + kt * 64 + piece * 8), (LAS unsigned*)(sb + V_OFF + chunk * 1024), 16, 0, 0); }
    };
    __syncthreads();
    u32x2 mw = (u32x2){0u, 0u};
    if (DSA) mw = *(const u32x2*)(maskb + (size_t)tq * 64);
    issue(0, 0);
    bf16x8 qf[NST];
#pragma unroll
    for (int st = 0; st < NST; ++st) qf[st] = *(const bf16x8*)(Q + (size_t)tq * ldq + st * 16 + hf * 8);
    f32x16 oacc[4];
#pragma unroll
    for (int dt = 0; dt < 4; ++dt)
#pragma unroll
        for (int i = 0; i < 16; ++i) oacc[dt][i] = 0.f;
    float mrun = -1e30f, lsum = 0.f;
    const int kx = (r & 15) ^ hf, vx = (r >> 1) & 7;
    for (int kt = 0; kt < ntiles; ++kt) {
        asm volatile("s_waitcnt vmcnt(0)" ::: "memory");
        __syncthreads();
        const u32x2 mcur = mw;
        if (DSA && kt + 1 < ntiles) mw = *(const u32x2*)(maskb + (size_t)tq * 64 + (kt + 1) * 2);
        if (kt + 1 < ntiles) issue(kt + 1, (kt + 1) & 1);
        if (kt * 64 <= qw0 + 31) {
            const LAS unsigned char* sb = F.lds + (kt & 1) * STAGE;
            f32x16 sacc[2];
#pragma unroll
            for (int kh = 0; kh < 2; ++kh) {
#pragma unroll
                for (int i = 0; i < 16; ++i) sacc[kh][i] = 0.f;
#pragma unroll
                for (int st = 0; st < NST; ++st) {
                    const LAS unsigned char* kp = (st < 8) ? sb + (kh * 32 + r) * 256 + (((2 * st) ^ kx) << 4)
                                                           : sb + KA_BYTES + (kh * 32 + r) * 128 + ((((2 * st - 16) | hf) ^ vx) << 4);
                    const bf16x8 kf = *(const LAS bf16x8*)kp;
                    sacc[kh] = __builtin_amdgcn_mfma_f32_32x32x16_bf16(kf, qf[st], sacc[kh], 0, 0, 0); }
            }
            if (!DSA && kt * 64 + 63 > qw0) {
                const int lim = tq - kt * 64 - 4 * hf;
#pragma unroll
                for (int i = 0; i < 16; ++i) { const int ko = (i & 3) + 8 * (i >> 2);
                    sacc[0][i] = (ko <= lim) ? sacc[0][i] : -INFINITY; sacc[1][i] = (ko + 32 <= lim) ? sacc[1][i] : -INFINITY; }
            }
            float mx = sacc[0][0];
#pragma unroll
            for (int i = 1; i < 16; ++i) mx = fmaxf(mx, sacc[0][i]);
#pragma unroll
            for (int i = 0; i < 16; ++i) mx = fmaxf(mx, sacc[1][i]);
            mx = pair32_max(mx);
            const float mnew = fmaxf(mrun, mx);
            const float alpha = fast_exp2(mrun - mnew);
            const bool grew = (mnew != mrun);
            mrun = mnew;
            float ps = 0.f;
            if (DSA) {
                const unsigned m0 = mcur.x >> (4 * hf), m1 = mcur.y >> (4 * hf);
#pragma unroll
                for (int i = 0; i < 16; ++i) { const unsigned bit = 1u << ((i & 3) + 8 * (i >> 2));
                    const float p0 = (m0 & bit) ? fast_exp2(sacc[0][i] - mnew) : 0.f, p1 = (m1 & bit) ? fast_exp2(sacc[1][i] - mnew) : 0.f;
                    sacc[0][i] = p0; sacc[1][i] = p1; ps += p0 + p1; }
            } else {
#pragma unroll
                for (int kh = 0; kh < 2; ++kh)
#pragma unroll
                    for (int i = 0; i < 16; ++i) { const float pv = fast_exp2(sacc[kh][i] - mnew); sacc[kh][i] = pv; ps += pv; }
            }
            lsum = lsum * alpha + ps;
            if (__builtin_amdgcn_ballot_w64(grew) != 0ull) {
#pragma unroll
                for (int dt = 0; dt < 4; ++dt)
#pragma unroll
                    for (int i = 0; i < 16; ++i) oacc[dt][i] *= alpha;
            }
            bf16x8 pf[2][2];
#pragma unroll
            for (int kh = 0; kh < 2; ++kh)
#pragma unroll
                for (int s2 = 0; s2 < 2; ++s2) { u32x4 pw;
                    pw.x = cvt_pk_bf16(sacc[kh][8 * s2 + 0], sacc[kh][8 * s2 + 1]); pw.y = cvt_pk_bf16(sacc[kh][8 * s2 + 2], sacc[kh][8 * s2 + 3]);
                    pw.z = cvt_pk_bf16(sacc[kh][8 * s2 + 4], sacc[kh][8 * s2 + 5]); pw.w = cvt_pk_bf16(sacc[kh][8 * s2 + 6], sacc[kh][8 * s2 + 7]);
                    pf[kh][s2] = __builtin_bit_cast(bf16x8, pw); }
#pragma unroll
            for (int dt = 0; dt < 4; ++dt)
#pragma unroll
                for (int kh = 0; kh < 2; ++kh)
#pragma unroll
                    for (int s2 = 0; s2 < 2; ++s2) {
                        const bf16x8 vf = *(const LAS bf16x8*)(sb + V_OFF + (dt * 32 + r) * 128 + ((((4 * kh + 2 * s2) | hf) ^ vx) << 4));
                        oacc[dt] = __builtin_amdgcn_mfma_f32_32x32x16_bf16(vf, pf[kh][s2], oacc[dt], 0, 0, 0); }
        }
    }
    const float ltot = pair32_sum(lsum);
    const float inv = fast_rcp(ltot);
    bf16_t* op = O + (size_t)tq * ldo + 4 * hf;
#pragma unroll
    for (int dt = 0; dt < 4; ++dt)
#pragma unroll
        for (int g4 = 0; g4 < 4; ++g4) { u32x2 ow; ow.x = cvt_pk_bf16(oacc[dt][4 * g4 + 0] * inv, oacc[dt][4 * g4 + 1] * inv); ow.y = cvt_pk_bf16(oacc[dt][4 * g4 + 2] * inv, oacc[dt][4 * g4 + 3] * inv);
            *(u32x2*)(op + dt * 32 + g4 * 8) = ow; }
}

#ifndef ATT_ENABLE_MLA
#define ATT_ENABLE_MLA 1
#endif
#ifndef ATT_ENABLE_DSA
#define ATT_ENABLE_DSA 1
#endif
__device__ __forceinline__ void phase_attn(const Frame& F) {
    unsigned char* ws = F.ws;
    const bf16_t* QA = (const bf16_t*)(ws + WS_QA); const bf16_t* KA = (const bf16_t*)(ws + WS_KA); const bf16_t* VAT = (const bf16_t*)(ws + WS_VAT);
    const bf16_t* QM = (const bf16_t*)(ws + WS_QM); const bf16_t* KM = (const bf16_t*)(ws + WS_KM); const bf16_t* VMT = (const bf16_t*)(ws + WS_VMT);
    const unsigned* MASK = (const unsigned*)(ws + WS_MASK); bf16_t* OAB = (bf16_t*)(ws + WS_OAB);
    for (int u = F.bid; u < 256; u += F.G) {
        const int b = u >> 6, h = (u >> 3) & 7, qb = u & 7;
        const size_t rb = (size_t)b * SEQ;
        if (ATT_ENABLE_DSA) attn_unit<128, true>(F, QA + rb * 1024 + h * 128, 1024, KA + rb * 256 + (h >> 2) * 128, 256, VAT + (size_t)(b * 2 + (h >> 2)) * 128 * SEQ, MASK + rb * 64, OAB + rb * DM + h * 128, DM, qb * 256);
        if (ATT_ENABLE_MLA) attn_unit<192, false>(F, QM + rb * 1536 + h * 192, 1536, KM + rb * 1536 + h * 192, 1536, VMT + (size_t)(b * 8 + h) * 128 * SEQ, nullptr, OAB + rb * DM + 1024 + h * 128, DM, (7 - qb) * 256);
    }
    __syncthreads();
}

__device__ __forceinline__ void phase_conv(const Frame& F, int l) {
    ArgsCP ap = F.a; unsigned char* ws = F.ws;
    const bf16_t* U = (const bf16_t*)(ws + WS_U); bf16_t* ACT = (bf16_t*)(ws + WS_ACT);
    const float* wconv = (const float*)ap->in[20] + (size_t)l * 3 * NUP; const float* bconv = (const float*)ap->in[21] + (size_t)l * NUP;
    const int cg = F.tid & 15, rs = F.tid >> 4;
    for (int it = F.bid; it < 32 * 44; it += F.G) {
        const int j = it % 44, pm = it / 44;
        const int ch = 128 * j + 8 * cg;
        const int row0 = pm * 256 + rs * 8;
        float wg[3][8], wvv[3][8], bg[8], bv[8];
#pragma unroll
        for (int k = 0; k < 3; ++k) { const f32x4 x0 = *(const f32x4*)(wconv + (size_t)k * NUP + ch), x1 = *(const f32x4*)(wconv + (size_t)k * NUP + ch + 4), y0 = *(const f32x4*)(wconv + (size_t)k * NUP + DFF + ch), y1 = *(const f32x4*)(wconv + (size_t)k * NUP + DFF + ch + 4);
#pragma unroll
            for (int e = 0; e < 4; ++e) { wg[k][e] = x0[e]; wg[k][4 + e] = x1[e]; wvv[k][e] = y0[e]; wvv[k][4 + e] = y1[e]; } }
        { const f32x4 x0 = *(const f32x4*)(bconv + ch), x1 = *(const f32x4*)(bconv + ch + 4), y0 = *(const f32x4*)(bconv + DFF + ch), y1 = *(const f32x4*)(bconv + DFF + ch + 4);
#pragma unroll
            for (int e = 0; e < 4; ++e) { bg[e] = x0[e]; bg[4 + e] = x1[e]; bv[e] = y0[e]; bv[4 + e] = y1[e]; } }
        const bf16_t* up = U + (size_t)row0 * NUP + 256 * j + 8 * cg;
        float g2[8], g1[8], v2[8], v1[8];
        const bool has_prev = (row0 & (SEQ - 1)) != 0;
#pragma unroll
        for (int e = 0; e < 8; ++e) { g2[e] = 0.f; g1[e] = 0.f; v2[e] = 0.f; v1[e] = 0.f; }
        if (has_prev) {
            const u32x4 a2 = *(const u32x4*)(up - 2 * (size_t)NUP), a1 = *(const u32x4*)(up - (size_t)NUP), c2 = *(const u32x4*)(up - 2 * (size_t)NUP + 128), c1 = *(const u32x4*)(up - (size_t)NUP + 128);
            g2[0] = bf_lo(a2.x); g2[1] = bf_hi(a2.x); g2[2] = bf_lo(a2.y); g2[3] = bf_hi(a2.y); g2[4] = bf_lo(a2.z); g2[5] = bf_hi(a2.z); g2[6] = bf_lo(a2.w); g2[7] = bf_hi(a2.w);
            g1[0] = bf_lo(a1.x); g1[1] = bf_hi(a1.x); g1[2] = bf_lo(a1.y); g1[3] = bf_hi(a1.y); g1[4] = bf_lo(a1.z); g1[5] = bf_hi(a1.z); g1[6] = bf_lo(a1.w); g1[7] = bf_hi(a1.w);
            v2[0] = bf_lo(c2.x); v2[1] = bf_hi(c2.x); v2[2] = bf_lo(c2.y); v2[3] = bf_hi(c2.y); v2[4] = bf_lo(c2.z); v2[5] = bf_hi(c2.z); v2[6] = bf_lo(c2.w); v2[7] = bf_hi(c2.w);
            v1[0] = bf_lo(c1.x); v1[1] = bf_hi(c1.x); v1[2] = bf_lo(c1.y); v1[3] = bf_hi(c1.y); v1[4] = bf_lo(c1.z); v1[5] = bf_hi(c1.z); v1[6] = bf_lo(c1.w); v1[7] = bf_hi(c1.w);
        }
        u32x4 gin[8], vin[8];
#pragma unroll
        for (int i = 0; i < 8; ++i) { gin[i] = *(const u32x4*)(up + (size_t)i * NUP); vin[i] = *(const u32x4*)(up + (size_t)i * NUP + 128); }
#pragma unroll
        for (int i = 0; i < 8; ++i) {
            float g0[8], v0[8], o[8];
            g0[0] = bf_lo(gin[i].x); g0[1] = bf_hi(gin[i].x); g0[2] = bf_lo(gin[i].y); g0[3] = bf_hi(gin[i].y); g0[4] = bf_lo(gin[i].z); g0[5] = bf_hi(gin[i].z); g0[6] = bf_lo(gin[i].w); g0[7] = bf_hi(gin[i].w);
            v0[0] = bf_lo(vin[i].x); v0[1] = bf_hi(vin[i].x); v0[2] = bf_lo(vin[i].y); v0[3] = bf_hi(vin[i].y); v0[4] = bf_lo(vin[i].z); v0[5] = bf_hi(vin[i].z); v0[6] = bf_lo(vin[i].w); v0[7] = bf_hi(vin[i].w);
#pragma unroll
            for (int e = 0; e < 8; ++e) {
                const float gc = bg[e] + wg[0][e] * g2[e] + wg[1][e] * g1[e] + wg[2][e] * g0[e];
                const float vc = bv[e] + wvv[0][e] * v2[e] + wvv[1][e] * v1[e] + wvv[2][e] * v0[e];
                o[e] = gc * sigmoidf_(gc) * vc;
                g2[e] = g1[e]; g1[e] = g0[e]; v2[e] = v1[e]; v1[e] = v0[e];
            }
            u32x4 ow; ow.x = cvt_pk_bf16(o[0], o[1]); ow.y = cvt_pk_bf16(o[2], o[3]); ow.z = cvt_pk_bf16(o[4], o[5]); ow.w = cvt_pk_bf16(o[6], o[7]);
            *(u32x4*)(ACT + (size_t)(row0 + i) * DFF + ch) = ow;
        }
    }
}

__device__ __forceinline__ void conv_fixup(const Frame& F, int l, int pm) {
    if ((pm & 7) == 0) return;
    ArgsCP ap = F.a; unsigned char* ws = F.ws;
    const float* wconv = (const float*)ap->in[20] + (size_t)l * 3 * NUP; const float* bconv = (const float*)ap->in[21] + (size_t)l * NUP;
    const float* UH = (const float*)(ws + WS_UHEAD) + (size_t)pm * 2 * NUP; const float* UT = (const float*)(ws + WS_UTAIL) + (size_t)(pm - 1) * 2 * NUP;
    bf16_t* ACT = (bf16_t*)(ws + WS_ACT);
    for (int idx = F.tid; idx < 2 * (DFF / 4); idx += 512) {
        const int rr = idx / (DFF / 4), ch = (idx % (DFF / 4)) * 4, colp = (ch >> 7) * 256 + (ch & 127);
        f32x4 o;
        f32x4 cvv[2];
#pragma unroll
        for (int bj = 0; bj < 2; ++bj) {
            const int cp = colp + bj * 128, cw = ch + bj * DFF;
            const f32x4 x2 = *(const f32x4*)(UT + (size_t)rr * NUP + cp);
            const f32x4 x1 = rr ? *(const f32x4*)(UH + cp) : *(const f32x4*)(UT + (size_t)NUP + cp);
            const f32x4 x0 = *(const f32x4*)(UH + (size_t)rr * NUP + cp);
            cvv[bj] = *(const f32x4*)(bconv + cw) + *(const f32x4*)(wconv + cw) * x2 + *(const f32x4*)(wconv + (size_t)NUP + cw) * x1 + *(const f32x4*)(wconv + (size_t)2 * NUP + cw) * x0;
        }
#pragma unroll
        for (int e = 0; e < 4; ++e) { const float g = cvv[0][e]; o[e] = g * sigmoidf_(g) * cvv[1][e]; }
        u32x2 ow; ow.x = cvt_pk_bf16(o[0], o[1]); ow.y = cvt_pk_bf16(o[2], o[3]);
        *(u32x2*)(ACT + (size_t)(pm * 256 + rr) * DFF + ch) = ow;
    }
}

typedef ArgsCP ArgsP;
__device__ __forceinline__ Frame make_frame() {
    Frame F;
    int tid = threadIdx.x; asm volatile("" : "+v"(tid));
    int bid = blockIdx.x, G = gridDim.x; asm volatile("" : "+s"(bid), "+s"(G));
    ArgsP ap = (ArgsP)__builtin_amdgcn_kernarg_segment_ptr(); asm volatile("" : "+s"(ap));
    extern __shared__ __attribute__((aligned(16))) unsigned char lds_raw[];
    F.lds = (LAS unsigned char*)lds_raw;
    F.tid = tid; F.lane = tid & 63; F.wave = __builtin_amdgcn_readfirstlane(tid >> 6); F.G = G; F.bid = bid;
    F.a = ap; F.ws = ap->ws;
    return F;
}

__global__ void __launch_bounds__(512, 2) fwd_kernel(Args args) {
    extern __shared__ __attribute__((aligned(16))) unsigned char lds_raw[];
    volatile LAS unsigned* MISC = (volatile LAS unsigned*)((LAS unsigned char*)lds_raw + LDS_MISC);
    if (threadIdx.x < 16) MISC[threadIdx.x] = 0u;
    __syncthreads();
    const int lo = args.ph_lo, hi = args.ph_hi;
    XcdBarrier bar; bar.bar = (unsigned*)(args.ws + WS_CTL) + 4096; bar.x = 0; bar.st = MISC;
    if (hi - lo > 1) bar = xcd_barrier_post((unsigned*)(args.ws + WS_CTL) + 4096, MISC);
#ifndef ONLY_PHASE
#define ONLY_PHASE -1
#endif
#define PH_EN(p) (ONLY_PHASE < 0 || ONLY_PHASE == (p))
#ifndef REP_MASK
#define REP_MASK 0
#endif
#define REPEAT(bit) _Pragma("unroll 1") for (int _rep = 0; _rep < (((REP_MASK >> (bit)) & 1) ? 2 : 1); ++_rep)
#define IN(k) (lo <= (k) && (k) < hi)
#define SEAM(k) do { if (IN(k) && IN((k) + 1)) { XcdBarrier b2 = bar; asm volatile("" : "+s"(b2.bar), "+s"(b2.x)); xcd_barrier(b2); } } while (0)

    if (PH_EN(100) && IN(0)) REPEAT(0) { const Frame F = make_frame(); p0_prologue(F); }
    SEAM(0);

#pragma unroll 1
    for (int l = 0; l < DEPTH; ++l) {
        const int pb = 1 + l * NPH_LAYER;
        if (PH_EN(0) && IN(pb + 0)) REPEAT(4) { const Frame F = make_frame(); unsigned char* ws = F.ws;
            const float* xin = (l == 0) ? (const float*)F.a->in[0] : (const float*)F.a->out;
            phase_norm(F, xin, (const float*)F.a->in[3] + l * DM, (const float*)(ws + WS_MOD) + (size_t)l * NBATCH * NADA, 0, DM, (bf16_t*)(ws + WS_H)); }
        SEAM(pb + 0);
        if (PH_EN(1) && IN(pb + 1)) REPEAT(1) { const Frame F = make_frame(); unsigned char* ws = F.ws;
            pg8::Gemm g{(const bf16_t*)(ws + WS_H), (const bf16_t*)(ws + WS_WIN) + (size_t)l * NPROJ * DM, DM, DM, DM, 0, 0};
            pg8::StaticOrder S; S.init(MROWS, NPROJ, F.G, F.bid);
            pg8::EpiStoreBf16 E{(bf16_t*)(ws + WS_PROJ), NPROJ};
            pg8::gemm_phase(F.lds, F.tid, g, S, E);
        }
        SEAM(pb + 1);
        if (PH_EN(2) && IN(pb + 2)) REPEAT(5) { const Frame F = make_frame(); phase_post1(F, l); }
        SEAM(pb + 2);
        if (PH_EN(3) && IN(pb + 3)) {
            { const Frame F = make_frame(); unsigned char* ws = F.ws;
              pg8::Gemm g{(const bf16_t*)(ws + WS_MQL), (const bf16_t*)(ws + WS_WMQ) + (size_t)l * 1536 * 512, 512, 512, 512, 0, 0};
              pg8::StaticOrder S; S.init(MROWS, 1536, F.G, F.bid); pg8::EpiStoreBf16 E{(bf16_t*)(ws + WS_MQ), 1536}; pg8::gemm_phase(F.lds, F.tid, g, S, E); }
            { const Frame F = make_frame(); unsigned char* ws = F.ws;
              pg8::Gemm g{(const bf16_t*)(ws + WS_MKVL), (const bf16_t*)(ws + WS_WMKV) + (size_t)l * 2048 * 256, 256, 256, 256, 0, 0};
              pg8::StaticOrder S; S.init(MROWS, 2048, F.G, F.bid); pg8::EpiStoreBf16 E{(bf16_t*)(ws + WS_MKV), 2048}; pg8::gemm_phase(F.lds, F.tid, g, S, E); }
            REPEAT(3) { const Frame F = make_frame(); phase_idx(F); }
        }
        SEAM(pb + 3);
        if (PH_EN(4) && IN(pb + 4)) REPEAT(6) { const Frame F = make_frame(); phase_post2(F, l); }
        SEAM(pb + 4);
        if (PH_EN(5) && IN(pb + 5)) REPEAT(2) { const Frame F = make_frame(); phase_attn(F); }
        SEAM(pb + 5);
        if (PH_EN(6) && IN(pb + 6)) { const Frame F = make_frame(); unsigned char* ws = F.ws;
            pg8::Gemm g{(const bf16_t*)(ws + WS_OAB), (const bf16_t*)(ws + WS_WPAB) + (size_t)l * 4096 * 1024, DM, 1024, 1024, (size_t)1024 * 2, (size_t)2048 * 1024 * 2};
            pg8::PairOrder S; S.s.init(MROWS, DM, F.G, F.bid);
            pg8::EpiPab E{(const bf16_t*)(ws + WS_PROJ), (bf16_t*)(ws + WS_MERGED)};
            pg8::gemm_phase(F.lds, F.tid, g, S, E);
        }
        SEAM(pb + 6);
        if (PH_EN(7) && IN(pb + 7)) { const Frame F = make_frame(); unsigned char* ws = F.ws;
            const float* xin = (l == 0) ? (const float*)F.a->in[0] : (const float*)F.a->out;
            pg8::Gemm g{(const bf16_t*)(ws + WS_MERGED), (const bf16_t*)(ws + WS_WO) + (size_t)l * DM * DM, DM, DM, DM, 0, 0};
            pg8::StaticOrder S; S.init(MROWS, DM, F.G, F.bid);
            pg8::EpiResid E{xin, F.a->out, (const float*)(ws + WS_MOD) + (size_t)l * NBATCH * NADA + 2 * DM};
            pg8::gemm_phase(F.lds, F.tid, g, S, E);
        }
        SEAM(pb + 7);
        if (PH_EN(8) && IN(pb + 8)) REPEAT(7) { const Frame F = make_frame(); unsigned char* ws = F.ws;
            phase_norm(F, F.a->out, (const float*)F.a->in[4] + l * DM, (const float*)(ws + WS_MOD) + (size_t)l * NBATCH * NADA, 3 * DM, 4 * DM, (bf16_t*)(ws + WS_H)); }
        SEAM(pb + 8);
        if (PH_EN(9) && IN(pb + 9)) { const Frame F = make_frame(); unsigned char* ws = F.ws;
            pg8::Gemm g{(const bf16_t*)(ws + WS_H), (const bf16_t*)(ws + WS_WUP) + (size_t)l * NUP * DM, DM, DM, DM, 0, 0};
            pg8::StaticOrder S; S.init(MROWS, NUP, F.G, F.bid);
            pg8::EpiUpConv E{(const float*)F.a->in[20] + (size_t)l * 3 * NUP, (const float*)F.a->in[21] + (size_t)l * NUP, (bf16_t*)(ws + WS_ACT), (float*)(ws + WS_UHEAD), (float*)(ws + WS_UTAIL), (LAS float*)(F.lds + LDS_XB)};
            pg8::gemm_phase(F.lds, F.tid, g, S, E);
        }
        SEAM(pb + 9);
        if (PH_EN(10) && IN(pb + 10)) { const Frame F = make_frame(); unsigned char* ws = F.ws;
            pg8::StaticOrder S; S.init(MROWS, DM, F.G, F.bid);
            { pg8::Unit uu; for (int i = 0; S.next(i, uu); ++i) conv_fixup(F, l, uu.pm); }
            asm volatile("s_waitcnt vmcnt(0)" ::: "memory"); __syncthreads();
            pg8::Gemm g{(const bf16_t*)(ws + WS_ACT), (const bf16_t*)(ws + WS_WDN) + (size_t)l * DM * DFF, DFF, DFF, DFF, 0, 0};
            pg8::EpiResid E{F.a->out, F.a->out, (const float*)(ws + WS_MOD) + (size_t)l * NBATCH * NADA + 5 * DM};
            pg8::gemm_phase(F.lds, F.tid, g, S, E);
        }
        SEAM(pb + 10);
    }
#undef IN
#undef SEAM
}

extern "C" void kernel_launch(void* const* d_in, const int* in_sizes, int n_in, void* d_out, int out_size, void* d_ws, size_t ws_size, hipStream_t stream) {
    static int grid = 0;
    if (grid == 0) {
        if (n_in != 23 || out_size != MROWS * DM || ws_size < WS_END) { fprintf(stderr, "kernel_launch: unexpected problem (n_in %d, out %d, ws %zu < %zu)\n", n_in, out_size, ws_size, (size_t)WS_END); grid = -1; return; }
        int dev = 0, cus = 0, per_cu = 0;
        if (hipGetDevice(&dev) != hipSuccess || hipDeviceGetAttribute(&cus, hipDeviceAttributeMultiprocessorCount, dev) != hipSuccess) { grid = -1; return; }
        if (hipFuncSetAttribute((const void*)fwd_kernel, hipFuncAttributeMaxDynamicSharedMemorySize, LDS_BYTES) != hipSuccess) { fprintf(stderr, "kernel_launch: hipFuncSetAttribute failed\n"); grid = -1; return; }
        if (hipOccupancyMaxActiveBlocksPerMultiprocessor(&per_cu, (const void*)fwd_kernel, 512, LDS_BYTES) != hipSuccess || per_cu < 1) { fprintf(stderr, "kernel_launch: occupancy query says %d\n", per_cu); }
        (void)hipGetLastError();
        grid = cus;
    }
    if (grid < 0) return;
    (void)in_sizes;
    hipMemsetAsync((char*)d_ws + WS_CTL, 0, CTL_ZERO_BYTES, stream);
    Args a{};
    for (int i = 0; i < 23; ++i) a.in[i] = d_in[i];
    a.out = (float*)d_out; a.ws = (unsigned char*)d_ws;
    for (int i = 0; i < 16; ++i) a.inv_a[i] = (float)pow(500000.0, -(double)(2 * i) / 32.0);
    for (int i = 0; i < 8; ++i) a.inv_i[i] = (float)pow(500000.0, -(double)(2 * i) / 16.0);
    for (int i = 0; i < 32; ++i) a.inv_m[i] = (float)pow(500000.0, -(double)(2 * i) / 64.0);
#if MK_ONE_LAUNCH
    a.ph_lo = 0; a.ph_hi = NPHASES;
    hipLaunchKernelGGL(fwd_kernel, dim3(grid), dim3(512), LDS_BYTES, stream, a);
#else
    for (int p = 0; p < NPHASES; ++p) { a.ph_lo = p; a.ph_hi = p + 1; hipLaunchKernelGGL(fwd_kernel, dim3(grid), dim3(512), LDS_BYTES, stream, a); }
#endif
}
```

```cpp
#include <hip/hip_runtime.h>
#include <cstdio>
#include <cstdint>
#include <cmath>

#define GAS __attribute__((address_space(1)))
#define LAS __attribute__((address_space(3)))
typedef unsigned short bf16_t;
typedef short bf16x8 __attribute__((ext_vector_type(8)));
typedef short bf16x4 __attribute__((ext_vector_type(4)));
typedef float f32x4 __attribute__((ext_vector_type(4)));
typedef float f32x16 __attribute__((ext_vector_type(16)));
typedef unsigned u32x4 __attribute__((ext_vector_type(4)));
typedef unsigned u32x2 __attribute__((ext_vector_type(2)));

constexpr int DM = 2048, NBATCH = 4, SEQ = 2048, DEPTH = 4, MROWS = NBATCH * SEQ;
constexpr int IN_DIM = 7568, NPROJ = 7680, DFF = 5632, NUP = 2 * DFF, NADA = 6 * DM;
constexpr int PC_QA = 0, PC_KA = 1024, PC_VA = 1280, PC_QI = 1536, PC_KI = 2560, PC_WI = 2624, PC_MKR = 2640, PC_MQL = 2816, PC_MKVL = 3328, PC_GA = 3584, PC_GB = 5632;
constexpr float EPS = 1e-6f;
constexpr float LOG2E = 1.4426950408889634f;
constexpr int NPH_LAYER = 9, NPHASES = 2 + DEPTH * NPH_LAYER;
#ifndef MK_ONE_LAUNCH
#define MK_ONE_LAUNCH 1
#endif

constexpr size_t MiB = 1u << 20;
constexpr size_t WS_CTL = 0, CTL_ZERO_BYTES = 1 * MiB;
constexpr size_t WS_SSQ = 256 * 1024;
constexpr size_t WS_MOD = 1 * MiB;
constexpr size_t WS_ROPE = 2 * MiB;
constexpr size_t WS_WIN = 8 * MiB;
constexpr size_t WS_WMQ = 128 * MiB;
constexpr size_t WS_WMKV = 134 * MiB;
constexpr size_t WS_WPAB = 138 * MiB;
constexpr size_t WS_WO = 170 * MiB;
constexpr size_t WS_WUP = 202 * MiB;
constexpr size_t WS_WDN = 378 * MiB;
constexpr size_t WS_H = 466 * MiB;
constexpr size_t WS_PROJ = 498 * MiB;
constexpr size_t WS_QA = 618 * MiB;
constexpr size_t WS_KA = 634 * MiB;
constexpr size_t WS_VAT = 638 * MiB;
constexpr size_t WS_QI = 642 * MiB;
constexpr size_t WS_KI = 658 * MiB;
constexpr size_t WS_WI = 659 * MiB;
constexpr size_t WS_MQL = 660 * MiB;
constexpr size_t WS_MKVL = 668 * MiB;
constexpr size_t WS_MQ = 672 * MiB;
constexpr size_t WS_MKV = 696 * MiB;
constexpr size_t WS_QM = 728 * MiB;
constexpr size_t WS_KM = 752 * MiB;
constexpr size_t WS_VMT = 776 * MiB;
constexpr size_t WS_MASK = 792 * MiB;
constexpr size_t WS_OAB = 794 * MiB;
constexpr size_t WS_MERGED = 826 * MiB;
constexpr size_t WS_U = 858 * MiB;
constexpr size_t WS_ACT = 1034 * MiB;
constexpr size_t WS_UHEAD = 1122 * MiB;
constexpr size_t WS_UTAIL = 1126 * MiB;
constexpr size_t WS_BIAS = 1130 * MiB, BIAS_ZERO_BYTES = 2560 * 1024;
constexpr size_t WS_BIAS_UP = WS_BIAS + (size_t)DEPTH * NBATCH * NPROJ * 8;
constexpr size_t WS_END = 1134 * MiB;

constexpr int LDS_BYTES = 147456;
constexpr int LDS_MISC = 135168;
constexpr int LDS_XB = 139264;

__device__ __forceinline__ unsigned cvt_pk_bf16(float lo, float hi) { unsigned r; asm("v_cvt_pk_bf16_f32 %0, %1, %2" : "=v"(r) : "v"(lo), "v"(hi)); return r; }
__device__ __forceinline__ float bf_lo(unsigned w) { return __uint_as_float(w << 16); }
__device__ __forceinline__ float bf_hi(unsigned w) { return __uint_as_float(w & 0xffff0000u); }
__device__ __forceinline__ float bf1(bf16_t v) { return __uint_as_float(((unsigned)v) << 16); }
template <int K> __device__ __forceinline__ float swz_xor(float v) { return __int_as_float(__builtin_amdgcn_ds_swizzle(__float_as_int(v), 0x1f | (K << 10))); }
__device__ __forceinline__ float pair32_sum(float v) { auto rr = __builtin_amdgcn_permlane32_swap(__float_as_uint(v), __float_as_uint(v), false, false); return __uint_as_float(rr[0]) + __uint_as_float(rr[1]); }
__device__ __forceinline__ float pair32_max(float v) { auto rr = __builtin_amdgcn_permlane32_swap(__float_as_uint(v), __float_as_uint(v), false, false); return fmaxf(__uint_as_float(rr[0]), __uint_as_float(rr[1])); }
__device__ __forceinline__ float pair32_other(float v, bool upper) { auto rr = __builtin_amdgcn_permlane32_swap(__float_as_uint(v), __float_as_uint(v), false, false); return __uint_as_float(upper ? rr[0] : rr[1]); }
__device__ __forceinline__ float wave_sum(float v) {
    v += swz_xor<1>(v); v += swz_xor<2>(v); v += swz_xor<4>(v); v += swz_xor<8>(v); v += swz_xor<16>(v);
    return pair32_sum(v);
}
__device__ __forceinline__ float fast_rsq(float x) { return __builtin_amdgcn_rsqf(x); }
__device__ __forceinline__ float fast_rcp(float x) { return __builtin_amdgcn_rcpf(x); }
__device__ __forceinline__ float fast_exp2(float x) { return __builtin_amdgcn_exp2f(x); }
typedef long long fx64;
constexpr float FX_SSQ = 4294967296.f, FX_SSQ_INV = 1.0f / 4294967296.f;
constexpr double FX_BIAS = 1099511627776.0; constexpr float FX_BIAS_INV = (float)(1.0 / 1099511627776.0);
__device__ __forceinline__ void fx_add(fx64* p, double scaled) { (void)__hip_atomic_fetch_add((unsigned long long*)p, (unsigned long long)(long long)__builtin_rint(scaled), __ATOMIC_RELAXED, __HIP_MEMORY_SCOPE_AGENT); }
__device__ __forceinline__ float sigmoidf_(float x) { return fast_rcp(1.0f + fast_exp2(-x * LOG2E)); }

#define XB_TMO      128
#define XB_XCNT(j)  (256  + 64 * (j))
#define XB_XSUB(j)  (1280 + 64 * (j))
#define XB_XGEN(j)  (2304 + 64 * (j))
#define XB_TOP      3328
#define XB_TOPGEN   3392
#define XCD_BAR_WORDS 3456
#define XB_SPIN_CAP (1u << 20)

__device__ __forceinline__ unsigned xb_ld(unsigned* p)              { return __hip_atomic_load(p, __ATOMIC_RELAXED, __HIP_MEMORY_SCOPE_AGENT); }
__device__ __forceinline__ unsigned xb_add(unsigned* p, unsigned v) { return __hip_atomic_fetch_add(p, v, __ATOMIC_RELAXED, __HIP_MEMORY_SCOPE_AGENT); }
__device__ __forceinline__ unsigned xb_xcc_id() { return (unsigned)__builtin_amdgcn_s_getreg((3 << 11) | 20) & 0xFu; }
#define XB_SPIN(cond, bar) do { unsigned _sp = 0; while (cond) { __builtin_amdgcn_s_sleep(1); \
    if ((++_sp & 255u) == 0u) { if (xb_ld(&(bar)[XB_TMO])) break; if (_sp > XB_SPIN_CAP) { atomicAdd(&(bar)[XB_TMO], 1u); break; } } } } while (0)

struct XcdBarrier { unsigned* bar; unsigned x; volatile LAS unsigned* st; };

__device__ __forceinline__ XcdBarrier xcd_barrier_post(unsigned* bar, volatile LAS unsigned* st) {
    XcdBarrier b; b.bar = bar; b.x = xb_xcc_id(); b.st = st;
    if (threadIdx.x == 0) (void)xb_add(&bar[XB_XCNT(b.x)], 1u);
    return b;
}
__device__ __forceinline__ void xcd_barrier_complete(unsigned* bar, unsigned x, unsigned& nloc, unsigned& nx) {
    const unsigned G = gridDim.x * gridDim.y * gridDim.z;
    unsigned sum, cnt, mine, sp = 0u;
    for (;;) {
        sum = 0u; cnt = 0u; mine = 0u;
#pragma unroll
        for (unsigned j = 0; j < 16; ++j) { const unsigned c = xb_ld(&bar[XB_XCNT(j)]); sum += c; cnt += (c > 0u) ? 1u : 0u; mine = (j == x) ? c : mine; }
        if (sum == G) break;
        __builtin_amdgcn_s_sleep(1);
        if ((++sp & 255u) == 0u) { if (xb_ld(&bar[XB_TMO])) break; if (sp > XB_SPIN_CAP) { atomicAdd(&bar[XB_TMO], 1u); break; } }
    }
    nloc = mine > 0u ? mine : 1u; nx = cnt > 0u ? cnt : 1u;
}
__device__ __forceinline__ void xcd_barrier(const XcdBarrier& b) {
    asm volatile("s_waitcnt vmcnt(0)" ::: "memory");
    __syncthreads();
    if (threadIdx.x == 0) {
        unsigned* bar = b.bar;
        __builtin_amdgcn_s_waitcnt(0);
        unsigned nloc = b.st[0], nx = b.st[1];
        if (nloc == 0u) { xcd_barrier_complete(bar, b.x, nloc, nx); b.st[0] = nloc; b.st[1] = nx; }
        const unsigned old = xb_add(&bar[XB_XSUB(b.x)], 1u);
        const unsigned gen = old / nloc;
        if (old + 1u == (gen + 1u) * nloc) {
            __builtin_amdgcn_fence(__ATOMIC_RELEASE, "agent");
            asm volatile("s_waitcnt vmcnt(0)" ::: "memory");
            const unsigned og = xb_add(&bar[XB_TOP], 1u);
            const unsigned tg = og / nx;
            if (og + 1u == (tg + 1u) * nx) xb_add(&bar[XB_TOPGEN], 1u);
            else XB_SPIN(xb_ld(&bar[XB_TOPGEN]) == tg, bar);
            __builtin_amdgcn_fence(__ATOMIC_ACQUIRE, "agent");
            xb_add(&bar[XB_XGEN(b.x)], 1u);
            asm volatile("s_waitcnt vmcnt(0)" ::: "memory");
        } else {
            XB_SPIN(xb_ld(&bar[XB_XGEN(b.x)]) == gen, bar);
            __builtin_amdgcn_fence(__ATOMIC_ACQUIRE, "agent");
            asm volatile("s_waitcnt vmcnt(0)" ::: "memory");
        }
    }
    __syncthreads();
}

namespace pg8 {
constexpr int BM = 256, BK = 64, HALF = 128, HTB = HALF * BK * 2, STAGE_BYTES = 8 * HTB, NXCD = 8, WGM = 8;
__host__ __device__ __forceinline__ int lds_byte(int r, int c) { const int st = (r >> 4) * 2 + (c >> 5), rr = r & 15, cc = c & 31, ob = rr * 64 + cc * 2; return st * 1024 + (ob ^ (((ob >> 9) & 1) << 5)); }
__host__ __device__ __forceinline__ void stage_rc(int b, int& R, int& C) { const int st = b / 1024, sb = b % 1024, swz = sb ^ (((sb >> 9) & 1) << 5); R = (st >> 1) * 16 + swz / 64; C = (st & 1) * 32 + (swz % 64) / 2; }
__host__ __device__ __forceinline__ int perm32(int rho) { const int n = rho >> 4, i = rho & 15; return 8 * (i >> 2) + 4 * n + (i & 3); }

struct Unit { int pm, pn, z; };
struct Gemm { const bf16_t* A; const bf16_t* Bt; int lda, ldb, K; size_t azs, bzs; };

struct StaticOrder {
    int nM, nN, nwg, G, c;
    __host__ __device__ __forceinline__ void init(int M, int N, int G_, int c_) { nM = M / BM; nN = N / BM; nwg = nM * nN; G = G_; c = c_; }
    __host__ __device__ __forceinline__ bool next(int i, Unit& u) const {
        const long L = (long)i * G + c; if (L >= nwg) return false;
        int wgid = (int)L; { const int q = nwg / NXCD, r = nwg % NXCD, xcd = wgid % NXCD, off = wgid / NXCD; wgid = (xcd < r ? xcd * (q + 1) : r * (q + 1) + (xcd - r) * q) + off; }
        const int nig = WGM * nN, gid = wgid / nig, fm = gid * WGM, gsz = (nM - fm) < WGM ? (nM - fm) : WGM;
        u.pm = fm + ((wgid % nig) % gsz); u.pn = (wgid % nig) / gsz; u.z = 0; return true;
    }
};
struct PairOrder {
    StaticOrder s;
    __host__ __device__ __forceinline__ bool next(int i, Unit& u) const { if (!s.next(i >> 1, u)) return false; u.z = i & 1; return true; }
};

template <class Epi, class Sched, bool ALIGN_EPI = true, bool SP2 = true>
__device__ __forceinline__ void gemm_phase(LAS unsigned char* lds, const int tid, const Gemm g, const Sched& S, const Epi& E) {
    const int wid = __builtin_amdgcn_readfirstlane(tid >> 6), lane = tid & 63, wr = wid >> 2, wc = wid & 3, fr = lane & 15, fq = lane >> 4;
    const int K = g.K, nt = K / BK;
    unsigned voffA[2], voffB[2];
#pragma unroll
    for (int i = 0; i < 2; ++i) { int R, C; stage_rc(tid * 16 + i * 8192, R, C); const int Rb = Epi::PERM ? ((R & ~31) + perm32(R & 31)) : R;
        const int Ra = Epi::PERM_A ? ((R & 64) | ((R & 15) << 2) | ((R >> 4) & 3)) : R;
        voffA[i] = (unsigned)(Ra * g.lda + C) * 2u; voffB[i] = (unsigned)(Rb * g.ldb + C) * 2u; }
    const size_t kstep = (size_t)(BK * 2);
    const size_t hstepA = (size_t)HALF * g.lda * 2, hstepB = (size_t)HALF * g.ldb * 2;
    const size_t tstepA = 2 * hstepA, tstepB = 2 * hstepB;
    const unsigned ldsw = (unsigned)wid * 1024u;
    const int aoff = lds_byte(wr * 64 + fr, fq * 8), boff = lds_byte(wc * 32 + fr, fq * 8);
#define PG8_SA(b, h) (((b) * 2 + (h)) * HTB)
#define PG8_SB(b, h) ((4 + (b) * 2 + (h)) * HTB)
#define PG8_STAGE(bufoff, gbase, voff) do { _Pragma("unroll") for (int _i = 0; _i < 2; ++_i) \
        __builtin_amdgcn_global_load_lds((const unsigned*)((const char*)(gbase) + (voff)[_i]), (LAS unsigned*)(lds + (bufoff) + ldsw + _i * 8192), 16, 0, 0); } while (0)
#define PG8_LDA(dst, b, h) do { _Pragma("unroll") for (int m = 0; m < 4; ++m) _Pragma("unroll") for (int k = 0; k < 2; ++k) dst[m][k] = *(const LAS bf16x8*)(lds + PG8_SA(b, h) + aoff + m * 2048 + k * 1024); } while (0)
#define PG8_LDB(dst, b, h) do { _Pragma("unroll") for (int n = 0; n < 2; ++n) _Pragma("unroll") for (int k = 0; k < 2; ++k) dst[n][k] = *(const LAS bf16x8*)(lds + PG8_SB(b, h) + boff + n * 2048 + k * 1024); } while (0)
#define PG8_MMA(ai, bj, At, Bt) do { __builtin_amdgcn_s_setprio(1); _Pragma("unroll") for (int m = 0; m < 4; ++m) _Pragma("unroll") for (int n = 0; n < 2; ++n) _Pragma("unroll") for (int k = 0; k < 2; ++k) \
        acc[ai][bj][m][n] = __builtin_amdgcn_mfma_f32_16x16x32_bf16(Bt[n][k], At[m][k], acc[ai][bj][m][n], 0, 0, 0); __builtin_amdgcn_s_setprio(0); } while (0)
#define PG8_WAIT_V(n) asm volatile("s_waitcnt vmcnt(" #n ")" ::: "memory")
#define PG8_WAIT_L(n) asm volatile("s_waitcnt lgkmcnt(" #n ")" ::: "memory")
#define PG8_BAR __builtin_amdgcn_s_barrier()
#define PG8_SCHED __builtin_amdgcn_sched_barrier(0)
    Unit cur, nxt; int ui = 0;
    if (!S.next(0, cur)) return;
    f32x4 acc[2][2][4][2];
#pragma unroll
    for (int a = 0; a < 2; ++a)
#pragma unroll
        for (int b = 0; b < 2; ++b)
#pragma unroll
            for (int m = 0; m < 4; ++m)
#pragma unroll
                for (int n = 0; n < 2; ++n) acc[a][b][m][n] = (f32x4){0.f, 0.f, 0.f, 0.f};
    bf16x8 At[4][2], B0[2][2], B1[2][2];
    const char* cA = (const char*)g.A + (size_t)cur.z * g.azs + (size_t)cur.pm * tstepA; const char* cB = (const char*)g.Bt + (size_t)cur.z * g.bzs + (size_t)cur.pn * tstepB;
    if constexpr (SP2) {
        PG8_STAGE(PG8_SB(0, 0), cB, voffB); PG8_STAGE(PG8_SB(0, 1), cB + hstepB, voffB); PG8_STAGE(PG8_SA(0, 0), cA, voffA); PG8_STAGE(PG8_SA(0, 1), cA + hstepA, voffA);
        if (wr == 1) PG8_BAR;
        PG8_WAIT_V(2); PG8_BAR;
        PG8_STAGE(PG8_SB(1, 0), cB + kstep, voffB); PG8_STAGE(PG8_SA(1, 0), cA + kstep, voffA); PG8_STAGE(PG8_SB(1, 1), cB + hstepB + kstep, voffB);
        PG8_WAIT_V(6); PG8_BAR;
    } else {
        PG8_STAGE(PG8_SB(0, 0), cB, voffB); PG8_STAGE(PG8_SA(0, 0), cA, voffA); PG8_STAGE(PG8_SB(0, 1), cB + hstepB, voffB); PG8_STAGE(PG8_SA(0, 1), cA + hstepA, voffA);
        if (wr == 1) PG8_BAR;
        PG8_WAIT_V(4); PG8_BAR;
        PG8_STAGE(PG8_SB(1, 0), cB + kstep, voffB); PG8_STAGE(PG8_SA(1, 0), cA + kstep, voffA); PG8_STAGE(PG8_SB(1, 1), cB + hstepB + kstep, voffB);
        PG8_WAIT_V(6); PG8_BAR;
    }
    for (;;) {
        const bool has_next = S.next(ui + 1, nxt);
        const char* nA = has_next ? (const char*)g.A + (size_t)nxt.z * g.azs + (size_t)nxt.pm * tstepA : cA; const char* nB = has_next ? (const char*)g.Bt + (size_t)nxt.z * g.bzs + (size_t)nxt.pn * tstepB : cB;
        for (int t = 0; t < nt; t += 2) {
            const bool last = (t == nt - 2);
            const char* a1 = cA + (size_t)(t + 1) * kstep;
            const char* a2 = last ? nA : cA + (size_t)(t + 2) * kstep; const char* b2 = last ? nB : cB + (size_t)(t + 2) * kstep;
            const char* a3 = a2 + kstep; const char* b3 = b2 + kstep;
            if constexpr (SP2) {
            PG8_LDB(B0, 0, 0); PG8_LDB(B1, 0, 1); PG8_SCHED; PG8_LDA(At, 0, 0); PG8_STAGE(PG8_SA(1, 1), a1 + hstepA, voffA);
            PG8_WAIT_V(8); PG8_WAIT_L(0); PG8_BAR; PG8_MMA(0, 0, At, B0); PG8_MMA(0, 1, At, B1); PG8_BAR; PG8_SCHED;
            PG8_LDA(At, 0, 1); PG8_STAGE(PG8_SB(0, 0), b2, voffB); PG8_STAGE(PG8_SB(0, 1), b2 + hstepB, voffB); PG8_STAGE(PG8_SA(0, 0), a2, voffA);
            PG8_WAIT_V(8); PG8_WAIT_L(0); PG8_BAR; PG8_MMA(1, 0, At, B0); PG8_MMA(1, 1, At, B1); PG8_BAR; PG8_SCHED;
            PG8_LDB(B0, 1, 0); PG8_LDB(B1, 1, 1); PG8_SCHED; PG8_LDA(At, 1, 0); PG8_STAGE(PG8_SA(0, 1), a2 + hstepA, voffA);
            PG8_WAIT_V(8); PG8_WAIT_L(0); PG8_BAR; PG8_MMA(0, 0, At, B0); PG8_MMA(0, 1, At, B1); PG8_BAR; PG8_SCHED;
            PG8_LDA(At, 1, 1); PG8_STAGE(PG8_SB(1, 0), b3, voffB); PG8_STAGE(PG8_SB(1, 1), b3 + hstepB, voffB); PG8_STAGE(PG8_SA(1, 0), a3, voffA);
            PG8_WAIT_V(8); PG8_WAIT_L(0); PG8_BAR; PG8_MMA(1, 0, At, B0); PG8_MMA(1, 1, At, B1); PG8_BAR; PG8_SCHED;
            } else {
            PG8_LDB(B0, 0, 0); PG8_SCHED; PG8_LDA(At, 0, 0); PG8_STAGE(PG8_SA(1, 1), a1 + hstepA, voffA);
            PG8_WAIT_L(8); PG8_BAR; PG8_WAIT_L(0); PG8_MMA(0, 0, At, B0); PG8_BAR; PG8_SCHED;
            PG8_LDB(B1, 0, 1); PG8_STAGE(PG8_SB(0, 0), b2, voffB);
            PG8_BAR; PG8_WAIT_L(0); PG8_MMA(0, 1, At, B1); PG8_BAR;
            PG8_LDA(At, 0, 1); PG8_STAGE(PG8_SA(0, 0), a2, voffA);
            PG8_BAR; PG8_WAIT_L(0); PG8_MMA(1, 0, At, B0); PG8_BAR; PG8_SCHED;
            PG8_STAGE(PG8_SB(0, 1), b2 + hstepB, voffB);
            PG8_WAIT_V(6); PG8_BAR; PG8_MMA(1, 1, At, B1); PG8_BAR;
            PG8_LDB(B0, 1, 0); PG8_SCHED; PG8_LDA(At, 1, 0); PG8_STAGE(PG8_SA(0, 1), a2 + hstepA, voffA);
            PG8_WAIT_L(8); PG8_BAR; PG8_WAIT_L(0); PG8_MMA(0, 0, At, B0); PG8_BAR; PG8_SCHED;
            PG8_LDB(B1, 1, 1); PG8_STAGE(PG8_SB(1, 0), b3, voffB);
            PG8_BAR; PG8_WAIT_L(0); PG8_MMA(0, 1, At, B1); PG8_BAR;
            PG8_LDA(At, 1, 1); PG8_STAGE(PG8_SA(1, 0), a3, voffA);
            PG8_BAR; PG8_WAIT_L(0); PG8_MMA(1, 0, At, B0); PG8_BAR; PG8_SCHED;
            PG8_STAGE(PG8_SB(1, 1), b3 + hstepB, voffB);
            PG8_WAIT_V(6); PG8_BAR; PG8_MMA(1, 1, At, B1); PG8_BAR;
            }
        }
        if constexpr (ALIGN_EPI) { if (wr == 0) PG8_BAR; }
        E(acc, cur, wr, wc, fr, fq);
        if (!has_next) break;
#pragma unroll
        for (int a = 0; a < 2; ++a)
#pragma unroll
            for (int b = 0; b < 2; ++b)
#pragma unroll
                for (int m = 0; m < 4; ++m)
#pragma unroll
                    for (int n = 0; n < 2; ++n) acc[a][b][m][n] = (f32x4){0.f, 0.f, 0.f, 0.f};
        cur = nxt; cA = nA; cB = nB; ++ui;
        if constexpr (ALIGN_EPI) { if (wr == 1) PG8_BAR; }
    }
    PG8_WAIT_V(0);
    if constexpr (!ALIGN_EPI) { if (wr == 0) PG8_BAR; }
    PG8_BAR;
#undef PG8_SA
#undef PG8_SB
#undef PG8_STAGE
#undef PG8_LDA
#undef PG8_LDB
#undef PG8_MMA
#undef PG8_WAIT_V
#undef PG8_WAIT_L
#undef PG8_BAR
#undef PG8_SCHED
}

struct EpiStoreBf16 {
    static constexpr bool PERM = true, PERM_A = false;
    bf16_t* O; int ldc;
    __device__ __forceinline__ void operator()(const f32x4 (&acc)[2][2][4][2], const Unit& u, int wr, int wc, int fr, int fq) const {
        const int row0 = u.pm * BM + wr * 64 + fr, col0 = u.pn * BM + wc * 32 + 8 * fq;
#pragma unroll
        for (int ai = 0; ai < 2; ++ai)
#pragma unroll
            for (int m = 0; m < 4; ++m) { bf16_t* rowp = O + (size_t)(row0 + ai * HALF + m * 16) * ldc + col0;
#pragma unroll
                for (int bj = 0; bj < 2; ++bj) { const f32x4 v0 = acc[ai][bj][m][0], v1 = acc[ai][bj][m][1];
                    u32x4 w; w.x = cvt_pk_bf16(v0[0], v0[1]); w.y = cvt_pk_bf16(v0[2], v0[3]); w.z = cvt_pk_bf16(v1[0], v1[1]); w.w = cvt_pk_bf16(v1[2], v1[3]);
                    *(u32x4*)(rowp + bj * HALF) = w; } }
    }
};
struct EpiPab {
    static constexpr bool PERM = true, PERM_A = false;
    const bf16_t* proj; bf16_t* merged;
    __device__ __forceinline__ void operator()(const f32x4 (&acc)[2][2][4][2], const Unit& u, int wr, int wc, int fr, int fq) const {
        const int row0 = u.pm * BM + wr * 64 + fr, col0 = u.pn * BM + wc * 32 + 8 * fq;
        const int gcol = (u.z ? PC_GB : PC_GA) + col0;
#pragma unroll
        for (int ai = 0; ai < 2; ++ai)
#pragma unroll
            for (int m = 0; m < 4; ++m) { const size_t r = (size_t)(row0 + ai * HALF + m * 16);
#pragma unroll
                for (int bj = 0; bj < 2; ++bj) {
                    const u32x4 gw = *(const u32x4*)(proj + r * NPROJ + gcol + bj * HALF);
                    const f32x4 v0 = acc[ai][bj][m][0], v1 = acc[ai][bj][m][1];
                    float o[8];
                    o[0] = sigmoidf_(bf_lo(gw.x)) * v0[0]; o[1] = sigmoidf_(bf_hi(gw.x)) * v0[1]; o[2] = sigmoidf_(bf_lo(gw.y)) * v0[2]; o[3] = sigmoidf_(bf_hi(gw.y)) * v0[3];
                    o[4] = sigmoidf_(bf_lo(gw.z)) * v1[0]; o[5] = sigmoidf_(bf_hi(gw.z)) * v1[1]; o[6] = sigmoidf_(bf_lo(gw.w)) * v1[2]; o[7] = sigmoidf_(bf_hi(gw.w)) * v1[3];
                    bf16_t* dst = merged + r * DM + col0 + bj * HALF;
                    if (u.z) { const u32x4 pw = *(const u32x4*)dst;
                        o[0] += bf_lo(pw.x); o[1] += bf_hi(pw.x); o[2] += bf_lo(pw.y); o[3] += bf_hi(pw.y); o[4] += bf_lo(pw.z); o[5] += bf_hi(pw.z); o[6] += bf_lo(pw.w); o[7] += bf_hi(pw.w); }
                    u32x4 w; w.x = cvt_pk_bf16(o[0], o[1]); w.y = cvt_pk_bf16(o[2], o[3]); w.z = cvt_pk_bf16(o[4], o[5]); w.w = cvt_pk_bf16(o[6], o[7]);
                    *(u32x4*)dst = w; } }
    }
};
struct EpiResid {
    static constexpr bool PERM = false, PERM_A = false;
    const float* xsrc; float* out; const float* gate;
    __device__ __forceinline__ void operator()(const f32x4 (&acc)[2][2][4][2], const Unit& u, int wr, int wc, int fr, int fq) const {
        const int row0 = u.pm * BM + wr * 64 + fr, col0 = u.pn * BM + wc * 32 + 4 * fq;
        const float* gp = gate + (size_t)(u.pm >> 3) * NADA + col0;
        f32x4 gv[2][2];
#pragma unroll
        for (int bj = 0; bj < 2; ++bj)
#pragma unroll
            for (int n = 0; n < 2; ++n) gv[bj][n] = *(const f32x4*)(gp + bj * HALF + n * 16);
#pragma unroll
        for (int ai = 0; ai < 2; ++ai)
#pragma unroll
            for (int m = 0; m < 4; ++m) { const size_t off = (size_t)(row0 + ai * HALF + m * 16) * DM + col0;
#pragma unroll
                for (int bj = 0; bj < 2; ++bj)
#pragma unroll
                    for (int n = 0; n < 2; ++n) { const f32x4 xv = *(const f32x4*)(xsrc + off + bj * HALF + n * 16);
                        *(f32x4*)(out + off + bj * HALF + n * 16) = xv + gv[bj][n] * acc[ai][bj][m][n]; }
                if (m & 1) asm volatile("" ::: "memory"); }
    }
};

struct EpiProjNorm {
    static constexpr bool PERM = true, PERM_A = false;
    bf16_t* O; int ldc; const fx64* ssq; const fx64* bias; int ldb;
    __device__ __forceinline__ void operator()(const f32x4 (&acc)[2][2][4][2], const Unit& u, int wr, int wc, int fr, int fq) const {
        const int row0 = u.pm * BM + wr * 64 + fr, col0 = u.pn * BM + wc * 32 + 8 * fq;
        const fx64* bp = bias + (size_t)(u.pm >> 3) * ldb + col0;
        f32x4 bv[2][2];
#pragma unroll
        for (int bj = 0; bj < 2; ++bj)
#pragma unroll
            for (int n = 0; n < 2; ++n)
#pragma unroll
                for (int e = 0; e < 4; ++e) bv[bj][n][e] = (float)bp[bj * HALF + 4 * n + e] * FX_BIAS_INV;
#pragma unroll
        for (int ai = 0; ai < 2; ++ai)
#pragma unroll
            for (int m = 0; m < 4; ++m) { const int row = row0 + ai * HALF + m * 16; bf16_t* rowp = O + (size_t)row * ldc + col0;
                const float rs = fast_rsq((float)ssq[row] * (FX_SSQ_INV / DM) + EPS);
#pragma unroll
                for (int bj = 0; bj < 2; ++bj) { const f32x4 v0 = acc[ai][bj][m][0] * rs + bv[bj][0], v1 = acc[ai][bj][m][1] * rs + bv[bj][1];
                    u32x4 w; w.x = cvt_pk_bf16(v0[0], v0[1]); w.y = cvt_pk_bf16(v0[2], v0[3]); w.z = cvt_pk_bf16(v1[0], v1[1]); w.w = cvt_pk_bf16(v1[2], v1[3]);
                    *(u32x4*)(rowp + bj * HALF) = w; } }
    }
};
struct EpiResidNorm {
    static constexpr bool PERM = false, PERM_A = false;
    const float* xsrc; float* out; const float* gate;
    const float* gn; const float* scn; bf16_t* hn; fx64* ssq;
    __device__ __forceinline__ void operator()(const f32x4 (&acc)[2][2][4][2], const Unit& u, int wr, int wc, int fr, int fq) const {
        const int row0 = u.pm * BM + wr * 64 + fr, col0 = u.pn * BM + wc * 32 + 4 * fq;
        const float* gp = gate + (size_t)(u.pm >> 3) * NADA + col0;
        f32x4 gv[2][2], gs[2][2];
#pragma unroll
        for (int bj = 0; bj < 2; ++bj)
#pragma unroll
            for (int n = 0; n < 2; ++n) { gv[bj][n] = *(const f32x4*)(gp + bj * HALF + n * 16);
                gs[bj][n] = hn ? *(const f32x4*)(gn + col0 + bj * HALF + n * 16) * (*(const f32x4*)(scn + (size_t)(u.pm >> 3) * NADA + col0 + bj * HALF + n * 16) + 1.0f) : (f32x4){0.f, 0.f, 0.f, 0.f}; }
#pragma unroll
        for (int ai = 0; ai < 2; ++ai)
#pragma unroll
            for (int m = 0; m < 4; ++m) { const int row = row0 + ai * HALF + m * 16; const size_t off = (size_t)row * DM + col0;
                float sq = 0.f;
#pragma unroll
                for (int bj = 0; bj < 2; ++bj)
#pragma unroll
                    for (int n = 0; n < 2; ++n) { const f32x4 xv = *(const f32x4*)(xsrc + off + bj * HALF + n * 16);
                        const f32x4 o = xv + gv[bj][n] * acc[ai][bj][m][n];
                        *(f32x4*)(out + off + bj * HALF + n * 16) = o;
                        if (hn) { sq += o[0] * o[0] + o[1] * o[1] + o[2] * o[2] + o[3] * o[3];
                            const f32x4 hv = o * gs[bj][n]; u32x2 w; w.x = cvt_pk_bf16(hv[0], hv[1]); w.y = cvt_pk_bf16(hv[2], hv[3]);
                            *(u32x2*)(hn + off + bj * HALF + n * 16) = w; } }
                if (hn) { sq += swz_xor<16>(sq); sq = pair32_sum(sq);
                    if (fq == 0) fx_add(ssq + row, (double)sq * (double)FX_SSQ); }
                if (m & 1) asm volatile("" ::: "memory"); }
    }
};

template <int CTRL> __device__ __forceinline__ float dpp_old_f(float oldv, float v) { return __int_as_float(__builtin_amdgcn_update_dpp(__float_as_int(oldv), __float_as_int(v), CTRL, 0xf, 0xf, false)); }
struct EpiUpConv {
    static constexpr bool PERM = true, PERM_A = true;
    const float* wconv; const float* bconv; bf16_t* act; float* uhead; float* utail; LAS float* xb; const fx64* ssq; const fx64* bias;
    __device__ __forceinline__ static int xidx(int ai, int rr, int wr, int wc, int bj, int n, int fq) { return ((((((ai * 2 + rr) * 2 + wr) * 4 + wc) * 2 + bj) * 2 + n) * 4 + fq) * 4; }
    __device__ __forceinline__ void operator()(f32x4 (&acc)[2][2][4][2], const Unit& u, int wr, int wc, int fr, int fq) const {
        const int colp = u.pn * BM + wc * 32 + 8 * fq;
        const int ch0 = u.pn * HALF + wc * 32 + 8 * fq;
        {
            const fx64* bp = bias + (size_t)(u.pm >> 3) * NUP + colp;
            f32x4 rs[2];
#pragma unroll
            for (int ai = 0; ai < 2; ++ai) { const fx64* qp = ssq + u.pm * BM + ai * HALF + wr * 64 + 4 * fr;
#pragma unroll
                for (int m = 0; m < 4; ++m) rs[ai][m] = fast_rsq((float)qp[m] * (FX_SSQ_INV / DM) + EPS); }
#pragma unroll
            for (int bj = 0; bj < 2; ++bj)
#pragma unroll
                for (int n = 0; n < 2; ++n) { f32x4 bv;
#pragma unroll
                    for (int e = 0; e < 4; ++e) bv[e] = (float)bp[bj * HALF + 4 * n + e] * FX_BIAS_INV;
#pragma unroll
                    for (int ai = 0; ai < 2; ++ai)
#pragma unroll
                        for (int m = 0; m < 4; ++m) acc[ai][bj][m][n] = acc[ai][bj][m][n] * rs[ai][m] + bv; }
        }
        if (fr == 15) {
#pragma unroll
            for (int ai = 0; ai < 2; ++ai)
#pragma unroll
                for (int bj = 0; bj < 2; ++bj)
#pragma unroll
                    for (int n = 0; n < 2; ++n) { *(LAS f32x4*)(xb + xidx(ai, 0, wr, wc, bj, n, fq)) = acc[ai][bj][2][n]; *(LAS f32x4*)(xb + xidx(ai, 1, wr, wc, bj, n, fq)) = acc[ai][bj][3][n]; }
            if (wr == 1) {
#pragma unroll
                for (int bj = 0; bj < 2; ++bj)
#pragma unroll
                    for (int n = 0; n < 2; ++n) { *(f32x4*)(utail + (size_t)(u.pm * 2 + 0) * NUP + colp + bj * HALF + 4 * n) = acc[1][bj][2][n]; *(f32x4*)(utail + (size_t)(u.pm * 2 + 1) * NUP + colp + bj * HALF + 4 * n) = acc[1][bj][3][n]; }
            }
        }
        if (fr == 0 && wr == 0) {
#pragma unroll
            for (int bj = 0; bj < 2; ++bj)
#pragma unroll
                for (int n = 0; n < 2; ++n) { *(f32x4*)(uhead + (size_t)(u.pm * 2 + 0) * NUP + colp + bj * HALF + 4 * n) = acc[0][bj][0][n]; *(f32x4*)(uhead + (size_t)(u.pm * 2 + 1) * NUP + colp + bj * HALF + 4 * n) = acc[0][bj][1][n]; }
        }
        asm volatile("s_waitcnt lgkmcnt(0)" ::: "memory"); __builtin_amdgcn_s_barrier(); asm volatile("" ::: "memory");
        const bool skip01 = (wr == 0) && (fr == 0) && ((u.pm & 7) != 0);
#pragma unroll
        for (int n = 0; n < 2; ++n) {
#pragma unroll
            for (int ai = 0; ai < 2; ++ai) {
                f32x4 cg[4];
#pragma unroll
                for (int bj = 0; bj < 2; ++bj) {
                    const int cw = ch0 + 4 * n + bj * DFF;
                    const f32x4 w0 = *(const f32x4*)(wconv + cw), w1 = *(const f32x4*)(wconv + (size_t)NUP + cw), w2 = *(const f32x4*)(wconv + (size_t)2 * NUP + cw), bb = *(const f32x4*)(bconv + cw);
                    f32x4 p1 = (f32x4){0.f, 0.f, 0.f, 0.f}, p2 = p1;
                    if (wr == 1 || ai == 1) {
                        const int sai = (wr == 1) ? ai : 0, swr = (wr == 1) ? 0 : 1;
                        p2 = *(const LAS f32x4*)(xb + xidx(sai, 0, swr, wc, bj, n, fq)); p1 = *(const LAS f32x4*)(xb + xidx(sai, 1, swr, wc, bj, n, fq));
                    }
                    const f32x4 v0 = acc[ai][bj][0][n], v1 = acc[ai][bj][1][n], v2 = acc[ai][bj][2][n], v3 = acc[ai][bj][3][n];
                    f32x4 s3, s2;
#pragma unroll
                    for (int e = 0; e < 4; ++e) { s3[e] = dpp_old_f<0x111>(p1[e], v3[e]); s2[e] = dpp_old_f<0x111>(p2[e], v2[e]); }
#pragma unroll
                    for (int m = 0; m < 4; ++m) {
                        const f32x4 v = (m == 0) ? v0 : (m == 1) ? v1 : (m == 2) ? v2 : v3;
                        const f32x4 q1 = (m == 0) ? s3 : (m == 1) ? v0 : (m == 2) ? v1 : v2;
                        const f32x4 q2 = (m == 0) ? s2 : (m == 1) ? s3 : (m == 2) ? v0 : v1;
                        const f32x4 cvv = bb + w0 * q2 + w1 * q1 + w2 * v;
                        if (bj == 0) cg[m] = cvv;
                        else {
                            float o[4];
#pragma unroll
                            for (int e = 0; e < 4; ++e) { const float g = cg[m][e]; o[e] = g * sigmoidf_(g) * cvv[e]; }
                            u32x2 ow; ow.x = cvt_pk_bf16(o[0], o[1]); ow.y = cvt_pk_bf16(o[2], o[3]);
                            const int row = u.pm * BM + ai * HALF + wr * 64 + 4 * fr + m;
                            if (!(skip01 && ai == 0 && m < 2)) *(u32x2*)(act + (size_t)row * DFF + ch0 + 4 * n) = ow;
                        }
                    }
                    asm volatile("" ::: "memory");
                }
            }
        }
    }
};
}

struct Args { const void* in[23]; float* out; unsigned char* ws; float inv_a[16]; float inv_i[8]; float inv_m[32]; int ph_lo, ph_hi; };
static_assert(sizeof(Args) == 23 * 8 + 16 + 56 * 4 + 8, "Args has no padding");

typedef const __attribute__((address_space(4))) struct Args* ArgsCP;
struct Frame {
    LAS unsigned char* lds; int tid, lane, wave, G, bid;
    unsigned char* ws; ArgsCP a;
};

__device__ __forceinline__ void sincos_d(double a, float& s, float& c) {
    const double q = __builtin_rint(a * 0.63661977236758134308);
    double r = __builtin_fma(-q, 1.57079632673412561417e+00, a);
    r = __builtin_fma(-q, 6.07710050650619224932e-11, r);
    const double r2 = r * r;
    double sp = -7.6471637318198164759e-13; sp = sp * r2 + 1.6059043836821614599e-10; sp = sp * r2 - 2.5052108385441718775e-08; sp = sp * r2 + 2.7557319223985890653e-06;
    sp = sp * r2 - 1.9841269841269841270e-04; sp = sp * r2 + 8.3333333333333333333e-03; sp = sp * r2 - 1.6666666666666666667e-01; const double sr = r + r * r2 * sp;
    double cp = 4.7794773323873852974e-14; cp = cp * r2 - 1.1470745597729724714e-11; cp = cp * r2 + 2.0876756987868098979e-09; cp = cp * r2 - 2.7557319223985890653e-07;
    cp = cp * r2 + 2.4801587301587301587e-05; cp = cp * r2 - 1.3888888888888888889e-03; cp = cp * r2 + 4.1666666666666666667e-02; cp = cp * r2 - 0.5; const double cr = 1.0 + r2 * cp;
    const int qi = ((int)q) & 3;
    const double sv = (qi == 0) ? sr : (qi == 1) ? cr : (qi == 2) ? -sr : -cr;
    const double cv = (qi == 0) ? cr : (qi == 1) ? -sr : (qi == 2) ? -cr : sr;
    s = (float)sv; c = (float)cv;
}

__device__ __forceinline__ int cmap_in(int n) {
    if (n < 2640) return n;
    if (n < 2704) return 3408 + (n - 2640);
    if (n < 2816) return -1;
    if (n < 3328) return 2640 + (n - 2816);
    if (n < 3584) return 3152 + (n - 3328);
    return 3472 + (n - 3584);
}
__device__ __forceinline__ int cmap_up(int n) { const int j = n >> 8, w = n & 255; return (w < 128) ? (128 * j + w) : (DFF + 128 * j + (w - 128)); }

template <int MODE, bool BIAS>
__device__ __forceinline__ void transpose_tile(const Frame& F, const float* src, int ldsrc, int K, bf16_t* dst, int k0, int n0, const float* shift  , fx64* bias, int ldbias) {
    LAS float* T = (LAS float*)F.lds;
    LAS float* SH = (LAS float*)(F.lds + 69632);
    LAS float* RED = (LAS float*)(F.lds + 73728);
    f32x4 v[8];
#pragma unroll
    for (int i = 0; i < 8; ++i) { const int idx = F.tid + 512 * i, kk = idx >> 5, n4 = idx & 31; const int n = n0 + 4 * n4;
        const int c = (MODE == 0) ? n : (MODE == 1) ? cmap_in(n) : cmap_up(n);
        v[i] = (c >= 0) ? *(const f32x4*)(src + (size_t)(k0 + kk) * ldsrc + c) : (f32x4){0.f, 0.f, 0.f, 0.f}; }
    float shv = 0.f;
    if (BIAS) shv = shift[(size_t)(F.tid >> 7) * NADA + k0 + (F.tid & 127)];
    __syncthreads();
#pragma unroll
    for (int i = 0; i < 8; ++i) { const int idx = F.tid + 512 * i, kk = idx >> 5, n4 = idx & 31; *(LAS f32x4*)(T + kk * 132 + 4 * n4) = v[i]; }
    if (BIAS) SH[F.tid] = shv;
    __syncthreads();
    const int n = F.tid & 127, kq = F.tid >> 7;
    bf16_t* dp = dst + (size_t)(n0 + n) * K + k0 + kq * 32;
    float pb[4] = {0.f, 0.f, 0.f, 0.f};
#pragma unroll
    for (int j = 0; j < 4; ++j) { float e[8];
#pragma unroll
        for (int i = 0; i < 8; ++i) e[i] = T[(kq * 32 + j * 8 + i) * 132 + n];
        if (BIAS) {
#pragma unroll
            for (int i = 0; i < 8; ++i)
#pragma unroll
                for (int b = 0; b < 4; ++b) pb[b] += e[i] * SH[b * 128 + kq * 32 + j * 8 + i]; }
        u32x4 w; w.x = cvt_pk_bf16(e[0], e[1]); w.y = cvt_pk_bf16(e[2], e[3]); w.z = cvt_pk_bf16(e[4], e[5]); w.w = cvt_pk_bf16(e[6], e[7]);
        *(u32x4*)(dp + j * 8) = w; }
    if (BIAS) {
#pragma unroll
        for (int b = 0; b < 4; ++b) RED[(kq * 4 + b) * 128 + n] = pb[b];
        __syncthreads();
        const int b = F.tid >> 7;
        const float sum = RED[(0 * 4 + b) * 128 + n] + RED[(1 * 4 + b) * 128 + n] + RED[(2 * 4 + b) * 128 + n] + RED[(3 * 4 + b) * 128 + n];
        fx_add(bias + (size_t)b * ldbias + n0 + n, (double)sum * FX_BIAS);
    }
}

__device__ __forceinline__ void p0a_prologue(const Frame& F) {
    ArgsCP ap = F.a;
    unsigned char* ws = F.ws;
    {
        LAS float* CAct = (LAS float*)F.lds;
        LAS float* RED = (LAS float*)(F.lds + 32768);
        const float* c = (const float*)ap->in[1];
        for (int i = F.tid; i < NBATCH * DM; i += 512) { const float x = c[i]; CAct[i] = x * sigmoidf_(x); }
        __syncthreads();
        const float* w_ada = (const float*)ap->in[5]; const float* b_ada = (const float*)ap->in[6];
        float* mod = (float*)(ws + WS_MOD);
        const int rg = F.lane >> 4, cq = F.lane & 15;
        for (int it = F.bid; it < DEPTH * (NADA / 64); it += F.G) {
            const int l = it / (NADA / 64), n0 = (it % (NADA / 64)) * 64;
            const float* wp = w_ada + (size_t)l * DM * NADA + n0 + 4 * cq;
            const int kb = F.wave * 256 + rg * 64;
            f32x4 acc[4];
#pragma unroll
            for (int b = 0; b < 4; ++b) acc[b] = (f32x4){0.f, 0.f, 0.f, 0.f};
            for (int i0 = 0; i0 < 64; i0 += 16) {
                f32x4 wv[16];
#pragma unroll
                for (int i = 0; i < 16; ++i) wv[i] = *(const f32x4*)(wp + (size_t)(kb + i0 + i) * NADA);
#pragma unroll
                for (int i = 0; i < 16; ++i) {
#pragma unroll
                    for (int b = 0; b < 4; ++b) acc[b] += CAct[b * DM + kb + i0 + i] * wv[i]; }
            }
#pragma unroll
            for (int b = 0; b < 4; ++b)
#pragma unroll
                for (int j = 0; j < 4; ++j) { float v = acc[b][j]; v += swz_xor<16>(v); v = pair32_sum(v); acc[b][j] = v; }
            if (rg == 0) {
#pragma unroll
                for (int b = 0; b < 4; ++b) *(LAS f32x4*)(RED + (F.wave * 4 + b) * 64 + 4 * cq) = acc[b]; }
            __syncthreads();
            if (F.tid < 256) { const int b = F.tid >> 6, col = F.tid & 63; float s = b_ada[(size_t)l * NADA + n0 + col];
#pragma unroll
                for (int w = 0; w < 8; ++w) s += RED[(w * 4 + b) * 64 + col];
                mod[((size_t)l * NBATCH + b) * NADA + n0 + col] = s; }
            __syncthreads();
        }
    }
    {
        const int* pos = (const int*)ap->in[2];
        float* CA = (float*)(ws + WS_ROPE); float* SA = CA + MROWS * 16; float* CI = SA + MROWS * 16; float* SI = CI + MROWS * 8; float* CM = SI + MROWS * 8; float* SM = CM + MROWS * 32;
        for (int i = F.bid * 512 + F.tid; i < MROWS * 56; i += F.G * 512) {
            const int r = i / 56, j = i % 56;
            const float p = (float)pos[r];
            float inv; float* cd; float* sd;
            if (j < 16) { inv = ap->inv_a[j]; cd = CA + r * 16 + j; sd = SA + r * 16 + j; }
            else if (j < 24) { inv = ap->inv_i[j - 16]; cd = CI + r * 8 + (j - 16); sd = SI + r * 8 + (j - 16); }
            else { inv = ap->inv_m[j - 24]; cd = CM + r * 32 + (j - 24); sd = SM + r * 32 + (j - 24); }
            const float ang = p * inv;
            float s, c; sincos_d((double)ang, s, c);
            *cd = c; *sd = s;
        }
    }
}

__device__ __forceinline__ void p0b_prologue(const Frame& F) {
    ArgsCP ap = F.a;
    unsigned char* ws = F.ws;
    const float* mod = (const float*)(ws + WS_MOD);
    {
        const float* x = (const float*)ap->in[0]; const float* g = (const float*)ap->in[3];
        bf16_t* h = (bf16_t*)(ws + WS_H); fx64* ssq = (fx64*)(ws + WS_SSQ);
        const int stride = F.G * 8;
        for (int row0 = F.bid * 8 + F.wave; row0 < MROWS; row0 += 4 * stride) {
            f32x4 v[4][8];
#pragma unroll
            for (int k = 0; k < 4; ++k) { const int row = row0 + k * stride;
                if (row < MROWS) {
#pragma unroll
                    for (int i = 0; i < 8; ++i) v[k][i] = *(const f32x4*)(x + (size_t)row * DM + (i * 64 + F.lane) * 4); } }
#pragma unroll
            for (int k = 0; k < 4; ++k) { const int row = row0 + k * stride;
                if (row < MROWS) {
                    float ss = 0.f;
#pragma unroll
                    for (int i = 0; i < 8; ++i) ss += v[k][i][0] * v[k][i][0] + v[k][i][1] * v[k][i][1] + v[k][i][2] * v[k][i][2] + v[k][i][3] * v[k][i][3];
                    ss = wave_sum(ss);
                    if (F.lane == 0) ssq[row] = (fx64)__builtin_rint((double)ss * (double)FX_SSQ);
                    const float* mp = mod + (size_t)(row >> 11) * NADA + DM;
#pragma unroll
                    for (int i = 0; i < 8; ++i) { const int c = (i * 64 + F.lane) * 4;
                        const f32x4 y = v[k][i] * (*(const f32x4*)(g + c)) * (*(const f32x4*)(mp + c) + 1.0f);
                        u32x2 w; w.x = cvt_pk_bf16(y[0], y[1]); w.y = cvt_pk_bf16(y[2], y[3]);
                        *(u32x2*)(h + (size_t)row * DM + c) = w; }
                } }
        }
    }
    {
        constexpr int T_IN = 960, T_MQ = 48, T_MKV = 32, T_PA = 128, T_PB = 128, T_WO = 256, T_UP = 1408, T_DN = 704;
        constexpr int C1 = T_IN, C2 = C1 + T_MQ, C3 = C2 + T_MKV, C4 = C3 + T_PA, C5 = C4 + T_PB, C6 = C5 + T_WO, C7 = C6 + T_UP, C8 = C7 + T_DN;
        fx64* bias_in = (fx64*)(ws + WS_BIAS); fx64* bias_up = (fx64*)(ws + WS_BIAS_UP);
        for (int it = F.bid; it < DEPTH * C8; it += F.G) {
            const int l = it / C8, r = it % C8;
            const float* modl = mod + (size_t)l * NBATCH * NADA;
            if (r < C1) { const int ti = r; transpose_tile<1, true>(F, (const float*)ap->in[7] + (size_t)l * DM * IN_DIM, IN_DIM, DM, (bf16_t*)(ws + WS_WIN) + (size_t)l * NPROJ * DM, (ti / 60) * 128, (ti % 60) * 128, modl, bias_in + (size_t)l * NBATCH * NPROJ, NPROJ); }
            else if (r < C2) { const int ti = r - C1; transpose_tile<0, false>(F, (const float*)ap->in[11] + (size_t)l * 512 * 1536, 1536, 512, (bf16_t*)(ws + WS_WMQ) + (size_t)l * 1536 * 512, (ti / 12) * 128, (ti % 12) * 128, nullptr, nullptr, 0); }
            else if (r < C3) { const int ti = r - C2; transpose_tile<0, false>(F, (const float*)ap->in[13] + (size_t)l * 256 * 2048, 2048, 256, (bf16_t*)(ws + WS_WMKV) + (size_t)l * 2048 * 256, (ti / 16) * 128, (ti % 16) * 128, nullptr, nullptr, 0); }
            else if (r < C4) { const int ti = r - C3; transpose_tile<0, false>(F, (const float*)ap->in[16] + (size_t)l * 1024 * 2048, 2048, 1024, (bf16_t*)(ws + WS_WPAB) + (size_t)l * 4096 * 1024, (ti / 16) * 128, (ti % 16) * 128, nullptr, nullptr, 0); }
            else if (r < C5) { const int ti = r - C4; transpose_tile<0, false>(F, (const float*)ap->in[17] + (size_t)l * 1024 * 2048, 2048, 1024, (bf16_t*)(ws + WS_WPAB) + (size_t)l * 4096 * 1024 + (size_t)2048 * 1024, (ti / 16) * 128, (ti % 16) * 128, nullptr, nullptr, 0); }
            else if (r < C6) { const int ti = r - C5; transpose_tile<0, false>(F, (const float*)ap->in[18] + (size_t)l * 2048 * 2048, 2048, 2048, (bf16_t*)(ws + WS_WO) + (size_t)l * 2048 * 2048, (ti / 16) * 128, (ti % 16) * 128, nullptr, nullptr, 0); }
            else if (r < C7) { const int ti = r - C6; transpose_tile<2, true>(F, (const float*)ap->in[19] + (size_t)l * DM * NUP, NUP, DM, (bf16_t*)(ws + WS_WUP) + (size_t)l * NUP * DM, (ti / 88) * 128, (ti % 88) * 128, modl + 3 * DM, bias_up + (size_t)l * NBATCH * NUP, NUP); }
            else { const int ti = r - C7; transpose_tile<0, false>(F, (const float*)ap->in[22] + (size_t)l * DFF * DM, DM, DFF, (bf16_t*)(ws + WS_WDN) + (size_t)l * DM * DFF, (ti / 16) * 128, (ti % 16) * 128, nullptr, nullptr, 0); }
        }
        __syncthreads();
    }
}

__device__ __forceinline__ void phase_norm(const Frame& F, const float* x, const float* g, const float* modl  , int sh_off, int sc_off, bf16_t* h) {
    const int stride = F.G * 8;
    for (int row0 = F.bid * 8 + F.wave; row0 < MROWS; row0 += 4 * stride) {
        f32x4 v[4][8];
#pragma unroll
        for (int k = 0; k < 4; ++k) { const int row = row0 + k * stride;
            if (row < MROWS) {
#pragma unroll
                for (int i = 0; i < 8; ++i) v[k][i] = *(const f32x4*)(x + (size_t)row * DM + (i * 64 + F.lane) * 4); } }
#pragma unroll
        for (int k = 0; k < 4; ++k) { const int row = row0 + k * stride;
            if (row < MROWS) {
                const int b = row >> 11;
                float ss = 0.f;
#pragma unroll
                for (int i = 0; i < 8; ++i) ss += v[k][i][0] * v[k][i][0] + v[k][i][1] * v[k][i][1] + v[k][i][2] * v[k][i][2] + v[k][i][3] * v[k][i][3];
                ss = wave_sum(ss);
                const float rs = fast_rsq(ss * (1.0f / DM) + EPS);
                const float* mp = modl + (size_t)b * NADA;
#pragma unroll
                for (int i = 0; i < 8; ++i) { const int c = (i * 64 + F.lane) * 4;
                    const f32x4 gv = *(const f32x4*)(g + c), sc = *(const f32x4*)(mp + sc_off + c), sh = *(const f32x4*)(mp + sh_off + c);
                    const f32x4 y = (v[k][i] * rs) * gv * (sc + 1.0f) + sh;
                    u32x2 w; w.x = cvt_pk_bf16(y[0], y[1]); w.y = cvt_pk_bf16(y[2], y[3]);
                    *(u32x2*)(h + (size_t)row * DM + c) = w; }
            } }
    }
}

__device__ __forceinline__ void vt_tile(const Frame& F, const bf16_t* src  , int lds_, bf16_t* dst  ) {
    LAS bf16_t* T = (LAS bf16_t*)F.lds;
    const int sl = F.tid >> 3, dq = F.tid & 7;
    const u32x4 a0 = *(const u32x4*)(src + (size_t)sl * lds_ + dq * 16), a1 = *(const u32x4*)(src + (size_t)sl * lds_ + dq * 16 + 8);
    __syncthreads();
    *(LAS u32x4*)(T + sl * 136 + dq * 16) = a0; *(LAS u32x4*)(T + sl * 136 + dq * 16 + 8) = a1;
    __syncthreads();
    const int d = F.tid >> 2, sq = F.tid & 3;
    unsigned w[8];
#pragma unroll
    for (int i = 0; i < 8; ++i) { const int p = 2 * i, sa = (p & 3) | ((p & 4) << 1) | ((p & 8) >> 1);
        const unsigned lo = T[(sq * 16 + sa) * 136 + d], hi = T[(sq * 16 + sa + 1) * 136 + d]; w[i] = lo | (hi << 16); }
    bf16_t* dp = dst + (size_t)d * SEQ + sq * 16;
    *(u32x4*)dp = (u32x4){w[0], w[1], w[2], w[3]}; *(u32x4*)(dp + 8) = (u32x4){w[4], w[5], w[6], w[7]};
}

__device__ __forceinline__ void phase_post1(const Frame& F, int l) {
    ArgsCP ap = F.a; unsigned char* ws = F.ws;
    const bf16_t* proj = (const bf16_t*)(ws + WS_PROJ);
    bf16_t* QA = (bf16_t*)(ws + WS_QA); bf16_t* KA = (bf16_t*)(ws + WS_KA); bf16_t* QI = (bf16_t*)(ws + WS_QI); bf16_t* KI = (bf16_t*)(ws + WS_KI);
    float* WI = (float*)(ws + WS_WI); bf16_t* MQL = (bf16_t*)(ws + WS_MQL); bf16_t* MKVL = (bf16_t*)(ws + WS_MKVL);
    const float* CA = (const float*)(ws + WS_ROPE); const float* SA = CA + MROWS * 16; const float* CI = SA + MROWS * 16; const float* SI = CI + MROWS * 8;
    const float* g_qa = (const float*)ap->in[8] + l * 128; const float* g_ka = (const float*)ap->in[9] + l * 128;
    const float* g_mq = (const float*)ap->in[10] + l * 512; const float* g_mkv = (const float*)ap->in[12] + l * 256;
    const int L = F.lane;
    const float qscale = 0.08838834764831845f * LOG2E;
#pragma unroll 2
    for (int r = F.bid * 8 + F.wave; r < MROWS; r += F.G * 8) {
        const bf16_t* p = proj + (size_t)r * NPROJ;
        const float gq0 = g_qa[2 * L], gq1 = g_qa[2 * L + 1], gk0 = g_ka[2 * L], gk1 = g_ka[2 * L + 1];
        float c0 = 0.f, c1 = 0.f, s0 = 0.f, s1 = 0.f;
        if (L < 16) { const int dd = 2 * (L & 7); c0 = CA[r * 16 + dd]; c1 = CA[r * 16 + dd + 1]; s0 = SA[r * 16 + dd]; s1 = SA[r * 16 + dd + 1]; }
#pragma unroll
        for (int hh = 0; hh < 10; ++hh) {
            const unsigned w = *(const unsigned*)(p + hh * 128 + 2 * L);
            const float a0 = bf_lo(w), a1 = bf_hi(w);
            const float ss = wave_sum(a0 * a0 + a1 * a1);
            const float rs = fast_rsq(ss * (1.0f / 128.0f) + EPS);
            float y0 = a0 * rs * (hh < 8 ? gq0 : gk0), y1 = a1 * rs * (hh < 8 ? gq1 : gk1);
            const float o0 = swz_xor<8>(y0), o1 = swz_xor<8>(y1);
            if (L < 8) { y0 = y0 * c0 - o0 * s0; y1 = y1 * c1 - o1 * s1; }
            else if (L < 16) { y0 = y0 * c0 + o0 * s0; y1 = y1 * c1 + o1 * s1; }
            if (hh < 8) *(unsigned*)(QA + (size_t)r * 1024 + hh * 128 + 2 * L) = cvt_pk_bf16(y0 * qscale, y1 * qscale);
            else *(unsigned*)(KA + (size_t)r * 256 + (hh - 8) * 128 + 2 * L) = cvt_pk_bf16(y0, y1);
        }
        {
            const int Lh = L & 31;
            float ci0 = 0.f, ci1 = 0.f, si0 = 0.f, si1 = 0.f;
            if (Lh < 8) { const int dd = 2 * (Lh & 3); ci0 = CI[r * 8 + dd]; ci1 = CI[r * 8 + dd + 1]; si0 = SI[r * 8 + dd]; si1 = SI[r * 8 + dd + 1]; }
#pragma unroll
            for (int ch = 0; ch < 9; ++ch) {
                unsigned w = 0u;
                if (ch < 8 || L < 32) w = *(const unsigned*)(p + PC_QI + ch * 128 + 2 * L);
                float y0 = bf_lo(w), y1 = bf_hi(w);
                const float o0 = swz_xor<4>(y0), o1 = swz_xor<4>(y1);
                if (Lh < 4) { y0 = y0 * ci0 - o0 * si0; y1 = y1 * ci1 - o1 * si1; }
                else if (Lh < 8) { y0 = y0 * ci0 + o0 * si0; y1 = y1 * ci1 + o1 * si1; }
                if (ch < 8) *(unsigned*)(QI + (size_t)r * 1024 + ch * 128 + 2 * L) = cvt_pk_bf16(y0, y1);
                else if (L < 32) *(unsigned*)(KI + (size_t)r * 64 + 2 * L) = cvt_pk_bf16(y0, y1);
            }
        }
        if (L < 16) WI[(size_t)r * 16 + L] = bf1(p[PC_WI + L]) * 0.03125f;
        {
            const u32x4 w = *(const u32x4*)(p + PC_MQL + 8 * L);
            float e[8] = {bf_lo(w.x), bf_hi(w.x), bf_lo(w.y), bf_hi(w.y), bf_lo(w.z), bf_hi(w.z), bf_lo(w.w), bf_hi(w.w)};
            float ss = 0.f;
#pragma unroll
            for (int j = 0; j < 8; ++j) ss += e[j] * e[j];
            ss = wave_sum(ss);
            const float rs = fast_rsq(ss * (1.0f / 512.0f) + EPS);
            const f32x4 g0 = *(const f32x4*)(g_mq + 8 * L), g1 = *(const f32x4*)(g_mq + 8 * L + 4);
            u32x4 o; o.x = cvt_pk_bf16(e[0] * rs * g0[0], e[1] * rs * g0[1]); o.y = cvt_pk_bf16(e[2] * rs * g0[2], e[3] * rs * g0[3]);
            o.z = cvt_pk_bf16(e[4] * rs * g1[0], e[5] * rs * g1[1]); o.w = cvt_pk_bf16(e[6] * rs * g1[2], e[7] * rs * g1[3]);
            *(u32x4*)(MQL + (size_t)r * 512 + 8 * L) = o;
        }
        {
            const u32x2 w = *(const u32x2*)(p + PC_MKVL + 4 * L);
            float e[4] = {bf_lo(w.x), bf_hi(w.x), bf_lo(w.y), bf_hi(w.y)};
            float ss = wave_sum(e[0] * e[0] + e[1] * e[1] + e[2] * e[2] + e[3] * e[3]);
            const float rs = fast_rsq(ss * (1.0f / 256.0f) + EPS);
            const f32x4 g0 = *(const f32x4*)(g_mkv + 4 * L);
            u32x2 o; o.x = cvt_pk_bf16(e[0] * rs * g0[0], e[1] * rs * g0[1]); o.y = cvt_pk_bf16(e[2] * rs * g0[2], e[3] * rs * g0[3]);
            *(u32x2*)(MKVL + (size_t)r * 256 + 4 * L) = o;
        }
    }
    bf16_t* VAT = (bf16_t*)(ws + WS_VAT);
    for (int it = F.bid; it < NBATCH * 2 * (SEQ / 64); it += F.G) {
        const int sb = it % (SEQ / 64), g = (it / (SEQ / 64)) & 1, b = it / (2 * (SEQ / 64));
        vt_tile(F, proj + (size_t)(b * SEQ + sb * 64) * NPROJ + PC_VA + g * 128, NPROJ, VAT + (size_t)(b * 2 + g) * 128 * SEQ + sb * 64);
    }
    __syncthreads();
}

__device__ __forceinline__ void phase_post2(const Frame& F, int l) {
    ArgsCP ap = F.a; unsigned char* ws = F.ws;
    const bf16_t* proj = (const bf16_t*)(ws + WS_PROJ); const bf16_t* MQ = (const bf16_t*)(ws + WS_MQ); const bf16_t* MKV = (const bf16_t*)(ws + WS_MKV);
    bf16_t* QM = (bf16_t*)(ws + WS_QM); bf16_t* KM = (bf16_t*)(ws + WS_KM);
    const float* CM = (const float*)(ws + WS_ROPE) + MROWS * 48; const float* SM = CM + MROWS * 32;
    const float* g_qm = (const float*)ap->in[14] + l * 192; const float* g_km = (const float*)ap->in[15] + l * 192;
    const int L = F.lane;
    const float qscale = 0.07216878364870322f * LOG2E;
    const float gq0 = g_qm[L], gq1 = g_qm[64 + L], gq2 = g_qm[128 + L], gk0 = g_km[L], gk1 = g_km[64 + L], gk2 = g_km[128 + L];
    for (int r = F.bid * 8 + F.wave; r < MROWS; r += F.G * 8) {
        const float cm = CM[r * 32 + (L & 31)], sm = SM[r * 32 + (L & 31)];
        const float kr = bf1(proj[(size_t)r * NPROJ + PC_MKR + L]);
#pragma unroll
        for (int h = 0; h < 8; ++h) {
            {
                const bf16_t* qp = MQ + (size_t)r * 1536 + h * 192;
                const float e0 = bf1(qp[L]), e1 = bf1(qp[64 + L]), e2 = bf1(qp[128 + L]);
                const float ss = wave_sum(e0 * e0 + e1 * e1 + e2 * e2);
                const float rs = fast_rsq(ss * (1.0f / 192.0f) + EPS);
                const float y0 = e0 * rs * gq0, y1 = e1 * rs * gq1; float y2 = e2 * rs * gq2;
                const float o2 = pair32_other(y2, L >= 32);
                y2 = (L < 32) ? (y2 * cm - o2 * sm) : (y2 * cm + o2 * sm);
                bf16_t* dp = QM + (size_t)r * 1536 + h * 192;
                dp[L] = (bf16_t)(cvt_pk_bf16(y0 * qscale, 0.f) & 0xffffu); dp[64 + L] = (bf16_t)(cvt_pk_bf16(y1 * qscale, 0.f) & 0xffffu); dp[128 + L] = (bf16_t)(cvt_pk_bf16(y2 * qscale, 0.f) & 0xffffu);
            }
            {
                const bf16_t* kp = MKV + (size_t)r * 2048 + h * 256;
                const float e0 = bf1(kp[L]), e1 = bf1(kp[64 + L]), e2 = kr;
                const float ss = wave_sum(e0 * e0 + e1 * e1 + e2 * e2);
                const float rs = fast_rsq(ss * (1.0f / 192.0f) + EPS);
                const float y0 = e0 * rs * gk0, y1 = e1 * rs * gk1; float y2 = e2 * rs * gk2;
                const float o2 = pair32_other(y2, L >= 32);
                y2 = (L < 32) ? (y2 * cm - o2 * sm) : (y2 * cm + o2 * sm);
                bf16_t* dp = KM + (size_t)r * 1536 + h * 192;
                dp[L] = (bf16_t)(cvt_pk_bf16(y0, 0.f) & 0xffffu); dp[64 + L] = (bf16_t)(cvt_pk_bf16(y1, 0.f) & 0xffffu); dp[128 + L] = (bf16_t)(cvt_pk_bf16(y2, 0.f) & 0xffffu);
            }
        }
    }
    bf16_t* VMT = (bf16_t*)(ws + WS_VMT);
    for (int it = F.bid; it < NBATCH * 8 * (SEQ / 64); it += F.G) {
        const int sb = it % (SEQ / 64), h = (it / (SEQ / 64)) & 7, b = it / (8 * (SEQ / 64));
        vt_tile(F, MKV + (size_t)(b * SEQ + sb * 64) * 2048 + h * 256 + 128, 2048, VMT + (size_t)(b * 8 + h) * 128 * SEQ + sb * 64);
    }
    __syncthreads();
}

constexpr int SC_STRIDE = 2052, RD = 4;
__device__ __forceinline__ void idx_unit(const Frame& F, int b, int tb) {
    unsigned char* ws = F.ws;
    const bf16_t* QI = (const bf16_t*)(ws + WS_QI); const bf16_t* KI = (const bf16_t*)(ws + WS_KI); const float* WI = (const float*)(ws + WS_WI);
    unsigned* MASK = (unsigned*)(ws + WS_MASK);
    LAS float* SC = (LAS float*)F.lds;
    const int L = F.lane, q = L & 15, hq = L >> 4;
    const int t0 = tb * 16; const size_t row0 = (size_t)b * SEQ + t0;
    __syncthreads();
    const int nkt = tb + 1;
    const bf16_t* kbase = KI + ((size_t)b * SEQ + q) * 64 + hq * 8;
    const int nmy = (nkt - F.wave + 7) >> 3;
#ifndef IDX_REP_SCORE
#define IDX_REP_SCORE 1
#endif
#ifndef IDX_REP_SEL
#define IDX_REP_SEL 1
#endif
#pragma unroll 1
    for (int hp = 0; hp < 2 * IDX_REP_SCORE; ++hp) {
        bf16x8 qf[8][2]; float wv[8];
#pragma unroll
        for (int hh = 0; hh < 8; ++hh) {
#pragma unroll
            for (int ks = 0; ks < 2; ++ks) qf[hh][ks] = *(const bf16x8*)(QI + (row0 + q) * 1024 + ((hp & 1) * 8 + hh) * 64 + ks * 32 + hq * 8);
            wv[hh] = WI[(row0 + q) * 16 + (hp & 1) * 8 + hh]; }
        bf16x8 kr[RD][2];
#pragma unroll
        for (int s8 = 0; s8 < RD; ++s8) { kr[s8][0] = (bf16x8){0, 0, 0, 0, 0, 0, 0, 0}; kr[s8][1] = kr[s8][0];
            if (s8 < nmy) { const bf16_t* kp = kbase + (size_t)(F.wave + 8 * s8) * 16 * 64; kr[s8][0] = *(const bf16x8*)kp; kr[s8][1] = *(const bf16x8*)(kp + 32); } }
#pragma unroll 1
        for (int base = 0; base < nmy; base += RD) {
#pragma unroll
            for (int s8 = 0; s8 < RD; ++s8) {
                const int i = base + s8;
                if (i < nmy) {
                    const int kt = F.wave + 8 * i;
                    const bf16x8 k0 = kr[s8][0], k1 = kr[s8][1];
                    if (i + RD < nmy) { const bf16_t* kp = kbase + (size_t)(kt + 8 * RD) * 16 * 64; kr[s8][0] = *(const bf16x8*)kp; kr[s8][1] = *(const bf16x8*)(kp + 32); }
                    f32x4 sc = (f32x4){0.f, 0.f, 0.f, 0.f};
#pragma unroll
                    for (int hh = 0; hh < 8; ++hh) {
                        f32x4 d = __builtin_amdgcn_mfma_f32_16x16x32_bf16(k0, qf[hh][0], (f32x4){0.f, 0.f, 0.f, 0.f}, 0, 0, 0);
                        d = __builtin_amdgcn_mfma_f32_16x16x32_bf16(k1, qf[hh][1], d, 0, 0, 0);
#pragma unroll
                        for (int j = 0; j < 4; ++j) { const int di = __float_as_int(d[j]); sc[j] = __builtin_fmaf(wv[hh], __int_as_float(di > 0 ? di : 0), sc[j]); }
                    }
                    LAS f32x4* sp = (LAS f32x4*)(SC + q * SC_STRIDE + kt * 16 + 4 * hq);
                    if (hp & 1) sc += *sp;
                    *sp = sc;
                }
            }
        }
    }
    __syncthreads();
#pragma unroll 1
    for (int qq = 0; qq < 2 * IDX_REP_SEL; ++qq) {
        const int qr = F.wave * 2 + (qq & 1), t = t0 + qr;
        unsigned key[32];
#pragma unroll
        for (int j = 0; j < 32; ++j) { const int s = j * 64 + L; unsigned u = __float_as_uint(SC[qr * SC_STRIDE + s]);
            u = (u & 0x80000000u) ? ~u : (u | 0x80000000u); key[j] = (s <= t) ? u : 0u; }
        unsigned T = 1u; int need = 1 << 30;
        if (t >= 256) {
            T = 0u;
#pragma unroll 1
            for (int bit = 31; bit >= 0; --bit) {
                const unsigned cand = __builtin_amdgcn_readfirstlane(T | (1u << bit)); int cnt = 0;
#pragma unroll
                for (int jb = 0; jb < 32; jb += 8) {
                    unsigned long long mk[8];
#pragma unroll
                    for (int j = 0; j < 8; ++j) asm volatile("v_cmp_ge_u32_e64 %0, %1, %2" : "=s"(mk[j]) : "v"(key[jb + j]), "s"(cand));
                    __builtin_amdgcn_sched_barrier(0);
#pragma unroll
                    for (int j = 0; j < 8; ++j) cnt += __builtin_popcountll(mk[j]);
                    __builtin_amdgcn_sched_barrier(0);
                }
                cnt = __builtin_amdgcn_readfirstlane(cnt);
                if (cnt >= 256) T = cand;
                if (cnt == 256) break;
            }
            int gt = 0;
#pragma unroll
            for (int j = 0; j < 32; ++j) gt += __builtin_popcountll(__ballot(key[j] > T));
            need = 256 - gt;
        }
        int run = 0; unsigned long long mymask = 0ull;
#pragma unroll
        for (int j = 0; j < 32; ++j) {
            const unsigned long long eq = __ballot(key[j] == T);
            const int rank = run + (int)__builtin_amdgcn_mbcnt_hi((unsigned)(eq >> 32), __builtin_amdgcn_mbcnt_lo((unsigned)eq, 0u));
            const bool sel = (key[j] > T) || (key[j] == T && rank < need);
            run += __builtin_popcountll(eq);
            const unsigned long long m = __ballot(sel);
            if (L == j) mymask = m;
        }
        if (L < 32) *(unsigned long long*)(MASK + (row0 + qr) * 64 + 2 * L) = mymask;
    }
}
__device__ __forceinline__ void phase_idx(const Frame& F) {
    for (int u = F.bid; u < 256; u += F.G) { const int b = u >> 6, i = u & 63; idx_unit(F, b, i); idx_unit(F, b, 127 - i); }
    __syncthreads();
}

template <int DQK, bool DSA>
__device__ __forceinline__ void attn_unit(const Frame& F, const bf16_t* Q, int ldq, const bf16_t* Kg, int ldk, const bf16_t* Vt, const unsigned* maskb, bf16_t* O, int ldo, int q0) {
    constexpr int NST = DQK / 16;
    constexpr int KA_BYTES = 64 * 256, KB_BYTES = (DQK == 192) ? 64 * 128 : 0, V_OFF = KA_BYTES + KB_BYTES, STAGE = V_OFF + 128 * 128;
    const int L = F.lane, r = L & 31, hf = L >> 5, w = F.wave;
    const int qw0 = q0 + 32 * w, tq = qw0 + r;
    const int ntiles = (q0 + 256) / 64;
    auto issue = [&](int kt, int buf) {
        LAS unsigned char* sb = F.lds + buf * STAGE;
#pragma unroll
        for (int i = 0; i < 2; ++i) { const int chunk = w + 8 * i, row = chunk * 4 + (L >> 4), slot = L & 15, piece = slot ^ (row & 15);
            __builtin_amdgcn_global_load_lds((const unsigned*)(Kg + (size_t)(kt * 64 + row) * ldk + piece * 8), (LAS unsigned*)(sb + chunk * 1024), 16, 0, 0); }
        if (DQK == 192) { const int row = w * 8 + (L >> 3), slot = L & 7, piece = 16 + (slot ^ ((row >> 1) & 7));
            __builtin_amdgcn_global_load_lds((const unsigned*)(Kg + (size_t)(kt * 64 + row) * ldk + piece * 8), (LAS unsigned*)(sb + KA_BYTES + w * 1024), 16, 0, 0); }
#pragma unroll
        for (int i = 0; i < 2; ++i) { const int chunk = w + 8 * i, row = chunk * 8 + (L >> 3), slot = L & 7, piece = slot ^ ((row >> 1) & 7);
            __builtin_amdgcn_global_load_lds((const unsigned*)(Vt + (size_t)row * SEQ + kt * 64 + piece * 8), (LAS unsigned*)(sb + V_OFF + chunk * 1024), 16, 0, 0); }
    };
    __syncthreads();
    u32x2 mw = (u32x2){0u, 0u};
    if (DSA) mw = *(const u32x2*)(maskb + (size_t)tq * 64);
    issue(0, 0);
    bf16x8 qf[NST];
#pragma unroll
    for (int st = 0; st < NST; ++st) qf[st] = *(const bf16x8*)(Q + (size_t)tq * ldq + st * 16 + hf * 8);
    f32x16 oacc[4];
#pragma unroll
    for (int dt = 0; dt < 4; ++dt)
#pragma unroll
        for (int i = 0; i < 16; ++i) oacc[dt][i] = 0.f;
    float mrun = -1e30f, lsum = 0.f;
    const int kx = (r & 15) ^ hf, vx = (r >> 1) & 7;
    for (int kt = 0; kt < ntiles; ++kt) {
        asm volatile("s_waitcnt vmcnt(0)" ::: "memory");
        __syncthreads();
        const u32x2 mcur = mw;
        if (DSA && kt + 1 < ntiles) mw = *(const u32x2*)(maskb + (size_t)tq * 64 + (kt + 1) * 2);
        if (kt + 1 < ntiles) issue(kt + 1, (kt + 1) & 1);
        if (kt * 64 <= qw0 + 31) {
            const LAS unsigned char* sb = F.lds + (kt & 1) * STAGE;
            f32x16 sacc[2];
#pragma unroll
            for (int kh = 0; kh < 2; ++kh) {
#pragma unroll
                for (int i = 0; i < 16; ++i) sacc[kh][i] = 0.f;
#pragma unroll
                for (int st = 0; st < NST; ++st) {
                    const LAS unsigned char* kp = (st < 8) ? sb + (kh * 32 + r) * 256 + (((2 * st) ^ kx) << 4)
                                                           : sb + KA_BYTES + (kh * 32 + r) * 128 + ((((2 * st - 16) | hf) ^ vx) << 4);
                    const bf16x8 kf = *(const LAS bf16x8*)kp;
                    sacc[kh] = __builtin_amdgcn_mfma_f32_32x32x16_bf16(kf, qf[st], sacc[kh], 0, 0, 0); }
            }
            if (!DSA && kt * 64 + 63 > qw0) {
                const int lim = tq - kt * 64 - 4 * hf;
#pragma unroll
                for (int i = 0; i < 16; ++i) { const int ko = (i & 3) + 8 * (i >> 2);
                    sacc[0][i] = (ko <= lim) ? sacc[0][i] : -INFINITY; sacc[1][i] = (ko + 32 <= lim) ? sacc[1][i] : -INFINITY; }
            }
            float mx = sacc[0][0];
#pragma unroll
            for (int i = 1; i < 16; ++i) mx = fmaxf(mx, sacc[0][i]);
#pragma unroll
            for (int i = 0; i < 16; ++i) mx = fmaxf(mx, sacc[1][i]);
            mx = pair32_max(mx);
            const float mnew = fmaxf(mrun, mx);
            const float alpha = fast_exp2(mrun - mnew);
            const bool grew = (mnew != mrun);
            mrun = mnew;
            float ps = 0.f;
            if (DSA) {
                const unsigned m0 = mcur.x >> (4 * hf), m1 = mcur.y >> (4 * hf);
#pragma unroll
                for (int i = 0; i < 16; ++i) { const unsigned bit = 1u << ((i & 3) + 8 * (i >> 2));
                    const float p0 = (m0 & bit) ? fast_exp2(sacc[0][i] - mnew) : 0.f, p1 = (m1 & bit) ? fast_exp2(sacc[1][i] - mnew) : 0.f;
                    sacc[0][i] = p0; sacc[1][i] = p1; ps += p0 + p1; }
            } else {
#pragma unroll
                for (int kh = 0; kh < 2; ++kh)
#pragma unroll
                    for (int i = 0; i < 16; ++i) { const float pv = fast_exp2(sacc[kh][i] - mnew); sacc[kh][i] = pv; ps += pv; }
            }
            lsum = lsum * alpha + ps;
            if (__builtin_amdgcn_ballot_w64(grew) != 0ull) {
#pragma unroll
                for (int dt = 0; dt < 4; ++dt)
#pragma unroll
                    for (int i = 0; i < 16; ++i) oacc[dt][i] *= alpha;
            }
            bf16x8 pf[2][2];
#pragma unroll
            for (int kh = 0; kh < 2; ++kh)
#pragma unroll
                for (int s2 = 0; s2 < 2; ++s2) { u32x4 pw;
                    pw.x = cvt_pk_bf16(sacc[kh][8 * s2 + 0], sacc[kh][8 * s2 + 1]); pw.y = cvt_pk_bf16(sacc[kh][8 * s2 + 2], sacc[kh][8 * s2 + 3]);
                    pw.z = cvt_pk_bf16(sacc[kh][8 * s2 + 4], sacc[kh][8 * s2 + 5]); pw.w = cvt_pk_bf16(sacc[kh][8 * s2 + 6], sacc[kh][8 * s2 + 7]);
                    pf[kh][s2] = __builtin_bit_cast(bf16x8, pw); }
#pragma unroll
            for (int dt = 0; dt < 4; ++dt)
#pragma unroll
                for (int kh = 0; kh < 2; ++kh)
#pragma unroll
                    for (int s2 = 0; s2 < 2; ++s2) {
                        const bf16x8 vf = *(const LAS bf16x8*)(sb + V_OFF + (dt * 32 + r) * 128 + ((((4 * kh + 2 * s2) | hf) ^ vx) << 4));
                        oacc[dt] = __builtin_amdgcn_mfma_f32_32x32x16_bf16(vf, pf[kh][s2], oacc[dt], 0, 0, 0); }
        }
    }
    const float ltot = pair32_sum(lsum);
    const float inv = fast_rcp(ltot);
    bf16_t* op = O + (size_t)tq * ldo + 4 * hf;
#pragma unroll
    for (int dt = 0; dt < 4; ++dt)
#pragma unroll
        for (int g4 = 0; g4 < 4; ++g4) { u32x2 ow; ow.x = cvt_pk_bf16(oacc[dt][4 * g4 + 0] * inv, oacc[dt][4 * g4 + 1] * inv); ow.y = cvt_pk_bf16(oacc[dt][4 * g4 + 2] * inv, oacc[dt][4 * g4 + 3] * inv);
            *(u32x2*)(op + dt * 32 + g4 * 8) = ow; }
}

#ifndef ATT_ENABLE_MLA
#define ATT_ENABLE_MLA 1
#endif
#ifndef ATT_ENABLE_DSA
#define ATT_ENABLE_DSA 1
#endif
__device__ __forceinline__ void phase_attn(const Frame& F) {
    unsigned char* ws = F.ws;
    const bf16_t* QA = (const bf16_t*)(ws + WS_QA); const bf16_t* KA = (const bf16_t*)(ws + WS_KA); const bf16_t* VAT = (const bf16_t*)(ws + WS_VAT);
    const bf16_t* QM = (const bf16_t*)(ws + WS_QM); const bf16_t* KM = (const bf16_t*)(ws + WS_KM); const bf16_t* VMT = (const bf16_t*)(ws + WS_VMT);
    const unsigned* MASK = (const unsigned*)(ws + WS_MASK); bf16_t* OAB = (bf16_t*)(ws + WS_OAB);
    for (int u = F.bid; u < 256; u += F.G) {
        const int b = u >> 6, h = (u >> 3) & 7, qb = u & 7;
        const size_t rb = (size_t)b * SEQ;
        if (ATT_ENABLE_DSA) attn_unit<128, true>(F, QA + rb * 1024 + h * 128, 1024, KA + rb * 256 + (h >> 2) * 128, 256, VAT + (size_t)(b * 2 + (h >> 2)) * 128 * SEQ, MASK + rb * 64, OAB + rb * DM + h * 128, DM, qb * 256);
        if (ATT_ENABLE_MLA) attn_unit<192, false>(F, QM + rb * 1536 + h * 192, 1536, KM + rb * 1536 + h * 192, 1536, VMT + (size_t)(b * 8 + h) * 128 * SEQ, nullptr, OAB + rb * DM + 1024 + h * 128, DM, (7 - qb) * 256);
    }
    __syncthreads();
}

__device__ __forceinline__ void phase_conv(const Frame& F, int l) {
    ArgsCP ap = F.a; unsigned char* ws = F.ws;
    const bf16_t* U = (const bf16_t*)(ws + WS_U); bf16_t* ACT = (bf16_t*)(ws + WS_ACT);
    const float* wconv = (const float*)ap->in[20] + (size_t)l * 3 * NUP; const float* bconv = (const float*)ap->in[21] + (size_t)l * NUP;
    const int cg = F.tid & 15, rs = F.tid >> 4;
    for (int it = F.bid; it < 32 * 44; it += F.G) {
        const int j = it % 44, pm = it / 44;
        const int ch = 128 * j + 8 * cg;
        const int row0 = pm * 256 + rs * 8;
        float wg[3][8], wvv[3][8], bg[8], bv[8];
#pragma unroll
        for (int k = 0; k < 3; ++k) { const f32x4 x0 = *(const f32x4*)(wconv + (size_t)k * NUP + ch), x1 = *(const f32x4*)(wconv + (size_t)k * NUP + ch + 4), y0 = *(const f32x4*)(wconv + (size_t)k * NUP + DFF + ch), y1 = *(const f32x4*)(wconv + (size_t)k * NUP + DFF + ch + 4);
#pragma unroll
            for (int e = 0; e < 4; ++e) { wg[k][e] = x0[e]; wg[k][4 + e] = x1[e]; wvv[k][e] = y0[e]; wvv[k][4 + e] = y1[e]; } }
        { const f32x4 x0 = *(const f32x4*)(bconv + ch), x1 = *(const f32x4*)(bconv + ch + 4), y0 = *(const f32x4*)(bconv + DFF + ch), y1 = *(const f32x4*)(bconv + DFF + ch + 4);
#pragma unroll
            for (int e = 0; e < 4; ++e) { bg[e] = x0[e]; bg[4 + e] = x1[e]; bv[e] = y0[e]; bv[4 + e] = y1[e]; } }
        const bf16_t* up = U + (size_t)row0 * NUP + 256 * j + 8 * cg;
        float g2[8], g1[8], v2[8], v1[8];
        const bool has_prev = (row0 & (SEQ - 1)) != 0;
#pragma unroll
        for (int e = 0; e < 8; ++e) { g2[e] = 0.f; g1[e] = 0.f; v2[e] = 0.f; v1[e] = 0.f; }
        if (has_prev) {
            const u32x4 a2 = *(const u32x4*)(up - 2 * (size_t)NUP), a1 = *(const u32x4*)(up - (size_t)NUP), c2 = *(const u32x4*)(up - 2 * (size_t)NUP + 128), c1 = *(const u32x4*)(up - (size_t)NUP + 128);
            g2[0] = bf_lo(a2.x); g2[1] = bf_hi(a2.x); g2[2] = bf_lo(a2.y); g2[3] = bf_hi(a2.y); g2[4] = bf_lo(a2.z); g2[5] = bf_hi(a2.z); g2[6] = bf_lo(a2.w); g2[7] = bf_hi(a2.w);
            g1[0] = bf_lo(a1.x); g1[1] = bf_hi(a1.x); g1[2] = bf_lo(a1.y); g1[3] = bf_hi(a1.y); g1[4] = bf_lo(a1.z); g1[5] = bf_hi(a1.z); g1[6] = bf_lo(a1.w); g1[7] = bf_hi(a1.w);
            v2[0] = bf_lo(c2.x); v2[1] = bf_hi(c2.x); v2[2] = bf_lo(c2.y); v2[3] = bf_hi(c2.y); v2[4] = bf_lo(c2.z); v2[5] = bf_hi(c2.z); v2[6] = bf_lo(c2.w); v2[7] = bf_hi(c2.w);
            v1[0] = bf_lo(c1.x); v1[1] = bf_hi(c1.x); v1[2] = bf_lo(c1.y); v1[3] = bf_hi(c1.y); v1[4] = bf_lo(c1.z); v1[5] = bf_hi(c1.z); v1[6] = bf_lo(c1.w); v1[7] = bf_hi(c1.w);
        }
        u32x4 gin[8], vin[8];
#pragma unroll
        for (int i = 0; i < 8; ++i) { gin[i] = *(const u32x4*)(up + (size_t)i * NUP); vin[i] = *(const u32x4*)(up + (size_t)i * NUP + 128); }
#pragma unroll
        for (int i = 0; i < 8; ++i) {
            float g0[8], v0[8], o[8];
            g0[0] = bf_lo(gin[i].x); g0[1] = bf_hi(gin[i].x); g0[2] = bf_lo(gin[i].y); g0[3] = bf_hi(gin[i].y); g0[4] = bf_lo(gin[i].z); g0[5] = bf_hi(gin[i].z); g0[6] = bf_lo(gin[i].w); g0[7] = bf_hi(gin[i].w);
            v0[0] = bf_lo(vin[i].x); v0[1] = bf_hi(vin[i].x); v0[2] = bf_lo(vin[i].y); v0[3] = bf_hi(vin[i].y); v0[4] = bf_lo(vin[i].z); v0[5] = bf_hi(vin[i].z); v0[6] = bf_lo(vin[i].w); v0[7] = bf_hi(vin[i].w);
#pragma unroll
            for (int e = 0; e < 8; ++e) {
                const float gc = bg[e] + wg[0][e] * g2[e] + wg[1][e] * g1[e] + wg[2][e] * g0[e];
                const float vc = bv[e] + wvv[0][e] * v2[e] + wvv[1][e] * v1[e] + wvv[2][e] * v0[e];
                o[e] = gc * sigmoidf_(gc) * vc;
                g2[e] = g1[e]; g1[e] = g0[e]; v2[e] = v1[e]; v1[e] = v0[e];
            }
            u32x4 ow; ow.x = cvt_pk_bf16(o[0], o[1]); ow.y = cvt_pk_bf16(o[2], o[3]); ow.z = cvt_pk_bf16(o[4], o[5]); ow.w = cvt_pk_bf16(o[6], o[7]);
            *(u32x4*)(ACT + (size_t)(row0 + i) * DFF + ch) = ow;
        }
    }
}

__device__ __forceinline__ void conv_fixup(const Frame& F, int l, int pm) {
    if ((pm & 7) == 0) return;
    ArgsCP ap = F.a; unsigned char* ws = F.ws;
    const float* wconv = (const float*)ap->in[20] + (size_t)l * 3 * NUP; const float* bconv = (const float*)ap->in[21] + (size_t)l * NUP;
    const float* UH = (const float*)(ws + WS_UHEAD) + (size_t)pm * 2 * NUP; const float* UT = (const float*)(ws + WS_UTAIL) + (size_t)(pm - 1) * 2 * NUP;
    bf16_t* ACT = (bf16_t*)(ws + WS_ACT);
    for (int idx = F.tid; idx < 2 * (DFF / 4); idx += 512) {
        const int rr = idx / (DFF / 4), ch = (idx % (DFF / 4)) * 4, colp = (ch >> 7) * 256 + (ch & 127);
        f32x4 o;
        f32x4 cvv[2];
#pragma unroll
        for (int bj = 0; bj < 2; ++bj) {
            const int cp = colp + bj * 128, cw = ch + bj * DFF;
            const f32x4 x2 = *(const f32x4*)(UT + (size_t)rr * NUP + cp);
            const f32x4 x1 = rr ? *(const f32x4*)(UH + cp) : *(const f32x4*)(UT + (size_t)NUP + cp);
            const f32x4 x0 = *(const f32x4*)(UH + (size_t)rr * NUP + cp);
            cvv[bj] = *(const f32x4*)(bconv + cw) + *(const f32x4*)(wconv + cw) * x2 + *(const f32x4*)(wconv + (size_t)NUP + cw) * x1 + *(const f32x4*)(wconv + (size_t)2 * NUP + cw) * x0;
        }
#pragma unroll
        for (int e = 0; e < 4; ++e) { const float g = cvv[0][e]; o[e] = g * sigmoidf_(g) * cvv[1][e]; }
        u32x2 ow; ow.x = cvt_pk_bf16(o[0], o[1]); ow.y = cvt_pk_bf16(o[2], o[3]);
        *(u32x2*)(ACT + (size_t)(pm * 256 + rr) * DFF + ch) = ow;
    }
}

typedef ArgsCP ArgsP;
__device__ __forceinline__ Frame make_frame() {
    Frame F;
    int tid = threadIdx.x; asm volatile("" : "+v"(tid));
    int bid = blockIdx.x, G = gridDim.x; asm volatile("" : "+s"(bid), "+s"(G));
    ArgsP ap = (ArgsP)__builtin_amdgcn_kernarg_segment_ptr(); asm volatile("" : "+s"(ap));
    extern __shared__ __attribute__((aligned(16))) unsigned char lds_raw[];
    F.lds = (LAS unsigned char*)lds_raw;
    F.tid = tid; F.lane = tid & 63; F.wave = __builtin_amdgcn_readfirstlane(tid >> 6); F.G = G; F.bid = bid;
    F.a = ap; F.ws = ap->ws;
    return F;
}

__global__ void __launch_bounds__(512, 2) fwd_kernel(Args args) {
    extern __shared__ __attribute__((aligned(16))) unsigned char lds_raw[];
    volatile LAS unsigned* MISC = (volatile LAS unsigned*)((LAS unsigned char*)lds_raw + LDS_MISC);
    if (threadIdx.x < 16) MISC[threadIdx.x] = 0u;
    __syncthreads();
    const int lo = args.ph_lo, hi = args.ph_hi;
    XcdBarrier bar; bar.bar = (unsigned*)(args.ws + WS_CTL) + 4096; bar.x = 0; bar.st = MISC;
    if (hi - lo > 1) bar = xcd_barrier_post((unsigned*)(args.ws + WS_CTL) + 4096, MISC);
#ifndef ONLY_PHASE
#define ONLY_PHASE -1
#endif
#define PH_EN(p) (ONLY_PHASE < 0 || ONLY_PHASE == (p))
#ifndef REP_MASK
#define REP_MASK 0
#endif
#define REPEAT(bit) _Pragma("unroll 1") for (int _rep = 0; _rep < (((REP_MASK >> (bit)) & 1) ? 2 : 1); ++_rep)
#define IN(k) (lo <= (k) && (k) < hi)
#ifndef BAR_REP
#define BAR_REP 1
#endif
#define SEAM(k) do { if (IN(k) && IN((k) + 1)) { _Pragma("unroll 1") for (int _br = 0; _br < BAR_REP; ++_br) { XcdBarrier b2 = bar; asm volatile("" : "+s"(b2.bar), "+s"(b2.x)); xcd_barrier(b2); } } } while (0)

    if (PH_EN(100) && IN(0)) { const Frame F = make_frame(); p0a_prologue(F); }
    SEAM(0);
    if (PH_EN(101) && IN(1)) REPEAT(0) { const Frame F = make_frame(); p0b_prologue(F); }
    SEAM(1);

#pragma unroll 1
    for (int l = 0; l < DEPTH; ++l) {
        const int pb = 2 + l * NPH_LAYER;
        if (PH_EN(0) && IN(pb + 0)) REPEAT(1) { const Frame F = make_frame(); unsigned char* ws = F.ws;
            pg8::Gemm g{(const bf16_t*)(ws + WS_H), (const bf16_t*)(ws + WS_WIN) + (size_t)l * NPROJ * DM, DM, DM, DM, 0, 0};
            pg8::StaticOrder S; S.init(MROWS, NPROJ, F.G, F.bid);
            pg8::EpiProjNorm E{(bf16_t*)(ws + WS_PROJ), NPROJ, (const fx64*)(ws + WS_SSQ) + (size_t)(l * 2 + 0) * MROWS, (const fx64*)(ws + WS_BIAS) + (size_t)l * NBATCH * NPROJ, NPROJ};
            pg8::gemm_phase(F.lds, F.tid, g, S, E);
        }
        SEAM(pb + 0);
        if (PH_EN(1) && IN(pb + 1)) REPEAT(5) { const Frame F = make_frame(); phase_post1(F, l); }
        SEAM(pb + 1);
        if (PH_EN(2) && IN(pb + 2)) {
            { const Frame F = make_frame(); unsigned char* ws = F.ws;
              pg8::Gemm g{(const bf16_t*)(ws + WS_MQL), (const bf16_t*)(ws + WS_WMQ) + (size_t)l * 1536 * 512, 512, 512, 512, 0, 0};
              pg8::StaticOrder S; S.init(MROWS, 1536, F.G, F.bid); pg8::EpiStoreBf16 E{(bf16_t*)(ws + WS_MQ), 1536}; pg8::gemm_phase(F.lds, F.tid, g, S, E); }
            { const Frame F = make_frame(); unsigned char* ws = F.ws;
              pg8::Gemm g{(const bf16_t*)(ws + WS_MKVL), (const bf16_t*)(ws + WS_WMKV) + (size_t)l * 2048 * 256, 256, 256, 256, 0, 0};
              pg8::StaticOrder S; S.init(MROWS, 2048, F.G, F.bid); pg8::EpiStoreBf16 E{(bf16_t*)(ws + WS_MKV), 2048}; pg8::gemm_phase(F.lds, F.tid, g, S, E); }
            REPEAT(3) { const Frame F = make_frame(); phase_idx(F); }
        }
        SEAM(pb + 2);
        if (PH_EN(3) && IN(pb + 3)) REPEAT(6) { const Frame F = make_frame(); phase_post2(F, l); }
        SEAM(pb + 3);
        if (PH_EN(4) && IN(pb + 4)) REPEAT(2) { const Frame F = make_frame(); phase_attn(F); }
        SEAM(pb + 4);
        if (PH_EN(5) && IN(pb + 5)) { const Frame F = make_frame(); unsigned char* ws = F.ws;
            pg8::Gemm g{(const bf16_t*)(ws + WS_OAB), (const bf16_t*)(ws + WS_WPAB) + (size_t)l * 4096 * 1024, DM, 1024, 1024, (size_t)1024 * 2, (size_t)2048 * 1024 * 2};
            pg8::PairOrder S; S.s.init(MROWS, DM, F.G, F.bid);
            pg8::EpiPab E{(const bf16_t*)(ws + WS_PROJ), (bf16_t*)(ws + WS_MERGED)};
            pg8::gemm_phase(F.lds, F.tid, g, S, E);
        }
        SEAM(pb + 5);
        if (PH_EN(6) && IN(pb + 6)) { const Frame F = make_frame(); unsigned char* ws = F.ws;
            const float* xin = (l == 0) ? (const float*)F.a->in[0] : (const float*)F.a->out;
            const float* modl = (const float*)(ws + WS_MOD) + (size_t)l * NBATCH * NADA;
            pg8::Gemm g{(const bf16_t*)(ws + WS_MERGED), (const bf16_t*)(ws + WS_WO) + (size_t)l * DM * DM, DM, DM, DM, 0, 0};
            pg8::StaticOrder S; S.init(MROWS, DM, F.G, F.bid);
            pg8::EpiResidNorm E{xin, F.a->out, modl + 2 * DM, (const float*)F.a->in[4] + l * DM, modl + 4 * DM, (bf16_t*)(ws + WS_H), (fx64*)(ws + WS_SSQ) + (size_t)(l * 2 + 1) * MROWS};
            pg8::gemm_phase(F.lds, F.tid, g, S, E);
        }
        SEAM(pb + 6);
        if (PH_EN(7) && IN(pb + 7)) { const Frame F = make_frame(); unsigned char* ws = F.ws;
            pg8::Gemm g{(const bf16_t*)(ws + WS_H), (const bf16_t*)(ws + WS_WUP) + (size_t)l * NUP * DM, DM, DM, DM, 0, 0};
            pg8::StaticOrder S; S.init(MROWS, NUP, F.G, F.bid);
            pg8::EpiUpConv E{(const float*)F.a->in[20] + (size_t)l * 3 * NUP, (const float*)F.a->in[21] + (size_t)l * NUP, (bf16_t*)(ws + WS_ACT), (float*)(ws + WS_UHEAD), (float*)(ws + WS_UTAIL), (LAS float*)(F.lds + LDS_XB),
                               (const fx64*)(ws + WS_SSQ) + (size_t)(l * 2 + 1) * MROWS, (const fx64*)(ws + WS_BIAS_UP) + (size_t)l * NBATCH * NUP};
            pg8::gemm_phase(F.lds, F.tid, g, S, E);
        }
        SEAM(pb + 7);
        if (PH_EN(8) && IN(pb + 8)) { const Frame F = make_frame(); unsigned char* ws = F.ws;
            pg8::StaticOrder S; S.init(MROWS, DM, F.G, F.bid);
            { pg8::Unit uu; for (int i = 0; S.next(i, uu); ++i) conv_fixup(F, l, uu.pm); }
            asm volatile("s_waitcnt vmcnt(0)" ::: "memory"); __syncthreads();
            const float* modl = (const float*)(ws + WS_MOD) + (size_t)l * NBATCH * NADA;
            const bool more = (l + 1 < DEPTH);
            pg8::Gemm g{(const bf16_t*)(ws + WS_ACT), (const bf16_t*)(ws + WS_WDN) + (size_t)l * DM * DFF, DFF, DFF, DFF, 0, 0};
            pg8::EpiResidNorm E{F.a->out, F.a->out, modl + 5 * DM, (const float*)F.a->in[3] + (l + 1) * DM, modl + NBATCH * NADA + DM, more ? (bf16_t*)(ws + WS_H) : (bf16_t*)nullptr, (fx64*)(ws + WS_SSQ) + (size_t)((l + 1) * 2 + 0) * MROWS};
            pg8::gemm_phase(F.lds, F.tid, g, S, E);
        }
        SEAM(pb + 8);
    }
#undef IN
#undef SEAM
}

extern "C" void kernel_launch(void* const* d_in, const int* in_sizes, int n_in, void* d_out, int out_size, void* d_ws, size_t ws_size, hipStream_t stream) {
    static int grid = 0;
    if (grid == 0) {
        if (n_in != 23 || out_size != MROWS * DM || ws_size < WS_END) { fprintf(stderr, "kernel_launch: unexpected problem (n_in %d, out %d, ws %zu < %zu)\n", n_in, out_size, ws_size, (size_t)WS_END); grid = -1; return; }
        int dev = 0, cus = 0, per_cu = 0;
        if (hipGetDevice(&dev) != hipSuccess || hipDeviceGetAttribute(&cus, hipDeviceAttributeMultiprocessorCount, dev) != hipSuccess) { grid = -1; return; }
        if (hipFuncSetAttribute((const void*)fwd_kernel, hipFuncAttributeMaxDynamicSharedMemorySize, LDS_BYTES) != hipSuccess) { fprintf(stderr, "kernel_launch: hipFuncSetAttribute failed\n"); grid = -1; return; }
        if (hipOccupancyMaxActiveBlocksPerMultiprocessor(&per_cu, (const void*)fwd_kernel, 512, LDS_BYTES) != hipSuccess || per_cu < 1) { fprintf(stderr, "kernel_launch: occupancy query says %d\n", per_cu); }
        (void)hipGetLastError();
        grid = cus;
    }
    if (grid < 0) return;
    (void)in_sizes;
    (void)hipMemsetAsync((char*)d_ws + WS_CTL, 0, CTL_ZERO_BYTES, stream);
    (void)hipMemsetAsync((char*)d_ws + WS_BIAS, 0, BIAS_ZERO_BYTES, stream);
    Args a{};
    for (int i = 0; i < 23; ++i) a.in[i] = d_in[i];
    a.out = (float*)d_out; a.ws = (unsigned char*)d_ws;
    for (int i = 0; i < 16; ++i) a.inv_a[i] = (float)pow(500000.0, -(double)(2 * i) / 32.0);
    for (int i = 0; i < 8; ++i) a.inv_i[i] = (float)pow(500000.0, -(double)(2 * i) / 16.0);
    for (int i = 0; i < 32; ++i) a.inv_m[i] = (float)pow(500000.0, -(double)(2 * i) / 64.0);
#if MK_ONE_LAUNCH
    a.ph_lo = 0; a.ph_hi = NPHASES;
    hipLaunchKernelGGL(fwd_kernel, dim3(grid), dim3(512), LDS_BYTES, stream, a);
#else
    for (int p = 0; p < NPHASES; ++p) { a.ph_lo = p; a.ph_hi = p + 1; hipLaunchKernelGGL(fwd_kernel, dim3(grid), dim3(512), LDS_BYTES, stream, a); }
#endif
}
```

```cpp
#include <hip/hip_runtime.h>
#include <cstdio>
#include <cstdint>
#include <cmath>

#define GAS __attribute__((address_space(1)))
#define LAS __attribute__((address_space(3)))
typedef unsigned short bf16_t;
typedef short bf16x8 __attribute__((ext_vector_type(8)));
typedef short bf16x4 __attribute__((ext_vector_type(4)));
typedef float f32x4 __attribute__((ext_vector_type(4)));
typedef float f32x16 __attribute__((ext_vector_type(16)));
typedef unsigned u32x4 __attribute__((ext_vector_type(4)));
typedef unsigned u32x2 __attribute__((ext_vector_type(2)));
typedef int i32x8 __attribute__((ext_vector_type(8)));
typedef int i32x4 __attribute__((ext_vector_type(4)));

constexpr int DM = 2048, NBATCH = 4, SEQ = 2048, DEPTH = 4, MROWS = NBATCH * SEQ;
constexpr int IN_DIM = 7568, NPROJ = 7680, DFF = 5632, NUP = 2 * DFF, NADA = 6 * DM;
constexpr int PC_QA = 0, PC_KA = 1024, PC_VA = 1280, PC_QI = 1536, PC_KI = 2560, PC_WI = 2624, PC_MKR = 2640, PC_MQL = 2816, PC_MKVL = 3328, PC_GA = 3584, PC_GB = 5632;
constexpr float EPS = 1e-6f;
constexpr float W8_SCALE = 32.0f, W8_INV = 1.0f / 32.0f;
constexpr float LOG2E = 1.4426950408889634f;
constexpr int NPH_LAYER = 8, NPHASES = 2 + DEPTH * NPH_LAYER;
#ifndef MK_ONE_LAUNCH
#define MK_ONE_LAUNCH 1
#endif

constexpr size_t MiB = 1u << 20;
constexpr size_t WS_CTL = 0, CTL_ZERO_BYTES = 1 * MiB;
constexpr size_t WS_SSQ = 256 * 1024;
constexpr size_t WS_MOD = 1 * MiB;
constexpr size_t WS_ROPE = 2 * MiB;
constexpr size_t WS_WIN = 8 * MiB;
constexpr size_t WS_WMQ = 128 * MiB;
constexpr size_t WS_WMKV = 134 * MiB;
constexpr size_t WS_WPAB = 138 * MiB;
constexpr size_t WS_WO = 170 * MiB;
constexpr size_t WS_WUP = 202 * MiB;
constexpr size_t WS_WDN = 378 * MiB;
constexpr size_t WS_H = 466 * MiB;
constexpr size_t WS_PROJ = 498 * MiB;
constexpr size_t WS_QA = 618 * MiB;
constexpr size_t WS_KA = 634 * MiB;
constexpr size_t WS_VAT = 638 * MiB;
constexpr size_t WS_QI = 642 * MiB;
constexpr size_t WS_KI = 658 * MiB;
constexpr size_t WS_WI = 659 * MiB;
constexpr size_t WS_MQL = 660 * MiB;
constexpr size_t WS_MKVL = 668 * MiB;
constexpr size_t WS_MQ = 672 * MiB;
constexpr size_t WS_MKV = 696 * MiB;
constexpr size_t WS_QM = 728 * MiB;
constexpr size_t WS_KM = 752 * MiB;
constexpr size_t WS_VMT = 776 * MiB;
constexpr size_t WS_MASK = 792 * MiB;
constexpr size_t WS_OAB = 794 * MiB;
constexpr size_t WS_MERGED = 826 * MiB;
constexpr size_t WS_U = 858 * MiB;
constexpr size_t WS_ACT = 1034 * MiB;
constexpr size_t WS_UHEAD = 1122 * MiB;
constexpr size_t WS_UTAIL = 1126 * MiB;
constexpr size_t WS_BIAS = 1130 * MiB, BIAS_ZERO_BYTES = 3584 * 1024;
constexpr size_t WS_BIAS_UP = WS_BIAS + (size_t)DEPTH * NBATCH * NPROJ * 8;
constexpr size_t WS_SSQ_LAT = 1133 * MiB;
constexpr size_t WS_H8 = 1134 * MiB;
constexpr size_t WS_END = 1150 * MiB;

constexpr int LDS_BYTES = 153600;
constexpr int LDS_TAB2 = 147456, LDS_CTAB2 = 149504;
constexpr int LDS_CTAB = 131072;
constexpr int LDS_MISC = 135168;
constexpr int LDS_TAB = 136192;
constexpr int LDS_XB = 139264;

__device__ __forceinline__ unsigned cvt_pk_bf16(float lo, float hi) { unsigned r; asm("v_cvt_pk_bf16_f32 %0, %1, %2" : "=v"(r) : "v"(lo), "v"(hi)); return r; }
__device__ __forceinline__ unsigned cvt_fp8x4(float a, float b, float c, float d) { int w = __builtin_amdgcn_cvt_pk_fp8_f32(a, b, 0, false); w = __builtin_amdgcn_cvt_pk_fp8_f32(c, d, w, true); return (unsigned)w; }
__device__ __forceinline__ float bf_lo(unsigned w) { return __uint_as_float(w << 16); }
__device__ __forceinline__ float bf_hi(unsigned w) { return __uint_as_float(w & 0xffff0000u); }
__device__ __forceinline__ float bf1(bf16_t v) { return __uint_as_float(((unsigned)v) << 16); }
template <int K> __device__ __forceinline__ float swz_xor(float v) { return __int_as_float(__builtin_amdgcn_ds_swizzle(__float_as_int(v), 0x1f | (K << 10))); }
__device__ __forceinline__ float pair32_sum(float v) { auto rr = __builtin_amdgcn_permlane32_swap(__float_as_uint(v), __float_as_uint(v), false, false); return __uint_as_float(rr[0]) + __uint_as_float(rr[1]); }
__device__ __forceinline__ float pair32_max(float v) { auto rr = __builtin_amdgcn_permlane32_swap(__float_as_uint(v), __float_as_uint(v), false, false); return fmaxf(__uint_as_float(rr[0]), __uint_as_float(rr[1])); }
__device__ __forceinline__ float pair32_other(float v, bool upper) { auto rr = __builtin_amdgcn_permlane32_swap(__float_as_uint(v), __float_as_uint(v), false, false); return __uint_as_float(upper ? rr[0] : rr[1]); }
template <int CTRL> __device__ __forceinline__ float dpp_mov_f(float v) { return __int_as_float(__builtin_amdgcn_update_dpp(0, __float_as_int(v), CTRL, 0xf, 0xf, true)); }
__device__ __forceinline__ float wave_sum(float v) {
    v += dpp_mov_f<0x128>(v); v += dpp_mov_f<0x124>(v); v += dpp_mov_f<0x122>(v); v += dpp_mov_f<0x121>(v);
    v += swz_xor<16>(v);
    return pair32_sum(v);
}
__device__ __forceinline__ float fast_rsq(float x) { return __builtin_amdgcn_rsqf(x); }
__device__ __forceinline__ float fast_rcp(float x) { return __builtin_amdgcn_rcpf(x); }
__device__ __forceinline__ float fast_exp2(float x) { return __builtin_amdgcn_exp2f(x); }
typedef long long fx64;
constexpr float FX_SSQ = 4294967296.f, FX_SSQ_INV = 1.0f / 4294967296.f;
constexpr double FX_BIAS = 1099511627776.0; constexpr float FX_BIAS_INV = (float)(1.0 / 1099511627776.0);
__device__ __forceinline__ void fx_add(fx64* p, double scaled) { (void)__hip_atomic_fetch_add((unsigned long long*)p, (unsigned long long)(long long)__builtin_rint(scaled), __ATOMIC_RELAXED, __HIP_MEMORY_SCOPE_AGENT); }
__device__ __forceinline__ float sigmoidf_(float x) { return fast_rcp(1.0f + fast_exp2(-x * LOG2E)); }

#define XB_TMO      128
#define XB_XCNT(j)  (256  + 64 * (j))
#define XB_XSUB(j)  (1280 + 64 * (j))
#define XB_XGEN(j)  (2304 + 64 * (j))
#define XB_TOP      3328
#define XB_TOPGEN   3392
#define XCD_BAR_WORDS 3456
#define XB_SPIN_CAP (1u << 20)

__device__ __forceinline__ unsigned xb_ld(unsigned* p)              { return __hip_atomic_load(p, __ATOMIC_RELAXED, __HIP_MEMORY_SCOPE_AGENT); }
__device__ __forceinline__ unsigned xb_add(unsigned* p, unsigned v) { return __hip_atomic_fetch_add(p, v, __ATOMIC_RELAXED, __HIP_MEMORY_SCOPE_AGENT); }
__device__ __forceinline__ unsigned xb_xcc_id() { return (unsigned)__builtin_amdgcn_s_getreg((3 << 11) | 20) & 0xFu; }
#define XB_SPIN(cond, bar) do { unsigned _sp = 0; while (cond) { __builtin_amdgcn_s_sleep(1); \
    if ((++_sp & 255u) == 0u) { if (xb_ld(&(bar)[XB_TMO])) break; if (_sp > XB_SPIN_CAP) { atomicAdd(&(bar)[XB_TMO], 1u); break; } } } } while (0)

struct XcdBarrier { unsigned* bar; unsigned x; volatile LAS unsigned* st; };

__device__ __forceinline__ XcdBarrier xcd_barrier_post(unsigned* bar, volatile LAS unsigned* st) {
    XcdBarrier b; b.bar = bar; b.x = xb_xcc_id(); b.st = st;
    if (threadIdx.x == 0) (void)xb_add(&bar[XB_XCNT(b.x)], 1u);
    return b;
}
__device__ __forceinline__ void xcd_barrier_complete(unsigned* bar, unsigned x, unsigned& nloc, unsigned& nx) {
    const unsigned G = gridDim.x * gridDim.y * gridDim.z;
    unsigned sum, cnt, mine, sp = 0u;
    for (;;) {
        sum = 0u; cnt = 0u; mine = 0u;
#pragma unroll
        for (unsigned j = 0; j < 16; ++j) { const unsigned c = xb_ld(&bar[XB_XCNT(j)]); sum += c; cnt += (c > 0u) ? 1u : 0u; mine = (j == x) ? c : mine; }
        if (sum == G) break;
        __builtin_amdgcn_s_sleep(1);
        if ((++sp & 255u) == 0u) { if (xb_ld(&bar[XB_TMO])) break; if (sp > XB_SPIN_CAP) { atomicAdd(&bar[XB_TMO], 1u); break; } }
    }
    nloc = mine > 0u ? mine : 1u; nx = cnt > 0u ? cnt : 1u;
}
__device__ __forceinline__ void xcd_barrier(const XcdBarrier& b) {
    asm volatile("s_waitcnt vmcnt(0)" ::: "memory");
    __syncthreads();
    if (threadIdx.x == 0) {
        unsigned* bar = b.bar;
        __builtin_amdgcn_s_waitcnt(0);
        unsigned nloc = b.st[0], nx = b.st[1];
        if (nloc == 0u) { xcd_barrier_complete(bar, b.x, nloc, nx); b.st[0] = nloc; b.st[1] = nx; }
        const unsigned old = xb_add(&bar[XB_XSUB(b.x)], 1u);
        const unsigned gen = old / nloc;
        if (old + 1u == (gen + 1u) * nloc) {
            __builtin_amdgcn_fence(__ATOMIC_RELEASE, "agent");
            asm volatile("s_waitcnt vmcnt(0)" ::: "memory");
            const unsigned og = xb_add(&bar[XB_TOP], 1u);
            const unsigned tg = og / nx;
            if (og + 1u == (tg + 1u) * nx) xb_add(&bar[XB_TOPGEN], 1u);
            else XB_SPIN(xb_ld(&bar[XB_TOPGEN]) == tg, bar);
            asm volatile("buffer_inv sc1" ::: "memory");
            xb_add(&bar[XB_XGEN(b.x)], 1u);
            asm volatile("s_waitcnt vmcnt(0)" ::: "memory");
        } else {
            XB_SPIN(xb_ld(&bar[XB_XGEN(b.x)]) == gen, bar);
            __builtin_amdgcn_fence(__ATOMIC_ACQUIRE, "agent");
            asm volatile("s_waitcnt vmcnt(0)" ::: "memory");
        }
    }
    __syncthreads();
}

namespace pg8 {
constexpr int BM = 256, BK = 64, HALF = 128, HTB = HALF * BK * 2, STAGE_BYTES = 8 * HTB, NXCD = 8, WGM = 8;
__host__ __device__ __forceinline__ int lds_byte(int r, int c) { const int st = (r >> 4) * 2 + (c >> 5), rr = r & 15, cc = c & 31, ob = rr * 64 + cc * 2; return st * 1024 + (ob ^ (((ob >> 9) & 1) << 5)); }
__host__ __device__ __forceinline__ void stage_rc(int b, int& R, int& C) { const int st = b / 1024, sb = b % 1024, swz = sb ^ (((sb >> 9) & 1) << 5); R = (st >> 1) * 16 + swz / 64; C = (st & 1) * 32 + (swz % 64) / 2; }
__host__ __device__ __forceinline__ int perm32(int rho) { const int n = rho >> 4, i = rho & 15; return 8 * (i >> 2) + 4 * n + (i & 3); }

struct Unit { int pm, pn, z; };
struct Gemm { const bf16_t* A; const bf16_t* Bt; int lda, ldb, K; size_t azs, bzs; };

struct StaticOrder {
    int nM, nN, nwg, G, c;
    __host__ __device__ __forceinline__ void init(int M, int N, int G_, int c_) { nM = M / BM; nN = N / BM; nwg = nM * nN; G = G_; c = c_; }
    __host__ __device__ __forceinline__ bool next(int i, Unit& u) const {
        const long L = (long)i * G + c; if (L >= nwg) return false;
        int wgid = (int)L; { const int q = nwg / NXCD, r = nwg % NXCD, xcd = wgid % NXCD, off = wgid / NXCD; wgid = (xcd < r ? xcd * (q + 1) : r * (q + 1) + (xcd - r) * q) + off; }
        const int nig = WGM * nN, gid = wgid / nig, fm = gid * WGM, gsz = (nM - fm) < WGM ? (nM - fm) : WGM;
        u.pm = fm + ((wgid % nig) % gsz); u.pn = (wgid % nig) / gsz; u.z = 0; return true;
    }
};
struct PairOrder {
    StaticOrder s;
    __host__ __device__ __forceinline__ bool next(int i, Unit& u) const { if (!s.next(i >> 1, u)) return false; u.z = i & 1; return true; }
};

template <class Epi, class Sched, bool ALIGN_EPI = true, bool SP2 = true>
__device__ __forceinline__ void gemm_phase(LAS unsigned char* lds, const int tid, const Gemm g, const Sched& S, const Epi& E) {
    const int wid = __builtin_amdgcn_readfirstlane(tid >> 6), lane = tid & 63, wr = wid >> 2, wc = wid & 3, fr = lane & 15, fq = lane >> 4;
    const int K = g.K, nt = K / BK;
    unsigned voffA[2], voffB[2];
#pragma unroll
    for (int i = 0; i < 2; ++i) { int R, C; stage_rc(tid * 16 + i * 8192, R, C); const int Rb = Epi::PERM ? ((R & ~31) + perm32(R & 31)) : R;
        const int Ra = Epi::PERM_A ? ((R & 64) | ((R & 15) << 2) | ((R >> 4) & 3)) : R;
        voffA[i] = (unsigned)(Ra * g.lda + C) * 2u; voffB[i] = (unsigned)(Rb * g.ldb + C) * 2u; }
    const size_t kstep = (size_t)(BK * 2);
    const size_t hstepA = (size_t)HALF * g.lda * 2, hstepB = (size_t)HALF * g.ldb * 2;
    const size_t tstepA = 2 * hstepA, tstepB = 2 * hstepB;
    const unsigned ldsw = (unsigned)wid * 1024u;
    const int aoff = lds_byte(wr * 64 + fr, fq * 8), boff = lds_byte(wc * 32 + fr, fq * 8);
#define PG8_SA(b, h) (((b) * 2 + (h)) * HTB)
#define PG8_SB(b, h) ((4 + (b) * 2 + (h)) * HTB)
#define PG8_STAGE(bufoff, gbase, voff) do { _Pragma("unroll") for (int _i = 0; _i < 2; ++_i) \
        __builtin_amdgcn_global_load_lds((const unsigned*)((const char*)(gbase) + (voff)[_i]), (LAS unsigned*)(lds + (bufoff) + ldsw + _i * 8192), 16, 0, 0); } while (0)
#define PG8_LDA(dst, b, h) do { _Pragma("unroll") for (int m = 0; m < 4; ++m) { const i32x4 lo_ = *(const LAS i32x4*)(lds + PG8_SA(b, h) + aoff + m * 2048), hi_ = *(const LAS i32x4*)(lds + PG8_SA(b, h) + aoff + m * 2048 + 1024); \
        dst[m] = __builtin_shufflevector(lo_, hi_, 0, 1, 2, 3, 4, 5, 6, 7); } } while (0)
#define PG8_LDB(dst, b, h) do { _Pragma("unroll") for (int n = 0; n < 2; ++n) { const i32x4 lo_ = *(const LAS i32x4*)(lds + PG8_SB(b, h) + boff + n * 2048), hi_ = *(const LAS i32x4*)(lds + PG8_SB(b, h) + boff + n * 2048 + 1024); \
        dst[n] = __builtin_shufflevector(lo_, hi_, 0, 1, 2, 3, 4, 5, 6, 7); } } while (0)
#define PG8_MMA(ai, bj, At, Bt) do { __builtin_amdgcn_s_setprio(1); \
        _Pragma("unroll") for (int m = 0; m < 4; ++m) _Pragma("unroll") for (int n = 0; n < 2; ++n) { \
            if constexpr (Epi::FP8) asm volatile("v_mfma_scale_f32_16x16x128_f8f6f4 %0, %1, %2, %0, %3, %3 op_sel_hi:[0,0,0]" : "+v"(acc[ai][bj][m][n]) : "v"(Bt[n]), "v"(At[m]), "v"(sc1_));     \
            else { acc[ai][bj][m][n] = __builtin_amdgcn_mfma_f32_16x16x32_bf16(__builtin_bit_cast(bf16x8, __builtin_shufflevector(Bt[n], Bt[n], 0, 1, 2, 3)), __builtin_bit_cast(bf16x8, __builtin_shufflevector(At[m], At[m], 0, 1, 2, 3)), acc[ai][bj][m][n], 0, 0, 0); \
                   acc[ai][bj][m][n] = __builtin_amdgcn_mfma_f32_16x16x32_bf16(__builtin_bit_cast(bf16x8, __builtin_shufflevector(Bt[n], Bt[n], 4, 5, 6, 7)), __builtin_bit_cast(bf16x8, __builtin_shufflevector(At[m], At[m], 4, 5, 6, 7)), acc[ai][bj][m][n], 0, 0, 0); } } \
        __builtin_amdgcn_s_setprio(0); } while (0)
#define PG8_WAIT_V(n) asm volatile("s_waitcnt vmcnt(" #n ")" ::: "memory")
#define PG8_WAIT_L(n) asm volatile("s_waitcnt lgkmcnt(" #n ")" ::: "memory")
#define PG8_BAR __builtin_amdgcn_s_barrier()
#define PG8_SCHED __builtin_amdgcn_sched_barrier(0)
    Unit cur, nxt; int ui = 0;
    if (!S.next(0, cur)) return;
    f32x4 acc[2][2][4][2];
#pragma unroll
    for (int a = 0; a < 2; ++a)
#pragma unroll
        for (int b = 0; b < 2; ++b)
#pragma unroll
            for (int m = 0; m < 4; ++m)
#pragma unroll
                for (int n = 0; n < 2; ++n) acc[a][b][m][n] = (f32x4){0.f, 0.f, 0.f, 0.f};
    i32x8 At[4], B0[2], B1[2];
    const int sc1_ = 0x7f7f7f7f;
    const char* cA = (const char*)g.A + (size_t)cur.z * g.azs + (size_t)cur.pm * tstepA; const char* cB = (const char*)g.Bt + (size_t)cur.z * g.bzs + (size_t)cur.pn * tstepB;
    if constexpr (SP2) {
        PG8_STAGE(PG8_SB(0, 0), cB, voffB); PG8_STAGE(PG8_SB(0, 1), cB + hstepB, voffB); PG8_STAGE(PG8_SA(0, 0), cA, voffA); PG8_STAGE(PG8_SA(0, 1), cA + hstepA, voffA);
        if (wr == 1) PG8_BAR;
        PG8_WAIT_V(2); PG8_BAR;
        PG8_STAGE(PG8_SB(1, 0), cB + kstep, voffB); PG8_STAGE(PG8_SA(1, 0), cA + kstep, voffA); PG8_STAGE(PG8_SB(1, 1), cB + hstepB + kstep, voffB);
        PG8_WAIT_V(6); PG8_BAR;
    } else {
        PG8_STAGE(PG8_SB(0, 0), cB, voffB); PG8_STAGE(PG8_SA(0, 0), cA, voffA); PG8_STAGE(PG8_SB(0, 1), cB + hstepB, voffB); PG8_STAGE(PG8_SA(0, 1), cA + hstepA, voffA);
        if (wr == 1) PG8_BAR;
        PG8_WAIT_V(4); PG8_BAR;
        PG8_STAGE(PG8_SB(1, 0), cB + kstep, voffB); PG8_STAGE(PG8_SA(1, 0), cA + kstep, voffA); PG8_STAGE(PG8_SB(1, 1), cB + hstepB + kstep, voffB);
        PG8_WAIT_V(6); PG8_BAR;
    }
    for (;;) {
        const bool has_next = S.next(ui + 1, nxt);
        const char* nA = has_next ? (const char*)g.A + (size_t)nxt.z * g.azs + (size_t)nxt.pm * tstepA : cA; const char* nB = has_next ? (const char*)g.Bt + (size_t)nxt.z * g.bzs + (size_t)nxt.pn * tstepB : cB;
        for (int t = 0; t < nt; t += 2) {
            const bool last = (t == nt - 2);
            const char* a1 = cA + (size_t)(t + 1) * kstep;
            const char* a2 = last ? nA : cA + (size_t)(t + 2) * kstep; const char* b2 = last ? nB : cB + (size_t)(t + 2) * kstep;
            const char* a3 = a2 + kstep; const char* b3 = b2 + kstep;
            if constexpr (SP2) {
            PG8_LDB(B0, 0, 0); PG8_LDB(B1, 0, 1); PG8_SCHED; PG8_LDA(At, 0, 0); PG8_STAGE(PG8_SA(1, 1), a1 + hstepA, voffA);
            PG8_WAIT_V(8); PG8_WAIT_L(0); PG8_BAR; PG8_MMA(0, 0, At, B0); PG8_MMA(0, 1, At, B1); PG8_BAR; PG8_SCHED;
            PG8_LDA(At, 0, 1); PG8_STAGE(PG8_SB(0, 0), b2, voffB); PG8_STAGE(PG8_SB(0, 1), b2 + hstepB, voffB); PG8_STAGE(PG8_SA(0, 0), a2, voffA);
            PG8_WAIT_V(8); PG8_WAIT_L(0); PG8_BAR; PG8_MMA(1, 0, At, B0); PG8_MMA(1, 1, At, B1); PG8_BAR; PG8_SCHED;
            PG8_LDB(B0, 1, 0); PG8_LDB(B1, 1, 1); PG8_SCHED; PG8_LDA(At, 1, 0); PG8_STAGE(PG8_SA(0, 1), a2 + hstepA, voffA);
            PG8_WAIT_V(8); PG8_WAIT_L(0); PG8_BAR; PG8_MMA(0, 0, At, B0); PG8_MMA(0, 1, At, B1); PG8_BAR; PG8_SCHED;
            PG8_LDA(At, 1, 1); PG8_STAGE(PG8_SB(1, 0), b3, voffB); PG8_STAGE(PG8_SB(1, 1), b3 + hstepB, voffB); PG8_STAGE(PG8_SA(1, 0), a3, voffA);
            PG8_WAIT_V(8); PG8_WAIT_L(0); PG8_BAR; PG8_MMA(1, 0, At, B0); PG8_MMA(1, 1, At, B1); PG8_BAR; PG8_SCHED;
            } else {
            PG8_LDB(B0, 0, 0); PG8_SCHED; PG8_LDA(At, 0, 0); PG8_STAGE(PG8_SA(1, 1), a1 + hstepA, voffA);
            PG8_WAIT_L(8); PG8_BAR; PG8_WAIT_L(0); PG8_MMA(0, 0, At, B0); PG8_BAR; PG8_SCHED;
            PG8_LDB(B1, 0, 1); PG8_STAGE(PG8_SB(0, 0), b2, voffB);
            PG8_BAR; PG8_WAIT_L(0); PG8_MMA(0, 1, At, B1); PG8_BAR;
            PG8_LDA(At, 0, 1); PG8_STAGE(PG8_SA(0, 0), a2, voffA);
            PG8_BAR; PG8_WAIT_L(0); PG8_MMA(1, 0, At, B0); PG8_BAR; PG8_SCHED;
            PG8_STAGE(PG8_SB(0, 1), b2 + hstepB, voffB);
            PG8_WAIT_V(6); PG8_BAR; PG8_MMA(1, 1, At, B1); PG8_BAR;
            PG8_LDB(B0, 1, 0); PG8_SCHED; PG8_LDA(At, 1, 0); PG8_STAGE(PG8_SA(0, 1), a2 + hstepA, voffA);
            PG8_WAIT_L(8); PG8_BAR; PG8_WAIT_L(0); PG8_MMA(0, 0, At, B0); PG8_BAR; PG8_SCHED;
            PG8_LDB(B1, 1, 1); PG8_STAGE(PG8_SB(1, 0), b3, voffB);
            PG8_BAR; PG8_WAIT_L(0); PG8_MMA(0, 1, At, B1); PG8_BAR;
            PG8_LDA(At, 1, 1); PG8_STAGE(PG8_SA(1, 0), a3, voffA);
            PG8_BAR; PG8_WAIT_L(0); PG8_MMA(1, 0, At, B0); PG8_BAR; PG8_SCHED;
            PG8_STAGE(PG8_SB(1, 1), b3 + hstepB, voffB);
            PG8_WAIT_V(6); PG8_BAR; PG8_MMA(1, 1, At, B1); PG8_BAR;
            }
        }
        if constexpr (ALIGN_EPI) { if (wr == 0) PG8_BAR; }
        if constexpr (Epi::NEXT_HOOK) E(acc, cur, wr, wc, fr, fq, ui, has_next, nxt); else E(acc, cur, wr, wc, fr, fq);
        if (!has_next) break;
#pragma unroll
        for (int a = 0; a < 2; ++a)
#pragma unroll
            for (int b = 0; b < 2; ++b)
#pragma unroll
                for (int m = 0; m < 4; ++m)
#pragma unroll
                    for (int n = 0; n < 2; ++n) acc[a][b][m][n] = (f32x4){0.f, 0.f, 0.f, 0.f};
        cur = nxt; cA = nA; cB = nB; ++ui;
        if constexpr (ALIGN_EPI) { if (wr == 1) PG8_BAR; }
    }
    PG8_WAIT_V(0);
    if constexpr (!ALIGN_EPI) { if (wr == 0) PG8_BAR; }
    PG8_BAR;
#undef PG8_SA
#undef PG8_SB
#undef PG8_STAGE
#undef PG8_LDA
#undef PG8_LDB
#undef PG8_MMA
#undef PG8_WAIT_V
#undef PG8_WAIT_L
#undef PG8_BAR
#undef PG8_SCHED
}

struct EpiStoreBf16 {
    static constexpr bool NEXT_HOOK = false;
    static constexpr bool PERM = true, PERM_A = false, FP8 = false;
    bf16_t* O; int ldc; const fx64* ssq; float invk;
    __device__ __forceinline__ void operator()(const f32x4 (&acc)[2][2][4][2], const Unit& u, int wr, int wc, int fr, int fq) const {
        const int row0 = u.pm * BM + wr * 64 + fr, col0 = u.pn * BM + wc * 32 + 8 * fq;
        fx64 sv[2][4];
#pragma unroll
        for (int ai = 0; ai < 2; ++ai)
#pragma unroll
            for (int m = 0; m < 4; ++m) sv[ai][m] = ssq[row0 + ai * HALF + m * 16];
#pragma unroll
        for (int ai = 0; ai < 2; ++ai)
#pragma unroll
            for (int m = 0; m < 4; ++m) { bf16_t* rowp = O + (size_t)(row0 + ai * HALF + m * 16) * ldc + col0;
                const float rs = fast_rsq((float)sv[ai][m] * (FX_SSQ_INV * invk) + EPS);
#pragma unroll
                for (int bj = 0; bj < 2; ++bj) { const f32x4 v0 = acc[ai][bj][m][0] * rs, v1 = acc[ai][bj][m][1] * rs;
                    u32x4 w; w.x = cvt_pk_bf16(v0[0], v0[1]); w.y = cvt_pk_bf16(v0[2], v0[3]); w.z = cvt_pk_bf16(v1[0], v1[1]); w.w = cvt_pk_bf16(v1[2], v1[3]);
                    *(u32x4*)(rowp + bj * HALF) = w; } }
    }
};
struct EpiPab {
    static constexpr bool NEXT_HOOK = false;
    static constexpr bool PERM = true, PERM_A = false, FP8 = false;
    const bf16_t* proj; bf16_t* merged;
    __device__ __forceinline__ void operator()(const f32x4 (&acc)[2][2][4][2], const Unit& u, int wr, int wc, int fr, int fq) const {
        const int row0 = u.pm * BM + wr * 64 + fr, col0 = u.pn * BM + wc * 32 + 8 * fq;
        const int gcol = (u.z ? PC_GB : PC_GA) + col0;
        const bool z1 = (u.z != 0);
        u32x4 gw[2][2][2], pw[2][2][2];
#define PAB_LOAD(bt, buf) do { _Pragma("unroll") for (int mm = 0; mm < 2; ++mm) { const size_t r = (size_t)(row0 + ((bt) >> 1) * HALF + (((bt) & 1) * 2 + mm) * 16); \
            _Pragma("unroll") for (int bj = 0; bj < 2; ++bj) { gw[buf][mm][bj] = *(const u32x4*)(proj + r * NPROJ + gcol + bj * HALF); \
                pw[buf][mm][bj] = (u32x4){0u, 0u, 0u, 0u}; if (z1) pw[buf][mm][bj] = *(const u32x4*)(merged + r * DM + col0 + bj * HALF); } } } while (0)
        PAB_LOAD(0, 0);
#pragma unroll
        for (int bt = 0; bt < 4; ++bt) {
            __builtin_amdgcn_sched_barrier(0);
            if (bt + 1 < 4) { if ((bt & 1) == 0) PAB_LOAD(bt + 1, 1); else PAB_LOAD(bt + 1, 0); }
            __builtin_amdgcn_sched_barrier(0);
            const int ai = bt >> 1, buf = bt & 1;
#pragma unroll
            for (int mm = 0; mm < 2; ++mm) { const int m = (bt & 1) * 2 + mm; const size_t r = (size_t)(row0 + ai * HALF + m * 16);
#pragma unroll
                for (int bj = 0; bj < 2; ++bj) {
                    const u32x4 g = gw[buf][mm][bj], p = pw[buf][mm][bj];
                    const f32x4 v0 = acc[ai][bj][m][0], v1 = acc[ai][bj][m][1];
                    float o[8];
                    o[0] = sigmoidf_(bf_lo(g.x)) * v0[0]; o[1] = sigmoidf_(bf_hi(g.x)) * v0[1]; o[2] = sigmoidf_(bf_lo(g.y)) * v0[2]; o[3] = sigmoidf_(bf_hi(g.y)) * v0[3];
                    o[4] = sigmoidf_(bf_lo(g.z)) * v1[0]; o[5] = sigmoidf_(bf_hi(g.z)) * v1[1]; o[6] = sigmoidf_(bf_lo(g.w)) * v1[2]; o[7] = sigmoidf_(bf_hi(g.w)) * v1[3];
                    if (z1) { o[0] += bf_lo(p.x); o[1] += bf_hi(p.x); o[2] += bf_lo(p.y); o[3] += bf_hi(p.y); o[4] += bf_lo(p.z); o[5] += bf_hi(p.z); o[6] += bf_lo(p.w); o[7] += bf_hi(p.w); }
                    u32x4 w; w.x = cvt_pk_bf16(o[0], o[1]); w.y = cvt_pk_bf16(o[2], o[3]); w.z = cvt_pk_bf16(o[4], o[5]); w.w = cvt_pk_bf16(o[6], o[7]);
                    *(u32x4*)(merged + r * DM + col0 + bj * HALF) = w; } }
        }
#undef PAB_LOAD
    }
};
struct EpiResid {
    static constexpr bool NEXT_HOOK = false;
    static constexpr bool PERM = false, PERM_A = false, FP8 = false;
    const float* xsrc; float* out; const float* gate;
    __device__ __forceinline__ void operator()(const f32x4 (&acc)[2][2][4][2], const Unit& u, int wr, int wc, int fr, int fq) const {
        const int row0 = u.pm * BM + wr * 64 + fr, col0 = u.pn * BM + wc * 32 + 4 * fq;
        const float* gp = gate + (size_t)(u.pm >> 3) * NADA + col0;
        f32x4 gv[2][2];
#pragma unroll
        for (int bj = 0; bj < 2; ++bj)
#pragma unroll
            for (int n = 0; n < 2; ++n) gv[bj][n] = *(const f32x4*)(gp + bj * HALF + n * 16);
#pragma unroll
        for (int ai = 0; ai < 2; ++ai)
#pragma unroll
            for (int m = 0; m < 4; ++m) { const size_t off = (size_t)(row0 + ai * HALF + m * 16) * DM + col0;
#pragma unroll
                for (int bj = 0; bj < 2; ++bj)
#pragma unroll
                    for (int n = 0; n < 2; ++n) { const f32x4 xv = *(const f32x4*)(xsrc + off + bj * HALF + n * 16);
                        *(f32x4*)(out + off + bj * HALF + n * 16) = xv + gv[bj][n] * acc[ai][bj][m][n]; }
                if (m & 1) asm volatile("" ::: "memory"); }
    }
};

struct EpiProjNorm {
    static constexpr bool NEXT_HOOK = false;
    static constexpr bool PERM = true, PERM_A = false, FP8 = true;
    bf16_t* O; int ldc; const fx64* ssq; const fx64* bias; int ldb; LAS float* tab; fx64* ssq_lat;
    __device__ __forceinline__ void operator()(const f32x4 (&acc)[2][2][4][2], const Unit& u, int wr, int wc, int fr, int fq) const {
        { const int t = (int)threadIdx.x;
          if (t < 256) tab[t] = fast_rsq((float)ssq[u.pm * BM + t] * (FX_SSQ_INV / DM) + EPS) * W8_INV;
          else tab[t] = (float)bias[(size_t)(u.pm >> 3) * ldb + u.pn * BM + (t - 256)] * FX_BIAS_INV;
          asm volatile("s_waitcnt lgkmcnt(0)" ::: "memory"); __builtin_amdgcn_s_barrier(); asm volatile("" ::: "memory"); }
        const int rl = wr * 64 + fr, cl = wc * 32 + 8 * fq;
        const int row0 = u.pm * BM + rl, col0 = u.pn * BM + cl;
        const bool lat = (u.pn * BM >= PC_MQL && u.pn * BM < PC_GA);
        float sqr[8];
#pragma unroll
        for (int ai = 0; ai < 2; ++ai)
#pragma unroll
            for (int m = 0; m < 4; ++m) { const int row = row0 + ai * HALF + m * 16; bf16_t* rowp = O + (size_t)row * ldc + col0;
                const float rs = tab[rl + ai * HALF + m * 16];
                float sq = 0.f;
#pragma unroll
                for (int bj = 0; bj < 2; ++bj) { const f32x4 b0 = *(const LAS f32x4*)(tab + 256 + cl + bj * HALF), b1 = *(const LAS f32x4*)(tab + 256 + cl + bj * HALF + 4);
                    const f32x4 v0 = acc[ai][bj][m][0] * rs + b0, v1 = acc[ai][bj][m][1] * rs + b1;
                    if (lat) sq += v0[0] * v0[0] + v0[1] * v0[1] + v0[2] * v0[2] + v0[3] * v0[3] + v1[0] * v1[0] + v1[1] * v1[1] + v1[2] * v1[2] + v1[3] * v1[3];
                    u32x4 w; w.x = cvt_pk_bf16(v0[0], v0[1]); w.y = cvt_pk_bf16(v0[2], v0[3]); w.z = cvt_pk_bf16(v1[0], v1[1]); w.w = cvt_pk_bf16(v1[2], v1[3]);
                    *(u32x4*)(rowp + bj * HALF) = w; }
                if (lat) { sq += swz_xor<16>(sq); sq = pair32_sum(sq); }
                sqr[ai * 4 + m] = sq; }
        if (lat && fq == 0) { fx64* sl = ssq_lat + (u.pn * BM >= PC_MKVL ? MROWS : 0);
#pragma unroll
            for (int j = 0; j < 8; ++j) fx_add(sl + row0 + (j >> 2) * HALF + (j & 3) * 16, (double)sqr[j] * (double)FX_SSQ); }
        asm volatile("" ::: "memory");
    }
};
struct EpiResidNorm {
    static constexpr bool NEXT_HOOK = false;
    static constexpr bool PERM = false, PERM_A = false, FP8 = false;
    const float* xsrc; float* out; const float* gate;
    const float* gn; const float* scn; bf16_t* hn; fx64* ssq; int h8;
    __device__ __forceinline__ void operator()(const f32x4 (&acc)[2][2][4][2], const Unit& u, int wr, int wc, int fr, int fq) const {
        const int row0 = u.pm * BM + wr * 64 + fr, col0 = u.pn * BM + wc * 32 + 4 * fq;
        const float* gp = gate + (size_t)(u.pm >> 3) * NADA + col0;
        f32x4 gv[2][2], gs[2][2];
#pragma unroll
        for (int bj = 0; bj < 2; ++bj)
#pragma unroll
            for (int n = 0; n < 2; ++n) { gv[bj][n] = *(const f32x4*)(gp + bj * HALF + n * 16);
                gs[bj][n] = hn ? *(const f32x4*)(gn + col0 + bj * HALF + n * 16) * (*(const f32x4*)(scn + (size_t)(u.pm >> 3) * NADA + col0 + bj * HALF + n * 16) + 1.0f) : (f32x4){0.f, 0.f, 0.f, 0.f}; }
        f32x4 xv[3][2][2];
        float sqr[8];
#define RN_LOAD(g, buf) do { const size_t off = (size_t)(row0 + ((g) >> 2) * HALF + ((g) & 3) * 16) * DM + col0; \
            _Pragma("unroll") for (int bj = 0; bj < 2; ++bj) _Pragma("unroll") for (int n = 0; n < 2; ++n) xv[buf][bj][n] = *(const f32x4*)(xsrc + off + bj * HALF + n * 16); } while (0)
        RN_LOAD(0, 0); RN_LOAD(1, 1);
#pragma unroll
        for (int g = 0; g < 8; ++g) {
            __builtin_amdgcn_sched_barrier(0);
            if (g + 2 < 8) { if ((g + 2) % 3 == 0) RN_LOAD(g + 2, 0); else if ((g + 2) % 3 == 1) RN_LOAD(g + 2, 1); else RN_LOAD(g + 2, 2); }
            __builtin_amdgcn_sched_barrier(0);
            const int ai = g >> 2, m = g & 3, buf = g % 3;
            const int row = row0 + ai * HALF + m * 16; const size_t off = (size_t)row * DM + col0;
            float sq = 0.f;
#pragma unroll
            for (int bj = 0; bj < 2; ++bj)
#pragma unroll
                for (int n = 0; n < 2; ++n) {
                    const f32x4 o = xv[buf][bj][n] + gv[bj][n] * acc[ai][bj][m][n];
                    *(f32x4*)(out + off + bj * HALF + n * 16) = o;
                    if (hn) { sq += o[0] * o[0] + o[1] * o[1] + o[2] * o[2] + o[3] * o[3];
                        const f32x4 hv = o * gs[bj][n];
                        if (h8) *(unsigned*)((unsigned char*)hn + off + bj * HALF + n * 16) = cvt_fp8x4(hv[0], hv[1], hv[2], hv[3]);
                        else { u32x2 w; w.x = cvt_pk_bf16(hv[0], hv[1]); w.y = cvt_pk_bf16(hv[2], hv[3]); *(u32x2*)(hn + off + bj * HALF + n * 16) = w; } } }
            if (hn) { sq += swz_xor<16>(sq); sq = pair32_sum(sq); }
            sqr[g] = sq;
        }
#undef RN_LOAD
        if (hn && fq == 0) {
#pragma unroll
            for (int j = 0; j < 8; ++j) fx_add(ssq + row0 + (j >> 2) * HALF + (j & 3) * 16, (double)sqr[j] * (double)FX_SSQ); }
    }
};

template <int CTRL> __device__ __forceinline__ float dpp_old_f(float oldv, float v) { return __int_as_float(__builtin_amdgcn_update_dpp(__float_as_int(oldv), __float_as_int(v), CTRL, 0xf, 0xf, false)); }
struct EpiUpConv {
    static constexpr bool NEXT_HOOK = true;
    static constexpr bool PERM = true, PERM_A = true, FP8 = false;
    const float* wconv; const float* bconv; bf16_t* act; float* uhead; float* utail; LAS float* xb; const fx64* ssq; const fx64* bias; LAS float* tab0; LAS float* ctab0; LAS float* tab1; LAS float* ctab1;
    __device__ __forceinline__ static int xidx(int ai, int rr, int wr, int wc, int bj, int n, int fq) { return ((((((ai * 2 + rr) * 2 + wr) * 4 + wc) * 2 + bj) * 2 + n) * 4 + fq) * 4; }
    __device__ __forceinline__ void tab_load(const Unit& uu, int t, fx64& v, float& c0, float& c1) const {
        v = (t < 256) ? ssq[uu.pm * BM + t] : bias[(size_t)(uu.pm >> 3) * NUP + uu.pn * BM + (t - 256)];
        { const int e = t, tap = e >> 8, half = (e >> 7) & 1, c = e & 127; c0 = (wconv + (size_t)tap * NUP)[uu.pn * HALF + half * DFF + c]; }
        { const int e = t + 512, tap = e >> 8, half = (e >> 7) & 1, c = e & 127; const float* sp = (tap < 3) ? (wconv + (size_t)tap * NUP) : bconv; c1 = sp[uu.pn * HALF + half * DFF + c]; } }
    __device__ __forceinline__ static void tab_store(LAS float* tb, LAS float* ct, int t, fx64 v, float c0, float c1) {
        if (t < 256) tb[t] = fast_rsq((float)v * (FX_SSQ_INV / DM) + EPS); else tb[t] = (float)v * FX_BIAS_INV;
        ct[t] = c0; ct[t + 512] = c1; }
    __device__ __forceinline__ void operator()(f32x4 (&acc)[2][2][4][2], const Unit& u, int wr, int wc, int fr, int fq, int ui, bool has_next, const Unit& nxt) const {
        LAS float* tab = (ui & 1) ? tab1 : tab0; LAS float* ctab = (ui & 1) ? ctab1 : ctab0;
        const int t = ((wr * 4 + wc) << 6) + (fq << 4) + fr;
        const int colp = u.pn * BM + wc * 32 + 8 * fq;
        const int ch0 = u.pn * HALF + wc * 32 + 8 * fq;
        {
            if (ui == 0) { fx64 v; float c0, c1; tab_load(u, t, v, c0, c1); tab_store(tab, ctab, t, v, c0, c1);
                asm volatile("s_waitcnt lgkmcnt(0)" ::: "memory"); __builtin_amdgcn_s_barrier(); asm volatile("" ::: "memory"); }
            f32x4 rs[2];
#pragma unroll
            for (int ai = 0; ai < 2; ++ai) rs[ai] = *(const LAS f32x4*)(tab + ai * HALF + wr * 64 + 4 * fr);
#pragma unroll
            for (int bj = 0; bj < 2; ++bj)
#pragma unroll
                for (int n = 0; n < 2; ++n) { const f32x4 bv = *(const LAS f32x4*)(tab + 256 + wc * 32 + 8 * fq + bj * HALF + 4 * n);
#pragma unroll
                    for (int ai = 0; ai < 2; ++ai)
#pragma unroll
                        for (int m = 0; m < 4; ++m) acc[ai][bj][m][n] = acc[ai][bj][m][n] * rs[ai][m] + bv; }
        }
        fx64 nv = 0; float nc0 = 0.f, nc1 = 0.f;
        if (has_next) tab_load(nxt, t, nv, nc0, nc1);
        if (fr == 15) {
#pragma unroll
            for (int ai = 0; ai < 2; ++ai)
#pragma unroll
                for (int bj = 0; bj < 2; ++bj)
#pragma unroll
                    for (int n = 0; n < 2; ++n) { *(LAS f32x4*)(xb + xidx(ai, 0, wr, wc, bj, n, fq)) = acc[ai][bj][2][n]; *(LAS f32x4*)(xb + xidx(ai, 1, wr, wc, bj, n, fq)) = acc[ai][bj][3][n]; }
            if (wr == 1) {
#pragma unroll
                for (int bj = 0; bj < 2; ++bj)
#pragma unroll
                    for (int n = 0; n < 2; ++n) { *(f32x4*)(utail + (size_t)(u.pm * 2 + 0) * NUP + colp + bj * HALF + 4 * n) = acc[1][bj][2][n]; *(f32x4*)(utail + (size_t)(u.pm * 2 + 1) * NUP + colp + bj * HALF + 4 * n) = acc[1][bj][3][n]; }
            }
        }
        if (fr == 0 && wr == 0) {
#pragma unroll
            for (int bj = 0; bj < 2; ++bj)
#pragma unroll
                for (int n = 0; n < 2; ++n) { *(f32x4*)(uhead + (size_t)(u.pm * 2 + 0) * NUP + colp + bj * HALF + 4 * n) = acc[0][bj][0][n]; *(f32x4*)(uhead + (size_t)(u.pm * 2 + 1) * NUP + colp + bj * HALF + 4 * n) = acc[0][bj][1][n]; }
        }
        asm volatile("s_waitcnt lgkmcnt(0)" ::: "memory"); __builtin_amdgcn_s_barrier(); asm volatile("" ::: "memory");
        const bool skip01 = (wr == 0) && (fr == 0) && ((u.pm & 7) != 0);
        const LAS float* cl = ctab + wc * 32 + 8 * fq;
        f32x4 cg[4];
#pragma unroll
        for (int it = 0; it < 8; ++it) {
            const int n = it >> 2, ai = (it >> 1) & 1, bj = it & 1;
            const f32x4 w0 = *(const LAS f32x4*)(cl + (0 * 2 + bj) * 128 + 4 * n), w1 = *(const LAS f32x4*)(cl + (1 * 2 + bj) * 128 + 4 * n), w2 = *(const LAS f32x4*)(cl + (2 * 2 + bj) * 128 + 4 * n), bb = *(const LAS f32x4*)(cl + (3 * 2 + bj) * 128 + 4 * n);
            f32x4 p1 = (f32x4){0.f, 0.f, 0.f, 0.f}, p2 = p1;
            if (wr == 1 || ai == 1) {
                const int sai = (wr == 1) ? ai : 0, swr = (wr == 1) ? 0 : 1;
                p2 = *(const LAS f32x4*)(xb + xidx(sai, 0, swr, wc, bj, n, fq)); p1 = *(const LAS f32x4*)(xb + xidx(sai, 1, swr, wc, bj, n, fq));
            }
            const f32x4 v0 = acc[ai][bj][0][n], v1 = acc[ai][bj][1][n], v2 = acc[ai][bj][2][n], v3 = acc[ai][bj][3][n];
            f32x4 s3, s2;
#pragma unroll
            for (int e = 0; e < 4; ++e) { s3[e] = dpp_old_f<0x111>(p1[e], v3[e]); s2[e] = dpp_old_f<0x111>(p2[e], v2[e]); }
#pragma unroll
            for (int m = 0; m < 4; ++m) {
                const f32x4 v = (m == 0) ? v0 : (m == 1) ? v1 : (m == 2) ? v2 : v3;
                const f32x4 q1 = (m == 0) ? s3 : (m == 1) ? v0 : (m == 2) ? v1 : v2;
                const f32x4 q2 = (m == 0) ? s2 : (m == 1) ? s3 : (m == 2) ? v0 : v1;
                const f32x4 cvv = bb + w0 * q2 + w1 * q1 + w2 * v;
                if (bj == 0) cg[m] = cvv;
                else {
                    float o[4];
#pragma unroll
                    for (int e = 0; e < 4; ++e) { const float g = cg[m][e]; o[e] = g * sigmoidf_(g) * cvv[e]; }
                    u32x2 ow; ow.x = cvt_pk_bf16(o[0], o[1]); ow.y = cvt_pk_bf16(o[2], o[3]);
                    const int row = u.pm * BM + ai * HALF + wr * 64 + 4 * fr + m;
                    if (!(skip01 && ai == 0 && m < 2)) *(u32x2*)(act + (size_t)row * DFF + ch0 + 4 * n) = ow;
                }
            }
        }
        if (has_next) tab_store((ui & 1) ? tab0 : tab1, (ui & 1) ? ctab0 : ctab1, t, nv, nc0, nc1);
    }
};
}

struct Args { const void* in[23]; float* out; unsigned char* ws; float inv_a[16]; float inv_i[8]; float inv_m[32]; int ph_lo, ph_hi; };
static_assert(sizeof(Args) == 23 * 8 + 16 + 56 * 4 + 8, "Args has no padding");

typedef const __attribute__((address_space(4))) struct Args* ArgsCP;
struct Frame {
    LAS unsigned char* lds; int tid, lane, wave, G, bid;
    unsigned char* ws; ArgsCP a;
};

__device__ __forceinline__ void sincos_d(double a, float& s, float& c) {
    const double q = __builtin_rint(a * 0.63661977236758134308);
    double r = __builtin_fma(-q, 1.57079632673412561417e+00, a);
    r = __builtin_fma(-q, 6.07710050650619224932e-11, r);
    const double r2 = r * r;
    double sp = -7.6471637318198164759e-13; sp = sp * r2 + 1.6059043836821614599e-10; sp = sp * r2 - 2.5052108385441718775e-08; sp = sp * r2 + 2.7557319223985890653e-06;
    sp = sp * r2 - 1.9841269841269841270e-04; sp = sp * r2 + 8.3333333333333333333e-03; sp = sp * r2 - 1.6666666666666666667e-01; const double sr = r + r * r2 * sp;
    double cp = 4.7794773323873852974e-14; cp = cp * r2 - 1.1470745597729724714e-11; cp = cp * r2 + 2.0876756987868098979e-09; cp = cp * r2 - 2.7557319223985890653e-07;
    cp = cp * r2 + 2.4801587301587301587e-05; cp = cp * r2 - 1.3888888888888888889e-03; cp = cp * r2 + 4.1666666666666666667e-02; cp = cp * r2 - 0.5; const double cr = 1.0 + r2 * cp;
    const int qi = ((int)q) & 3;
    const double sv = (qi == 0) ? sr : (qi == 1) ? cr : (qi == 2) ? -sr : -cr;
    const double cv = (qi == 0) ? cr : (qi == 1) ? -sr : (qi == 2) ? -cr : sr;
    s = (float)sv; c = (float)cv;
}

__device__ __forceinline__ int cmap_in(int n) {
    if (n < 2640) return n;
    if (n < 2704) return 3408 + (n - 2640);
    if (n < 2816) return -1;
    if (n < 3328) return 2640 + (n - 2816);
    if (n < 3584) return 3152 + (n - 3328);
    return 3472 + (n - 3584);
}
__device__ __forceinline__ int cmap_up(int n) { const int j = n >> 8, w = n & 255; return (w < 128) ? (128 * j + w) : (DFF + 128 * j + (w - 128)); }

struct TileDesc { const float* src; bf16_t* dst; const float* shift; fx64* bias; const float* gk; int ldsrc, K, k0, n0, mode, ldbias; float w8; };
__device__ __forceinline__ void tile_load(const Frame& F, const TileDesc& d, f32x4 (&v)[8], float& shv) {
    const int a = F.tid >> 5, n4 = F.tid & 31; const int n = d.n0 + 4 * n4;
    const int c = (d.mode == 0) ? n : (d.mode == 1) ? cmap_in(n) : cmap_up(n);
#pragma unroll
    for (int i = 0; i < 8; ++i) v[i] = (c >= 0) ? *(const f32x4*)(d.src + (size_t)(d.k0 + 8 * a + i) * d.ldsrc + c) : (f32x4){0.f, 0.f, 0.f, 0.f};
    shv = d.bias ? d.shift[(size_t)(F.tid >> 7) * NADA + d.k0 + (F.tid & 127)] : 0.f;
}
constexpr int TR_SH = 69632, TR_RED = 73728;
__device__ __forceinline__ void tile_to_lds(const Frame& F, const TileDesc& d, const f32x4 (&v)[8], float shv) {
    LAS unsigned char* O = F.lds;
    const int a = F.tid >> 5, n4 = F.tid & 31;
    if (d.w8 != 0.f) {
        const int pos = a ^ ((n4 & 7) << 1);
#pragma unroll
        for (int e = 0; e < 4; ++e) { u32x2 w; w.x = cvt_fp8x4(v[0][e] * d.w8, v[1][e] * d.w8, v[2][e] * d.w8, v[3][e] * d.w8); w.y = cvt_fp8x4(v[4][e] * d.w8, v[5][e] * d.w8, v[6][e] * d.w8, v[7][e] * d.w8);
            *(LAS u32x2*)(O + (4 * n4 + e) * 128 + pos * 8) = w; }
    } else {
        const int pos = a ^ (n4 & 15);
        f32x4 g0 = (f32x4){1.f, 1.f, 1.f, 1.f}, g1 = g0;
        if (d.gk) { g0 = *(const f32x4*)(d.gk + d.k0 + 8 * a); g1 = *(const f32x4*)(d.gk + d.k0 + 8 * a + 4); }
#pragma unroll
        for (int e = 0; e < 4; ++e) { u32x4 w; w.x = cvt_pk_bf16(v[0][e] * g0[0], v[1][e] * g0[1]); w.y = cvt_pk_bf16(v[2][e] * g0[2], v[3][e] * g0[3]); w.z = cvt_pk_bf16(v[4][e] * g1[0], v[5][e] * g1[1]); w.w = cvt_pk_bf16(v[6][e] * g1[2], v[7][e] * g1[3]);
            *(LAS u32x4*)(O + (4 * n4 + e) * 256 + pos * 16) = w; }
    }
    if (d.bias) ((LAS float*)(F.lds + TR_SH))[F.tid] = shv;
}
__device__ __forceinline__ void tile_bias(const Frame& F, const TileDesc& d, const f32x4 (&v)[8], float (&pb)[16]) {
#pragma unroll
    for (int x = 0; x < 16; ++x) pb[x] = 0.f;
    if (d.bias) { const LAS float* SH = (const LAS float*)(F.lds + TR_SH); const int a = F.tid >> 5;
#pragma unroll
        for (int b = 0; b < 4; ++b) { const f32x4 s0 = *(const LAS f32x4*)(SH + b * 128 + 8 * a), s1 = *(const LAS f32x4*)(SH + b * 128 + 8 * a + 4);
#pragma unroll
            for (int e = 0; e < 4; ++e) pb[b * 4 + e] = v[0][e] * s0[0] + v[1][e] * s0[1] + v[2][e] * s0[2] + v[3][e] * s0[3] + v[4][e] * s1[0] + v[5][e] * s1[1] + v[6][e] * s1[2] + v[7][e] * s1[3]; } }
}
__device__ __forceinline__ void tile_finish(const Frame& F, const TileDesc& d, float (&pb)[16]) {
    const LAS unsigned char* O = F.lds; LAS float* RED = (LAS float*)(F.lds + TR_RED);
    if (d.bias) {
#pragma unroll
        for (int x = 0; x < 16; ++x) pb[x] = pair32_sum(pb[x]);
        if (F.lane < 32) {
#pragma unroll
            for (int b = 0; b < 4; ++b) *(LAS f32x4*)(RED + (F.wave * 4 + b) * 128 + 4 * F.lane) = (f32x4){pb[b * 4 + 0], pb[b * 4 + 1], pb[b * 4 + 2], pb[b * 4 + 3]}; }
    }
    if (d.w8 != 0.f) {
#pragma unroll
        for (int p = 0; p < 2; ++p) { const int n = 64 * p + (F.tid >> 3), c16 = F.tid & 7; const int m = c16 ^ ((n >> 2) & 7);
            const u32x4 w = *(const LAS u32x4*)(O + n * 128 + m * 16);
            *(u32x4*)((unsigned char*)d.dst + (size_t)(d.n0 + n) * d.K + d.k0 + 16 * c16) = w; }
    } else {
#pragma unroll
        for (int p = 0; p < 4; ++p) { const int n = 32 * p + (F.tid >> 4), c = F.tid & 15; const int pos = c ^ ((n >> 2) & 15);
            const u32x4 w = *(const LAS u32x4*)(O + n * 256 + pos * 16);
            *(u32x4*)(d.dst + (size_t)(d.n0 + n) * d.K + d.k0 + 8 * c) = w; }
    }
    if (d.bias) {
        __syncthreads();
        const int b = F.tid >> 7, n = F.tid & 127;
        float sum = 0.f;
#pragma unroll
        for (int w = 0; w < 8; ++w) sum += RED[(w * 4 + b) * 128 + n];
        fx_add(d.bias + (size_t)b * d.ldbias + d.n0 + n, (double)sum * FX_BIAS);
    }
}

constexpr int TR_IN = 960, TR_MQ = 48, TR_MKV = 32, TR_PA = 128, TR_PB = 128, TR_WO = 256, TR_UP = 1408, TR_DN = 704;
constexpr int TR_C1 = TR_IN, TR_C2 = TR_C1 + TR_MQ, TR_C3 = TR_C2 + TR_MKV, TR_C4 = TR_C3 + TR_PA, TR_C5 = TR_C4 + TR_PB, TR_C6 = TR_C5 + TR_WO, TR_C7 = TR_C6 + TR_UP, TR_C8 = TR_C7 + TR_DN;
__device__ __forceinline__ TileDesc tr_make(const Frame& F, const int l, const int r) {
    ArgsCP ap = F.a; unsigned char* ws = F.ws;
    const float* modl = (const float*)(ws + WS_MOD) + (size_t)l * NBATCH * NADA;
    fx64* bias_in = (fx64*)(ws + WS_BIAS); fx64* bias_up = (fx64*)(ws + WS_BIAS_UP);
    TileDesc d; d.shift = nullptr; d.bias = nullptr; d.gk = nullptr; d.ldbias = 0; d.mode = 0; d.w8 = 0.f;
    if (r < TR_C1) { const int ti = r; d.src = (const float*)ap->in[7] + (size_t)l * DM * IN_DIM; d.ldsrc = IN_DIM; d.K = DM; d.dst = (bf16_t*)(ws + WS_WIN + (size_t)l * NPROJ * DM); d.w8 = W8_SCALE; d.k0 = (ti / 60) * 128; d.n0 = (ti % 60) * 128; d.mode = 1; d.shift = modl; d.bias = bias_in + (size_t)l * NBATCH * NPROJ; d.ldbias = NPROJ; }
    else if (r < TR_C2) { const int ti = r - TR_C1; d.src = (const float*)ap->in[11] + (size_t)l * 512 * 1536; d.ldsrc = 1536; d.K = 512; d.dst = (bf16_t*)(ws + WS_WMQ) + (size_t)l * 1536 * 512; d.k0 = (ti / 12) * 128; d.n0 = (ti % 12) * 128; d.gk = (const float*)ap->in[10] + l * 512; }
    else if (r < TR_C3) { const int ti = r - TR_C2; d.src = (const float*)ap->in[13] + (size_t)l * 256 * 2048; d.ldsrc = 2048; d.K = 256; d.dst = (bf16_t*)(ws + WS_WMKV) + (size_t)l * 2048 * 256; d.k0 = (ti / 16) * 128; d.n0 = (ti % 16) * 128; d.gk = (const float*)ap->in[12] + l * 256; }
    else if (r < TR_C4) { const int ti = r - TR_C3; d.src = (const float*)ap->in[16] + (size_t)l * 1024 * 2048; d.ldsrc = 2048; d.K = 1024; d.dst = (bf16_t*)(ws + WS_WPAB) + (size_t)l * 4096 * 1024; d.k0 = (ti / 16) * 128; d.n0 = (ti % 16) * 128; }
    else if (r < TR_C5) { const int ti = r - TR_C4; d.src = (const float*)ap->in[17] + (size_t)l * 1024 * 2048; d.ldsrc = 2048; d.K = 1024; d.dst = (bf16_t*)(ws + WS_WPAB) + (size_t)l * 4096 * 1024 + (size_t)2048 * 1024; d.k0 = (ti / 16) * 128; d.n0 = (ti % 16) * 128; }
    else if (r < TR_C6) { const int ti = r - TR_C5; d.src = (const float*)ap->in[18] + (size_t)l * 2048 * 2048; d.ldsrc = 2048; d.K = 2048; d.dst = (bf16_t*)(ws + WS_WO) + (size_t)l * 2048 * 2048; d.k0 = (ti / 16) * 128; d.n0 = (ti % 16) * 128; }
    else if (r < TR_C7) { const int ti = r - TR_C6; d.src = (const float*)ap->in[19] + (size_t)l * DM * NUP; d.ldsrc = NUP; d.K = DM; d.dst = (bf16_t*)(ws + WS_WUP) + (size_t)l * NUP * DM; d.k0 = (ti / 88) * 128; d.n0 = (ti % 88) * 128; d.mode = 2; d.shift = modl + 3 * DM; d.bias = bias_up + (size_t)l * NBATCH * NUP; d.ldbias = NUP; }
    else { const int ti = r - TR_C7; d.src = (const float*)ap->in[22] + (size_t)l * DFF * DM; d.ldsrc = DM; d.K = DFF; d.dst = (bf16_t*)(ws + WS_WDN) + (size_t)l * DM * DFF; d.k0 = (ti / 16) * 128; d.n0 = (ti % 16) * 128; }
    return d;
}
template <class Map>
__device__ __forceinline__ void tr_run(const Frame& F, const int n, const Map& map) {
    int k = 0;
    bool hasA = 0 < n, hasB = 1 < n;
    TileDesc dA, dB; f32x4 vA[8], vB[8]; float sA = 0.f, sB = 0.f;
    if (hasA) { int l, r; map(0, l, r); dA = tr_make(F, l, r); tile_load(F, dA, vA, sA); }
    if (hasB) { int l, r; map(1, l, r); dB = tr_make(F, l, r); tile_load(F, dB, vB, sB); }
#pragma unroll 1
    while (hasA) {
        __syncthreads();
        tile_to_lds(F, dA, vA, sA);
        __syncthreads();
        { const TileDesc dc = dA; hasA = k + 2 < n; float pb[16]; tile_bias(F, dc, vA, pb);
          if (hasA) { int l, r; map(k + 2, l, r); dA = tr_make(F, l, r); tile_load(F, dA, vA, sA); }
          tile_finish(F, dc, pb); }
        if (!hasB) break;
        __syncthreads();
        tile_to_lds(F, dB, vB, sB);
        __syncthreads();
        { const TileDesc dc = dB; hasB = k + 3 < n; float pb[16]; tile_bias(F, dc, vB, pb);
          if (hasB) { int l, r; map(k + 3, l, r); dB = tr_make(F, l, r); tile_load(F, dB, vB, sB); }
          tile_finish(F, dc, pb); }
        k += 2;
    }
    __syncthreads();
}
constexpr int LATE_UP = 7, LATE_IN = 3;
__device__ __forceinline__ int late_up_tiles(int G) { const int rem = ((MROWS / 256) * (NUP / 256)) % G; if (rem == 0) return 0; const int t = (G - rem) * LATE_UP; return t < TR_UP ? t : TR_UP; }
__device__ __forceinline__ int late_in_tiles(int G) { const int rem = ((MROWS / 256) * (NPROJ / 256)) % G; if (rem == 0) return 0; const int t = (G - rem) * LATE_IN, left = TR_UP - late_up_tiles(G); return t < left ? t : left; }
struct TrMapPrologue { int bid, G, late;
    __device__ __forceinline__ void operator()(int k, int& l, int& r) const { const int j = bid + k * G, early = TR_C8 - late;
        if (j < TR_C8) { l = 0; r = j; } else { const int jj = j - TR_C8; l = 1 + jj / early; r = jj % early; if (r >= TR_C6) r += late; } } };
struct TrMapLate { int l1, first, stride;
    __device__ __forceinline__ void operator()(int k, int& l, int& r) const { l = l1; r = TR_C6 + first + k * stride; } };
__device__ __forceinline__ void tr_late(const Frame& F, int l1, int ntiles_phase, int base, int count, int per) {
    const int rem = ntiles_phase % F.G;
    if (rem == 0 || F.bid < rem || count <= 0) return;
    const int nshort = F.G - rem, first = F.bid - rem;
    int n = (count - first + nshort - 1) / nshort; if (n > per) n = per; if (n <= 0) return;
    const TrMapLate map{l1, base + first, nshort};
    tr_run(F, n, map);
}

__device__ __forceinline__ void p0a_prologue(const Frame& F) {
    ArgsCP ap = F.a;
    unsigned char* ws = F.ws;
    {
        LAS float* CAct = (LAS float*)F.lds;
        LAS float* RED = (LAS float*)(F.lds + 32768);
        const float* c = (const float*)ap->in[1];
        for (int i = F.tid; i < NBATCH * DM; i += 512) { const float x = c[i]; CAct[i] = x * sigmoidf_(x); }
        __syncthreads();
        const float* w_ada = (const float*)ap->in[5]; const float* b_ada = (const float*)ap->in[6];
        float* mod = (float*)(ws + WS_MOD);
        const int rg = F.lane >> 4, cq = F.lane & 15;
        for (int it = F.bid; it < DEPTH * (NADA / 64); it += F.G) {
            const int l = it / (NADA / 64), n0 = (it % (NADA / 64)) * 64;
            const float* wp = w_ada + (size_t)l * DM * NADA + n0 + 4 * cq;
            const int kb = F.wave * 256 + rg * 64;
            f32x4 acc[4];
#pragma unroll
            for (int b = 0; b < 4; ++b) acc[b] = (f32x4){0.f, 0.f, 0.f, 0.f};
            for (int i0 = 0; i0 < 64; i0 += 16) {
                f32x4 wv[16];
#pragma unroll
                for (int i = 0; i < 16; ++i) wv[i] = *(const f32x4*)(wp + (size_t)(kb + i0 + i) * NADA);
#pragma unroll
                for (int i = 0; i < 16; ++i) {
#pragma unroll
                    for (int b = 0; b < 4; ++b) acc[b] += CAct[b * DM + kb + i0 + i] * wv[i]; }
            }
#pragma unroll
            for (int b = 0; b < 4; ++b)
#pragma unroll
                for (int j = 0; j < 4; ++j) { float v = acc[b][j]; v += swz_xor<16>(v); v = pair32_sum(v); acc[b][j] = v; }
            if (rg == 0) {
#pragma unroll
                for (int b = 0; b < 4; ++b) *(LAS f32x4*)(RED + (F.wave * 4 + b) * 64 + 4 * cq) = acc[b]; }
            __syncthreads();
            if (F.tid < 256) { const int b = F.tid >> 6, col = F.tid & 63; float s = b_ada[(size_t)l * NADA + n0 + col];
#pragma unroll
                for (int w = 0; w < 8; ++w) s += RED[(w * 4 + b) * 64 + col];
                mod[((size_t)l * NBATCH + b) * NADA + n0 + col] = s; }
            __syncthreads();
        }
    }
    {
        const int* pos = (const int*)ap->in[2];
        float* CA = (float*)(ws + WS_ROPE); float* SA = CA + MROWS * 16; float* CI = SA + MROWS * 16; float* SI = CI + MROWS * 8; float* CM = SI + MROWS * 8; float* SM = CM + MROWS * 32;
        for (int i = F.bid * 512 + F.tid; i < MROWS * 56; i += F.G * 512) {
            const int r = i / 56, j = i % 56;
            const float p = (float)pos[r];
            float inv; float* cd; float* sd;
            if (j < 16) { inv = ap->inv_a[j]; cd = CA + r * 16 + j; sd = SA + r * 16 + j; }
            else if (j < 24) { inv = ap->inv_i[j - 16]; cd = CI + r * 8 + (j - 16); sd = SI + r * 8 + (j - 16); }
            else { inv = ap->inv_m[j - 24]; cd = CM + r * 32 + (j - 24); sd = SM + r * 32 + (j - 24); }
            const float ang = p * inv;
            float s, c; sincos_d((double)ang, s, c);
            *cd = c; *sd = s;
        }
    }
}

__device__ __forceinline__ void p0b_prologue(const Frame& F) {
    ArgsCP ap = F.a;
    unsigned char* ws = F.ws;
    const float* mod = (const float*)(ws + WS_MOD);
    {
        const float* x = (const float*)ap->in[0]; const float* g = (const float*)ap->in[3];
        unsigned char* h8 = ws + WS_H8; fx64* ssq = (fx64*)(ws + WS_SSQ);
        const int stride = F.G * 8;
        f32x4 gv[8];
#pragma unroll
        for (int i = 0; i < 8; ++i) gv[i] = *(const f32x4*)(g + (i * 64 + F.lane) * 4);
        for (int row0 = F.bid * 8 + F.wave; row0 < MROWS; row0 += 4 * stride) {
            f32x4 v[4][8];
#pragma unroll
            for (int k = 0; k < 4; ++k) { const int row = row0 + k * stride;
                if (row < MROWS) {
#pragma unroll
                    for (int i = 0; i < 8; ++i) v[k][i] = *(const f32x4*)(x + (size_t)row * DM + (i * 64 + F.lane) * 4); } }
#pragma unroll
            for (int k = 0; k < 4; ++k) { const int row = row0 + k * stride;
                if (row < MROWS) {
                    const float* mp = mod + (size_t)(row >> 11) * NADA + DM;
                    f32x4 sc[8];
#pragma unroll
                    for (int i = 0; i < 8; ++i) sc[i] = *(const f32x4*)(mp + (i * 64 + F.lane) * 4);
                    __builtin_amdgcn_sched_barrier(0);
                    float ss = 0.f;
#pragma unroll
                    for (int i = 0; i < 8; ++i) ss += v[k][i][0] * v[k][i][0] + v[k][i][1] * v[k][i][1] + v[k][i][2] * v[k][i][2] + v[k][i][3] * v[k][i][3];
                    ss = wave_sum(ss);
                    if (F.lane == 0) ssq[row] = (fx64)__builtin_rint((double)ss * (double)FX_SSQ);
#pragma unroll
                    for (int i = 0; i < 8; ++i) { const int c = (i * 64 + F.lane) * 4;
                        const f32x4 y = v[k][i] * gv[i] * (sc[i] + 1.0f);
                        *(unsigned*)(h8 + (size_t)row * DM + c) = cvt_fp8x4(y[0], y[1], y[2], y[3]); }
                } }
        }
    }
    {
        const int late = late_up_tiles(F.G) + late_in_tiles(F.G);
        const int NT = TR_C8 + (DEPTH - 1) * (TR_C8 - late);
        const TrMapPrologue map{F.bid, F.G, late};
        tr_run(F, (NT - F.bid + F.G - 1) / F.G, map);
        __syncthreads();
    }
}

__device__ __forceinline__ void phase_norm(const Frame& F, const float* x, const float* g, const float* modl  , int sh_off, int sc_off, bf16_t* h) {
    const int stride = F.G * 8;
    for (int row0 = F.bid * 8 + F.wave; row0 < MROWS; row0 += 4 * stride) {
        f32x4 v[4][8];
#pragma unroll
        for (int k = 0; k < 4; ++k) { const int row = row0 + k * stride;
            if (row < MROWS) {
#pragma unroll
                for (int i = 0; i < 8; ++i) v[k][i] = *(const f32x4*)(x + (size_t)row * DM + (i * 64 + F.lane) * 4); } }
#pragma unroll
        for (int k = 0; k < 4; ++k) { const int row = row0 + k * stride;
            if (row < MROWS) {
                const int b = row >> 11;
                float ss = 0.f;
#pragma unroll
                for (int i = 0; i < 8; ++i) ss += v[k][i][0] * v[k][i][0] + v[k][i][1] * v[k][i][1] + v[k][i][2] * v[k][i][2] + v[k][i][3] * v[k][i][3];
                ss = wave_sum(ss);
                const float rs = fast_rsq(ss * (1.0f / DM) + EPS);
                const float* mp = modl + (size_t)b * NADA;
#pragma unroll
                for (int i = 0; i < 8; ++i) { const int c = (i * 64 + F.lane) * 4;
                    const f32x4 gv = *(const f32x4*)(g + c), sc = *(const f32x4*)(mp + sc_off + c), sh = *(const f32x4*)(mp + sh_off + c);
                    const f32x4 y = (v[k][i] * rs) * gv * (sc + 1.0f) + sh;
                    u32x2 w; w.x = cvt_pk_bf16(y[0], y[1]); w.y = cvt_pk_bf16(y[2], y[3]);
                    *(u32x2*)(h + (size_t)row * DM + c) = w; }
            } }
    }
}

__device__ __forceinline__ void vt_load(const Frame& F, const bf16_t* src  , int lds_, u32x4& a0, u32x4& a1) {
    const int sl = F.tid >> 3, dq = F.tid & 7;
    a0 = *(const u32x4*)(src + (size_t)sl * lds_ + dq * 16); a1 = *(const u32x4*)(src + (size_t)sl * lds_ + dq * 16 + 8);
}
__device__ __forceinline__ void vt_finish(const Frame& F, const u32x4 a0, const u32x4 a1, bf16_t* dst  ) {
    LAS bf16_t* T = (LAS bf16_t*)F.lds;
    const int sl = F.tid >> 3, dq = F.tid & 7;
    __syncthreads();
    *(LAS u32x4*)(T + sl * 136 + dq * 16) = a0; *(LAS u32x4*)(T + sl * 136 + dq * 16 + 8) = a1;
    __syncthreads();
    const int d = F.tid >> 2, sq = F.tid & 3;
    unsigned w[8];
#pragma unroll
    for (int i = 0; i < 8; ++i) { const int p = 2 * i, sa = (p & 3) | ((p & 4) << 1) | ((p & 8) >> 1);
        const unsigned lo = T[(sq * 16 + sa) * 136 + d], hi = T[(sq * 16 + sa + 1) * 136 + d]; w[i] = lo | (hi << 16); }
    bf16_t* dp = dst + (size_t)d * SEQ + sq * 16;
    *(u32x4*)dp = (u32x4){w[0], w[1], w[2], w[3]}; *(u32x4*)(dp + 8) = (u32x4){w[4], w[5], w[6], w[7]};
}
__device__ __forceinline__ void vt_tile(const Frame& F, const bf16_t* src, int lds_, bf16_t* dst) { u32x4 a0, a1; vt_load(F, src, lds_, a0, a1); vt_finish(F, a0, a1, dst); }

__device__ __forceinline__ void phase_post1(const Frame& F, int l) {
    ArgsCP ap = F.a; unsigned char* ws = F.ws;
    const bf16_t* proj = (const bf16_t*)(ws + WS_PROJ);
    bf16_t* QA = (bf16_t*)(ws + WS_QA); bf16_t* KA = (bf16_t*)(ws + WS_KA); bf16_t* QI = (bf16_t*)(ws + WS_QI); bf16_t* KI = (bf16_t*)(ws + WS_KI);
    float* WI = (float*)(ws + WS_WI);
    const float* CA = (const float*)(ws + WS_ROPE); const float* SA = CA + MROWS * 16; const float* CI = SA + MROWS * 16; const float* SI = CI + MROWS * 8;
    const float* g_qa = (const float*)ap->in[8] + l * 128; const float* g_ka = (const float*)ap->in[9] + l * 128;
    const int L = F.lane;
    const float qscale = 0.08838834764831845f * LOG2E;
    const float gq0 = g_qa[2 * L], gq1 = g_qa[2 * L + 1], gk0 = g_ka[2 * L], gk1 = g_ka[2 * L + 1];
    const int Lh = L & 31;
#define P1_LOAD(R, r_) do { const int rr_ = (r_); const bf16_t* p = proj + (size_t)rr_ * NPROJ; \
        _Pragma("unroll") for (int hh = 0; hh < 10; ++hh) R.wqk[hh] = *(const unsigned*)(p + hh * 128 + 2 * L); \
        _Pragma("unroll") for (int ch = 0; ch < 9; ++ch) { R.wqi[ch] = 0u; if (ch < 8 || L < 32) R.wqi[ch] = *(const unsigned*)(p + PC_QI + ch * 128 + 2 * L); }       \
        R.c0 = 0.f; R.c1 = 0.f; R.s0 = 0.f; R.s1 = 0.f; \
        if (L < 16) { const int dd = 2 * (L & 7); R.c0 = CA[rr_ * 16 + dd]; R.c1 = CA[rr_ * 16 + dd + 1]; R.s0 = SA[rr_ * 16 + dd]; R.s1 = SA[rr_ * 16 + dd + 1]; } \
        R.ci0 = 0.f; R.ci1 = 0.f; R.si0 = 0.f; R.si1 = 0.f; \
        if (Lh < 8) { const int dd = 2 * (Lh & 3); R.ci0 = CI[rr_ * 8 + dd]; R.ci1 = CI[rr_ * 8 + dd + 1]; R.si0 = SI[rr_ * 8 + dd]; R.si1 = SI[rr_ * 8 + dd + 1]; } \
        R.wi = 0; if (L < 16) R.wi = p[PC_WI + L]; } while (0)
#define P1_ROW(R, r_) do { const int r = (r_); \
          \
        { const float c0 = R.c0, c1 = R.c1, s0 = R.s0, s1 = R.s1; \
        _Pragma("unroll") for (int hh = 0; hh < 10; ++hh) { \
            const unsigned w = R.wqk[hh]; \
            const float a0 = bf_lo(w), a1 = bf_hi(w); \
            const float ss = wave_sum(a0 * a0 + a1 * a1); \
            const float rs = fast_rsq(ss * (1.0f / 128.0f) + EPS); \
            float y0 = a0 * rs * (hh < 8 ? gq0 : gk0), y1 = a1 * rs * (hh < 8 ? gq1 : gk1); \
            const float o0 = swz_xor<8>(y0), o1 = swz_xor<8>(y1); \
            if (L < 8) { y0 = y0 * c0 - o0 * s0; y1 = y1 * c1 - o1 * s1; } \
            else if (L < 16) { y0 = y0 * c0 + o0 * s0; y1 = y1 * c1 + o1 * s1; } \
            if (hh < 8) *(unsigned*)(QA + (size_t)r * 1024 + hh * 128 + 2 * L) = cvt_pk_bf16(y0 * qscale, y1 * qscale); \
            else *(unsigned*)(KA + (size_t)r * 256 + (hh - 8) * 128 + 2 * L) = cvt_pk_bf16(y0, y1); \
        } } \
          \
        { const float ci0 = R.ci0, ci1 = R.ci1, si0 = R.si0, si1 = R.si1; \
        _Pragma("unroll") for (int ch = 0; ch < 9; ++ch) { \
            const unsigned w = R.wqi[ch]; \
            float y0 = bf_lo(w), y1 = bf_hi(w); \
            const float o0 = swz_xor<4>(y0), o1 = swz_xor<4>(y1); \
            if (Lh < 4) { y0 = y0 * ci0 - o0 * si0; y1 = y1 * ci1 - o1 * si1; } \
            else if (Lh < 8) { y0 = y0 * ci0 + o0 * si0; y1 = y1 * ci1 + o1 * si1; } \
              \
              \
            const int fo = (Lh >> 4) * 512 + (((Lh >> 2) & 3) * 16 + (r & 15)) * 8 + 2 * (Lh & 3); \
            if (ch < 8) *(unsigned*)(QI + (size_t)(r & ~15) * 1024 + (ch * 2 + (L >> 5)) * 1024 + fo) = cvt_pk_bf16(y0, y1); \
            else if (L < 32) *(unsigned*)(KI + (size_t)(r & ~15) * 64 + fo) = cvt_pk_bf16(y0, y1); \
        } } \
          \
        if (L < 16) WI[(size_t)r * 16 + L] = bf1(R.wi) * 0.03125f; \
        } while (0)
    {
        struct P1Row { unsigned wqk[10], wqi[9]; float c0, c1, s0, s1, ci0, ci1, si0, si1; bf16_t wi; };
        const int step = F.G * 8; int r0 = F.bid * 8 + F.wave;
        if (r0 < MROWS) {
            P1Row A, B;
            P1_LOAD(A, r0);
#pragma unroll 1
            for (;;) {
                const int rb = r0 + step; const bool hb = rb < MROWS;
                __builtin_amdgcn_sched_barrier(0);
                P1_LOAD(B, hb ? rb : r0);
                __builtin_amdgcn_sched_barrier(0);
                P1_ROW(A, r0);
                if (!hb) break;
                const int ra = rb + step; const bool ha = ra < MROWS;
                __builtin_amdgcn_sched_barrier(0);
                P1_LOAD(A, ha ? ra : rb);
                __builtin_amdgcn_sched_barrier(0);
                P1_ROW(B, rb);
                if (!ha) break;
                r0 = ra;
            }
        }
    }
#undef P1_LOAD
#undef P1_ROW
    bf16_t* VAT = (bf16_t*)(ws + WS_VAT);
    for (int it = F.bid; it < NBATCH * 2 * (SEQ / 64); it += F.G) {
        const int sb = it % (SEQ / 64), g = (it / (SEQ / 64)) & 1, b = it / (2 * (SEQ / 64));
        vt_tile(F, proj + (size_t)(b * SEQ + sb * 64) * NPROJ + PC_VA + g * 128, NPROJ, VAT + (size_t)(b * 2 + g) * 128 * SEQ + sb * 64);
    }
    __syncthreads();
}

__device__ __forceinline__ void phase_post2(const Frame& F, int l) {
    ArgsCP ap = F.a; unsigned char* ws = F.ws;
    const bf16_t* proj = (const bf16_t*)(ws + WS_PROJ); const bf16_t* MQ = (const bf16_t*)(ws + WS_MQ); const bf16_t* MKV = (const bf16_t*)(ws + WS_MKV);
    bf16_t* QM = (bf16_t*)(ws + WS_QM); bf16_t* KM = (bf16_t*)(ws + WS_KM);
    const float* CM = (const float*)(ws + WS_ROPE) + MROWS * 48; const float* SM = CM + MROWS * 32;
    const float* g_qm = (const float*)ap->in[14] + l * 192; const float* g_km = (const float*)ap->in[15] + l * 192;
    const int L = F.lane;
    const float qscale = 0.07216878364870322f * LOG2E;
    const int Lr = L & 31, Lc = L & 15;
    const float gqn0 = g_qm[2 * L], gqn1 = g_qm[2 * L + 1], gqr0 = g_qm[128 + 2 * Lr], gqr1 = g_qm[128 + 2 * Lr + 1];
    const float gkn0 = g_km[2 * L], gkn1 = g_km[2 * L + 1], gkr0 = g_km[128 + 2 * Lr], gkr1 = g_km[128 + 2 * Lr + 1];
#define P2_LOAD(R, r_) do { const int rr_ = (r_); \
        R.c0 = CM[rr_ * 32 + 2 * Lc]; R.c1 = CM[rr_ * 32 + 2 * Lc + 1]; R.s0 = SM[rr_ * 32 + 2 * Lc]; R.s1 = SM[rr_ * 32 + 2 * Lc + 1]; \
        R.kr = *(const unsigned*)(proj + (size_t)rr_ * NPROJ + PC_MKR + 2 * Lr); \
        _Pragma("unroll") for (int h = 0; h < 8; ++h) { const bf16_t* qp = MQ + (size_t)rr_ * 1536 + h * 192; const bf16_t* kp = MKV + (size_t)rr_ * 2048 + h * 256; \
            R.qn[h] = *(const unsigned*)(qp + 2 * L); R.qr[h] = *(const unsigned*)(qp + 128 + 2 * Lr); R.kn[h] = *(const unsigned*)(kp + 2 * L); } } while (0)
#define P2_HEAD(wn_, wr_, gn0_, gn1_, gr0_, gr1_, sc_, dst_) do { \
        const float a0 = bf_lo(wn_), a1 = bf_hi(wn_); const float b0 = (L < 32) ? bf_lo(wr_) : 0.f, b1 = (L < 32) ? bf_hi(wr_) : 0.f; \
        const float ss = wave_sum(a0 * a0 + a1 * a1 + b0 * b0 + b1 * b1); \
        const float rs = fast_rsq(ss * (1.0f / 192.0f) + EPS); \
        const float y0 = a0 * rs * gn0_, y1 = a1 * rs * gn1_; float z0 = b0 * rs * gr0_, z1 = b1 * rs * gr1_; \
        const float o0 = swz_xor<16>(z0), o1 = swz_xor<16>(z1); \
        if (L < 16) { z0 = z0 * c0 - o0 * s0; z1 = z1 * c1 - o1 * s1; } else { z0 = z0 * c0 + o0 * s0; z1 = z1 * c1 + o1 * s1; } \
        bf16_t* dp = (dst_); \
        *(unsigned*)(dp + 2 * L) = cvt_pk_bf16(y0 * (sc_), y1 * (sc_)); \
        if (L < 32) *(unsigned*)(dp + 128 + 2 * L) = cvt_pk_bf16(z0 * (sc_), z1 * (sc_)); } while (0)
#define P2_ROW(R, r_) do { const int r = (r_); const float c0 = R.c0, c1 = R.c1, s0 = R.s0, s1 = R.s1; \
        _Pragma("unroll") for (int h = 0; h < 8; ++h) { \
            P2_HEAD(R.qn[h], R.qr[h], gqn0, gqn1, gqr0, gqr1, qscale, QM + (size_t)r * 1536 + h * 192);            \
            P2_HEAD(R.kn[h], R.kr, gkn0, gkn1, gkr0, gkr1, 1.0f, KM + (size_t)r * 1536 + h * 192);                  \
        } } while (0)
    {
        struct P2Row { unsigned qn[8], qr[8], kn[8]; unsigned kr; float c0, c1, s0, s1; };
        const int step = F.G * 8; int r0 = F.bid * 8 + F.wave;
        if (r0 < MROWS) {
            P2Row A, B;
            P2_LOAD(A, r0);
#pragma unroll 1
            for (;;) {
                const int rb = r0 + step; const bool hb = rb < MROWS;
                __builtin_amdgcn_sched_barrier(0);
                P2_LOAD(B, hb ? rb : r0);
                __builtin_amdgcn_sched_barrier(0);
                P2_ROW(A, r0);
                if (!hb) break;
                const int ra = rb + step; const bool ha = ra < MROWS;
                __builtin_amdgcn_sched_barrier(0);
                P2_LOAD(A, ha ? ra : rb);
                __builtin_amdgcn_sched_barrier(0);
                P2_ROW(B, rb);
                if (!ha) break;
                r0 = ra;
            }
        }
    }
#undef P2_LOAD
#undef P2_HEAD
#undef P2_ROW
    bf16_t* VMT = (bf16_t*)(ws + WS_VMT);
    {
        constexpr int NVT = NBATCH * 8 * (SEQ / 64);
#define VMT_SRC(it_) (MKV + (size_t)(((it_) / (8 * (SEQ / 64))) * SEQ + ((it_) % (SEQ / 64)) * 64) * 2048 + (((it_) / (SEQ / 64)) & 7) * 256 + 128)
        int it = F.bid;
        if (it < NVT) {
            u32x4 a0, a1; vt_load(F, VMT_SRC(it), 2048, a0, a1);
#pragma unroll 1
            for (; it < NVT; it += F.G) {
                const int nx = (it + F.G < NVT) ? it + F.G : it;
                u32x4 n0, n1; vt_load(F, VMT_SRC(nx), 2048, n0, n1);
                const int sb = it % (SEQ / 64), h = (it / (SEQ / 64)) & 7, b = it / (8 * (SEQ / 64));
                vt_finish(F, a0, a1, VMT + (size_t)(b * 8 + h) * 128 * SEQ + sb * 64);
                a0 = n0; a1 = n1;
            }
        }
#undef VMT_SRC
    }
    __syncthreads();
}

__device__ __forceinline__ float fma_scalar(float a, float b, float c) { float d; asm("v_fma_f32 %0, %1, %2, %3" : "=v"(d) : "v"(a), "v"(b), "v"(c)); return d; }
constexpr int SC_STRIDE = 2052, RD = 4;
template <int NJ>
__device__ __forceinline__ void idx_select(const Frame& F, LAS float* SC, const int t0, const size_t row0, unsigned* MASK) {
    const int L = F.lane;
    {
        const int qrA = F.wave * 2, qrB = qrA + 1, tA = t0 + qrA, tB = t0 + qrB;
        unsigned keyA[NJ], keyB[NJ];
#pragma unroll
        for (int j = 0; j < NJ; ++j) { const int s = j * 64 + L;
            unsigned ua = __float_as_uint(SC[qrA * SC_STRIDE + s]), ub = __float_as_uint(SC[qrB * SC_STRIDE + s]);
            ua = (ua & 0x80000000u) ? ~ua : (ua | 0x80000000u); ub = (ub & 0x80000000u) ? ~ub : (ub | 0x80000000u);
            keyA[j] = (s <= tA) ? ua : 0u; keyB[j] = (s <= tB) ? ub : 0u; }
#define IDX_WAVE_TOTAL(c) (c += __builtin_amdgcn_update_dpp(0, c, 0x128, 0xf, 0xf, true), c += __builtin_amdgcn_update_dpp(0, c, 0x124, 0xf, 0xf, true), c += __builtin_amdgcn_update_dpp(0, c, 0x122, 0xf, 0xf, true), \
        c += __builtin_amdgcn_update_dpp(0, c, 0x121, 0xf, 0xf, true), __builtin_amdgcn_readlane(c, 0) + __builtin_amdgcn_readlane(c, 16) + __builtin_amdgcn_readlane(c, 32) + __builtin_amdgcn_readlane(c, 48))
        unsigned TA = 1u, TB = 1u; bool actA = (tA >= 256), actB = (tB >= 256);
        if (actA) TA = 0u;
        if (actB) TB = 0u;
#pragma unroll 1
        for (int bit = 31; bit >= 0 && (actA || actB); --bit) {
            const unsigned cA = __builtin_amdgcn_readfirstlane(TA | (1u << bit)), cB = __builtin_amdgcn_readfirstlane(TB | (1u << bit));
            int nA = 0, nB = 0;
#pragma unroll
            for (int j = 0; j < NJ; ++j) { nA += (keyA[j] >= cA) ? 1 : 0; nB += (keyB[j] >= cB) ? 1 : 0; }
            const int totA = IDX_WAVE_TOTAL(nA), totB = IDX_WAVE_TOTAL(nB);
            if (actA) { if (totA >= 256) TA = cA; if (totA == 256) actA = false; }
            if (actB) { if (totB >= 256) TB = cB; if (totB == 256) actB = false; }
        }
#pragma unroll 1
        for (int qq = 0; qq < 2; ++qq) {
            const unsigned T = qq ? TB : TA; const int t = qq ? tB : tA, qr = qq ? qrB : qrA;
            int need = 1 << 30;
            if (t >= 256) { int gt = 0;
#pragma unroll
                for (int j = 0; j < NJ; ++j) gt += __builtin_popcountll(__ballot((qq ? keyB[j] : keyA[j]) > T));
                need = 256 - gt; }
            int run = 0; unsigned long long mymask = 0ull;
#pragma unroll
            for (int j = 0; j < NJ; ++j) {
                const unsigned kj = qq ? keyB[j] : keyA[j];
                const unsigned long long eq = __ballot(kj == T);
                const int rank = run + (int)__builtin_amdgcn_mbcnt_hi((unsigned)(eq >> 32), __builtin_amdgcn_mbcnt_lo((unsigned)eq, 0u));
                const bool sel = (kj > T) || (kj == T && rank < need);
                run += __builtin_popcountll(eq);
                const unsigned long long m = __ballot(sel);
                if (L == j) mymask = m;
            }
            if (L < 32) *(unsigned long long*)(MASK + (row0 + qr) * 64 + 2 * L) = mymask;
        }
#undef IDX_WAVE_TOTAL
    }
}
__device__ __forceinline__ void idx_unit(const Frame& F, int b, int tb) {
    unsigned char* ws = F.ws;
    const bf16_t* QI = (const bf16_t*)(ws + WS_QI); const bf16_t* KI = (const bf16_t*)(ws + WS_KI); const float* WI = (const float*)(ws + WS_WI);
    unsigned* MASK = (unsigned*)(ws + WS_MASK);
    LAS float* SC = (LAS float*)F.lds;
    const int L = F.lane, q = L & 15, hq = L >> 4;
    const int t0 = tb * 16; const size_t row0 = (size_t)b * SEQ + t0;
    __syncthreads();
    const int nkt = tb + 1;
    const bf16_t* kbase = KI + (size_t)b * SEQ * 64 + L * 8;
    const int nmy = (nkt - F.wave + 7) >> 3;
#ifndef IDX_REP_SCORE
#define IDX_REP_SCORE 1
#endif
#ifndef IDX_REP_SEL
#define IDX_REP_SEL 1
#endif
#pragma unroll 1
    for (int hp = 0; hp < IDX_REP_SCORE; ++hp) {
        bf16x8 qf[16][2]; float wv[16];
#pragma unroll
        for (int hh = 0; hh < 16; ++hh) {
#pragma unroll
            for (int ks = 0; ks < 2; ++ks) qf[hh][ks] = *(const bf16x8*)(QI + row0 * 1024 + hh * 1024 + ks * 512 + L * 8); }
        {
#pragma unroll
          for (int k4 = 0; k4 < 4; ++k4) { const f32x4 w0 = *(const f32x4*)(WI + (row0 + q) * 16 + 4 * k4); wv[4 * k4 + 0] = w0[0]; wv[4 * k4 + 1] = w0[1]; wv[4 * k4 + 2] = w0[2]; wv[4 * k4 + 3] = w0[3]; } }
        __builtin_amdgcn_sched_barrier(0);
        if (nmy > 0) {
            const int lastk = nmy - 1;
            bf16x8 kr[RD][2];
#pragma unroll
            for (int s8 = 0; s8 < RD; ++s8) { const int ic = s8 < lastk ? s8 : lastk; const bf16_t* kp = kbase + (size_t)(F.wave + 8 * ic) * 16 * 64; kr[s8][0] = *(const bf16x8*)kp; kr[s8][1] = *(const bf16x8*)(kp + 512); }
#pragma unroll 1
            for (int base = 0; base < nmy; base += RD) {
#pragma unroll
                for (int s8 = 0; s8 < RD; ++s8) {
                    const int i = base + s8;
                    if (i < nmy) {
                        const int kt = F.wave + 8 * i;
                        LAS f32x4* sp = (LAS f32x4*)(SC + q * SC_STRIDE + kt * 16 + 4 * hq);
                        f32x4 sc = (f32x4){0.f, 0.f, 0.f, 0.f};
#pragma unroll
                        for (int hh = 0; hh < 16; ++hh) {
                            f32x4 d = __builtin_amdgcn_mfma_f32_16x16x32_bf16(kr[s8][0], qf[hh][0], (f32x4){0.f, 0.f, 0.f, 0.f}, 0, 0, 0);
                            d = __builtin_amdgcn_mfma_f32_16x16x32_bf16(kr[s8][1], qf[hh][1], d, 0, 0, 0);
#pragma unroll
                            for (int j = 0; j < 4; ++j) { const int di = __float_as_int(d[j]); sc[j] = fma_scalar(wv[hh], __int_as_float(di > 0 ? di : 0), sc[j]); }
                        }
                        *sp = sc;
                    }
                    __builtin_amdgcn_sched_barrier(0);
                    { const int ic = (i + RD) < lastk ? (i + RD) : lastk; const bf16_t* kp = kbase + (size_t)(F.wave + 8 * ic) * 16 * 64; kr[s8][0] = *(const bf16x8*)kp; kr[s8][1] = *(const bf16x8*)(kp + 512); }
                    __builtin_amdgcn_sched_barrier(0);
                }
            }
        }
    }
    __syncthreads();
    {
        const int njv = (t0 + 16 + 63) >> 6;
        if (njv <= 8) idx_select<8>(F, SC, t0, row0, MASK);
        else if (njv <= 16) idx_select<16>(F, SC, t0, row0, MASK);
        else if (njv <= 24) idx_select<24>(F, SC, t0, row0, MASK);
        else idx_select<32>(F, SC, t0, row0, MASK);
    }
}
__device__ __forceinline__ void phase_idx(const Frame& F) {
    for (int u = F.bid; u < 256; u += F.G) { const int b = u >> 6, i = u & 63; idx_unit(F, b, i); idx_unit(F, b, 127 - i); }
    __syncthreads();
}

#ifndef ATT_PROBE
#define ATT_PROBE 0
#endif
#ifndef ATT_PROBE_OFS
#define ATT_PROBE_OFS 0
#endif
#ifndef ATT_PROBE_BID
#define ATT_PROBE_BID 0
#endif
#ifndef ATT_PROBE_TID
#define ATT_PROBE_TID 0
#endif
template <int DQK, bool DSA>
__device__ __forceinline__ void attn_unit(const Frame& F, const bf16_t* Q, int ldq, const bf16_t* Kg, int ldk, const bf16_t* Vt, const unsigned* maskb, bf16_t* O, int ldo, int q0) {
    constexpr int NST = DQK / 16;
    constexpr int KA_BYTES = 64 * 256, KB_BYTES = (DQK == 192) ? 64 * 128 : 0, V_OFF = KA_BYTES + KB_BYTES, STAGE = V_OFF + 128 * 128;
    static_assert(3 * STAGE <= 131072, "three attention stages fit the phase scratch");
    int L = F.lane; asm volatile("" : "+v"(L));
    const int r = L & 31, hf = L >> 5, w = F.wave;
    const int qw0 = q0 + 32 * w, tq = qw0 + r;
    const int ntiles = (q0 + 256) / 64;
    const int lkA = r * 256 + ((((r & 15) ^ hf)) << 4), lkB = r * 128 + ((hf ^ ((r >> 1) & 7)) << 4);
#define ATT_KADDR(sbo, kh, st) (((st) < 8) ? (F.lds + (((sbo) + (kh) * 8192 + lkA) ^ ((st) << 5))) : (F.lds + (((sbo) + KA_BYTES + (kh) * 4096 + lkB) ^ ((2 * (st) - 16) << 4))))
#define ATT_VADDR(sbo, kh, s2, dt) (F.lds + ((((sbo) + V_OFF + lkB) ^ ((4 * (kh) + 2 * (s2)) << 4)) + (dt) * 4096))
    auto issue = [&](int kt, int buf) {
        int Li = L; asm volatile("" : "+v"(Li));
        LAS unsigned char* sb = F.lds + buf * STAGE;
        const char* kb = (const char*)Kg + (size_t)kt * 64 * ldk * 2; const char* vb = (const char*)Vt + (size_t)kt * 128;
#pragma unroll
        for (int i = 0; i < 2; ++i) { const int chunk = w + 8 * i, row = chunk * 4 + (Li >> 4), slot = Li & 15, piece = slot ^ (row & 15);
            __builtin_amdgcn_global_load_lds((const unsigned*)(kb + (unsigned)(row * ldk + piece * 8) * 2u), (LAS unsigned*)(sb + chunk * 1024), 16, 0, 0); }
        if (DQK == 192) { const int row = w * 8 + (Li >> 3), slot = Li & 7, piece = 16 + (slot ^ ((row >> 1) & 7));
            __builtin_amdgcn_global_load_lds((const unsigned*)(kb + (unsigned)(row * ldk + piece * 8) * 2u), (LAS unsigned*)(sb + KA_BYTES + w * 1024), 16, 0, 0); }
#pragma unroll
        for (int i = 0; i < 2; ++i) { const int chunk = w + 8 * i, row = chunk * 8 + (Li >> 3), slot = Li & 7, piece = slot ^ ((row >> 1) & 7);
            __builtin_amdgcn_global_load_lds((const unsigned*)(vb + (unsigned)(row * SEQ + piece * 8) * 2u), (LAS unsigned*)(sb + V_OFF + chunk * 1024), 16, 0, 0); }
    };
    bf16x8 qf[NST];
    f32x16 oacc[4];
    f32x16 sacc[2];
    float lsum = 0.f;
    f32x16 negm;
#pragma unroll
    for (int i = 0; i < 16; ++i) negm[i] = 0.f;
    constexpr int PFD = 8;
#define ATT_QK(sbo) do { \
        _Pragma("unroll") for (int kh = 0; kh < 2; ++kh) { \
            sacc[kh] = negm; \
            _Pragma("unroll") for (int st = 0; st < NST; ++st) \
                sacc[kh] = __builtin_amdgcn_mfma_f32_32x32x16_bf16(*(const LAS bf16x8*)ATT_KADDR(sbo, kh, st), qf[st], sacc[kh], 0, 0, 0); } \
        __builtin_amdgcn_sched_group_barrier(0x100, PFD, 0); \
        _Pragma("unroll") for (int x = 0; x < 2 * NST - PFD; ++x) { __builtin_amdgcn_sched_group_barrier(0x008, 1, 0); __builtin_amdgcn_sched_group_barrier(0x100, 1, 0); } \
        __builtin_amdgcn_sched_group_barrier(0x008, PFD, 0); } while (0)

    __syncthreads();
#if ATT_PROBE
    unsigned long long pr_t0 = __builtin_amdgcn_s_memtime(), pr_w = 0ull; unsigned pr_n = 0u;
#endif
    u32x2 mw = (u32x2){0u, 0u};
    if (DSA) mw = *(const u32x2*)(maskb + (size_t)tq * 64);
    issue(0, 0);
    if (ntiles > 1) issue(1, 1);
#pragma unroll
    for (int st = 0; st < NST; ++st) qf[st] = *(const bf16x8*)(Q + (size_t)tq * ldq + st * 16 + hf * 8);
#pragma unroll
    for (int dt = 0; dt < 4; ++dt)
#pragma unroll
        for (int i = 0; i < 16; ++i) oacc[dt][i] = 0.f;
    asm volatile("s_waitcnt vmcnt(0)" ::: "memory");
    __syncthreads();
    const bool late = (w >= 4);
    const int wlim = (qw0 + 31) >> 6;
    if (late) ATT_QK(0);
#pragma clang loop unroll(disable)
    for (int kt = 0; kt < ntiles; ++kt) {
#if ATT_PROBE
        const unsigned long long pr_a = __builtin_amdgcn_s_memtime();
#endif
        if (kt > 0) {
#if ATT_PROBE == 2
            __syncthreads();
#else
            asm volatile("s_waitcnt vmcnt(0)" ::: "memory");
#endif
#if ATT_PROBE
            const unsigned long long pr_b = __builtin_amdgcn_s_memtime(); pr_w += pr_b - pr_a;
#endif
#if ATT_PROBE == 2
            asm volatile("s_waitcnt vmcnt(0)" ::: "memory");
#else
            __syncthreads();
#endif
        }
        const u32x2 mcur = mw;
        if (DSA && kt + 1 < ntiles) mw = *(const u32x2*)(maskb + (size_t)tq * 64 + (kt + 1) * 2);
        if (kt + 2 < ntiles) issue(kt + 2, (kt + 2) % 3);
        const int sbc = (kt % 3) * STAGE;
#if ATT_PROBE == 5
        __builtin_amdgcn_sched_barrier(0); const unsigned long long pr_q = __builtin_amdgcn_s_memtime(); __builtin_amdgcn_sched_barrier(0);
#endif
        if (!late && kt <= wlim) ATT_QK(sbc);
#if ATT_PROBE == 5
        if (!late && kt <= wlim) { __builtin_amdgcn_sched_barrier(0); asm volatile("" :: "v"(sacc[1][15])); pr_w += __builtin_amdgcn_s_memtime() - pr_q; pr_n += 1; __builtin_amdgcn_sched_barrier(0); }
#endif
        if (kt <= wlim) {
            if (!DSA && kt * 64 + 63 > qw0) { const int lim = tq - kt * 64 - 4 * hf;
#pragma unroll
                for (int i = 0; i < 16; ++i) { const int ko = (i & 3) + 8 * (i >> 2);
                    sacc[0][i] = (ko <= lim) ? sacc[0][i] : -INFINITY; sacc[1][i] = (ko + 32 <= lim) ? sacc[1][i] : -INFINITY; } }
#if ATT_PROBE == 3
            __builtin_amdgcn_sched_barrier(0); const unsigned long long pr_c = __builtin_amdgcn_s_memtime(); __builtin_amdgcn_sched_barrier(0);
#endif
            float mx = sacc[0][0];
#pragma unroll
            for (int i = 1; i < 16; ++i) mx = fmaxf(mx, sacc[0][i]);
#pragma unroll
            for (int i = 0; i < 16; ++i) mx = fmaxf(mx, sacc[1][i]);
            mx = pair32_max(mx);
            const bool grew = (kt == 0) || (mx > 8.0f);
            if (__builtin_amdgcn_ballot_w64(grew) != 0ull) {
                const float d = grew ? mx : 0.f;
                const float alpha = (kt == 0) ? 0.f : fast_exp2(-d);
#pragma unroll
                for (int i = 0; i < 16; ++i) { sacc[0][i] -= d; sacc[1][i] -= d; negm[i] -= d; }
                lsum *= alpha;
#pragma unroll
                for (int dt = 0; dt < 4; ++dt)
#pragma unroll
                    for (int i = 0; i < 16; ++i) oacc[dt][i] *= alpha;
            }
            float ps = 0.f;
            if (DSA) {
                const unsigned m0 = mcur.x >> (4 * hf), m1 = mcur.y >> (4 * hf);
#pragma unroll
                for (int i = 0; i < 16; ++i) { const int kb = (i & 3) + 8 * (i >> 2);
                    const float p0 = __int_as_float(__float_as_int(fast_exp2(sacc[0][i])) & __builtin_amdgcn_sbfe((int)m0, kb, 1)), p1 = __int_as_float(__float_as_int(fast_exp2(sacc[1][i])) & __builtin_amdgcn_sbfe((int)m1, kb, 1));
                    sacc[0][i] = p0; sacc[1][i] = p1; ps += p0 + p1; }
            } else {
#pragma unroll
                for (int kh = 0; kh < 2; ++kh)
#pragma unroll
                    for (int i = 0; i < 16; ++i) { const float pv = fast_exp2(sacc[kh][i]); sacc[kh][i] = pv; ps += pv; }
            }
            lsum += ps;
            bf16x8 pf[2][2];
#pragma unroll
            for (int kh = 0; kh < 2; ++kh)
#pragma unroll
                for (int s2 = 0; s2 < 2; ++s2) { u32x4 pw;
                    pw.x = cvt_pk_bf16(sacc[kh][8 * s2 + 0], sacc[kh][8 * s2 + 1]); pw.y = cvt_pk_bf16(sacc[kh][8 * s2 + 2], sacc[kh][8 * s2 + 3]);
                    pw.z = cvt_pk_bf16(sacc[kh][8 * s2 + 4], sacc[kh][8 * s2 + 5]); pw.w = cvt_pk_bf16(sacc[kh][8 * s2 + 6], sacc[kh][8 * s2 + 7]);
                    pf[kh][s2] = __builtin_bit_cast(bf16x8, pw); }
#if ATT_PROBE == 3
            __builtin_amdgcn_sched_barrier(0); asm volatile("" :: "v"(pf[1][1])); pr_w += __builtin_amdgcn_s_memtime() - pr_c; __builtin_amdgcn_sched_barrier(0);
#endif
#pragma unroll
            for (int dt = 0; dt < 4; ++dt)
#pragma unroll
                for (int kh = 0; kh < 2; ++kh)
#pragma unroll
                    for (int s2 = 0; s2 < 2; ++s2)
                        oacc[dt] = __builtin_amdgcn_mfma_f32_32x32x16_bf16(*(const LAS bf16x8*)ATT_VADDR(sbc, kh, s2, dt), pf[kh][s2], oacc[dt], 0, 0, 0);
            __builtin_amdgcn_sched_group_barrier(0x100, PFD, 1);
#pragma unroll
            for (int x = 0; x < 16 - PFD; ++x) { __builtin_amdgcn_sched_group_barrier(0x008, 1, 1); __builtin_amdgcn_sched_group_barrier(0x100, 1, 1); }
            __builtin_amdgcn_sched_group_barrier(0x008, PFD, 1);
        }
        if (late && kt + 1 <= wlim) ATT_QK(((kt + 1) % 3) * STAGE);
    }
#undef ATT_QK
#undef ATT_KADDR
#undef ATT_VADDR
#if ATT_PROBE
    if (F.tid == ATT_PROBE_TID) { volatile LAS unsigned* MS = (volatile LAS unsigned*)(F.lds + LDS_MISC); MS[4] += (unsigned)pr_w; MS[5] += (unsigned)(__builtin_amdgcn_s_memtime() - pr_t0); MS[6] += pr_n; }
#endif
    __builtin_amdgcn_s_setprio(0);
    const float ltot = pair32_sum(lsum);
    const float inv = fast_rcp(ltot);
    bf16_t* op = O + (size_t)tq * ldo + 4 * hf;
#pragma unroll
    for (int dt = 0; dt < 4; ++dt)
#pragma unroll
        for (int g4 = 0; g4 < 4; ++g4) { u32x2 ow; ow.x = cvt_pk_bf16(oacc[dt][4 * g4 + 0] * inv, oacc[dt][4 * g4 + 1] * inv); ow.y = cvt_pk_bf16(oacc[dt][4 * g4 + 2] * inv, oacc[dt][4 * g4 + 3] * inv);
            *(u32x2*)(op + dt * 32 + g4 * 8) = ow; }
}

#ifndef ATT_ENABLE_MLA
#define ATT_ENABLE_MLA 1
#endif
#ifndef ATT_ENABLE_DSA
#define ATT_ENABLE_DSA 1
#endif
__device__ __forceinline__ void phase_attn(const Frame& F) {
    unsigned char* ws = F.ws;
    const bf16_t* QA = (const bf16_t*)(ws + WS_QA); const bf16_t* KA = (const bf16_t*)(ws + WS_KA); const bf16_t* VAT = (const bf16_t*)(ws + WS_VAT);
    const bf16_t* QM = (const bf16_t*)(ws + WS_QM); const bf16_t* KM = (const bf16_t*)(ws + WS_KM); const bf16_t* VMT = (const bf16_t*)(ws + WS_VMT);
    const unsigned* MASK = (const unsigned*)(ws + WS_MASK); bf16_t* OAB = (bf16_t*)(ws + WS_OAB);
    for (int u0 = F.bid; u0 < 256; u0 += F.G) {
        const int u = (F.G == 256) ? ((u0 & 7) * 32 + (u0 >> 3)) : u0;
        const int b = u >> 6, h = (u >> 3) & 7, qb = u & 7;
        const size_t rb = (size_t)b * SEQ;
        if (ATT_ENABLE_DSA) attn_unit<128, true>(F, QA + rb * 1024 + h * 128, 1024, KA + rb * 256 + (h >> 2) * 128, 256, VAT + (size_t)(b * 2 + (h >> 2)) * 128 * SEQ, MASK + rb * 64, OAB + rb * DM + h * 128, DM, qb * 256);
        if (ATT_ENABLE_MLA) attn_unit<192, false>(F, QM + rb * 1536 + h * 192, 1536, KM + rb * 1536 + h * 192, 1536, VMT + (size_t)(b * 8 + h) * 128 * SEQ, nullptr, OAB + rb * DM + 1024 + h * 128, DM, (7 - qb) * 256);
    }
    __syncthreads();
}

__device__ __forceinline__ void phase_conv(const Frame& F, int l) {
    ArgsCP ap = F.a; unsigned char* ws = F.ws;
    const bf16_t* U = (const bf16_t*)(ws + WS_U); bf16_t* ACT = (bf16_t*)(ws + WS_ACT);
    const float* wconv = (const float*)ap->in[20] + (size_t)l * 3 * NUP; const float* bconv = (const float*)ap->in[21] + (size_t)l * NUP;
    const int cg = F.tid & 15, rs = F.tid >> 4;
    for (int it = F.bid; it < 32 * 44; it += F.G) {
        const int j = it % 44, pm = it / 44;
        const int ch = 128 * j + 8 * cg;
        const int row0 = pm * 256 + rs * 8;
        float wg[3][8], wvv[3][8], bg[8], bv[8];
#pragma unroll
        for (int k = 0; k < 3; ++k) { const f32x4 x0 = *(const f32x4*)(wconv + (size_t)k * NUP + ch), x1 = *(const f32x4*)(wconv + (size_t)k * NUP + ch + 4), y0 = *(const f32x4*)(wconv + (size_t)k * NUP + DFF + ch), y1 = *(const f32x4*)(wconv + (size_t)k * NUP + DFF + ch + 4);
#pragma unroll
            for (int e = 0; e < 4; ++e) { wg[k][e] = x0[e]; wg[k][4 + e] = x1[e]; wvv[k][e] = y0[e]; wvv[k][4 + e] = y1[e]; } }
        { const f32x4 x0 = *(const f32x4*)(bconv + ch), x1 = *(const f32x4*)(bconv + ch + 4), y0 = *(const f32x4*)(bconv + DFF + ch), y1 = *(const f32x4*)(bconv + DFF + ch + 4);
#pragma unroll
            for (int e = 0; e < 4; ++e) { bg[e] = x0[e]; bg[4 + e] = x1[e]; bv[e] = y0[e]; bv[4 + e] = y1[e]; } }
        const bf16_t* up = U + (size_t)row0 * NUP + 256 * j + 8 * cg;
        float g2[8], g1[8], v2[8], v1[8];
        const bool has_prev = (row0 & (SEQ - 1)) != 0;
#pragma unroll
        for (int e = 0; e < 8; ++e) { g2[e] = 0.f; g1[e] = 0.f; v2[e] = 0.f; v1[e] = 0.f; }
        if (has_prev) {
            const u32x4 a2 = *(const u32x4*)(up - 2 * (size_t)NUP), a1 = *(const u32x4*)(up - (size_t)NUP), c2 = *(const u32x4*)(up - 2 * (size_t)NUP + 128), c1 = *(const u32x4*)(up - (size_t)NUP + 128);
            g2[0] = bf_lo(a2.x); g2[1] = bf_hi(a2.x); g2[2] = bf_lo(a2.y); g2[3] = bf_hi(a2.y); g2[4] = bf_lo(a2.z); g2[5] = bf_hi(a2.z); g2[6] = bf_lo(a2.w); g2[7] = bf_hi(a2.w);
            g1[0] = bf_lo(a1.x); g1[1] = bf_hi(a1.x); g1[2] = bf_lo(a1.y); g1[3] = bf_hi(a1.y); g1[4] = bf_lo(a1.z); g1[5] = bf_hi(a1.z); g1[6] = bf_lo(a1.w); g1[7] = bf_hi(a1.w);
            v2[0] = bf_lo(c2.x); v2[1] = bf_hi(c2.x); v2[2] = bf_lo(c2.y); v2[3] = bf_hi(c2.y); v2[4] = bf_lo(c2.z); v2[5] = bf_hi(c2.z); v2[6] = bf_lo(c2.w); v2[7] = bf_hi(c2.w);
            v1[0] = bf_lo(c1.x); v1[1] = bf_hi(c1.x); v1[2] = bf_lo(c1.y); v1[3] = bf_hi(c1.y); v1[4] = bf_lo(c1.z); v1[5] = bf_hi(c1.z); v1[6] = bf_lo(c1.w); v1[7] = bf_hi(c1.w);
        }
        u32x4 gin[8], vin[8];
#pragma unroll
        for (int i = 0; i < 8; ++i) { gin[i] = *(const u32x4*)(up + (size_t)i * NUP); vin[i] = *(const u32x4*)(up + (size_t)i * NUP + 128); }
#pragma unroll
        for (int i = 0; i < 8; ++i) {
            float g0[8], v0[8], o[8];
            g0[0] = bf_lo(gin[i].x); g0[1] = bf_hi(gin[i].x); g0[2] = bf_lo(gin[i].y); g0[3] = bf_hi(gin[i].y); g0[4] = bf_lo(gin[i].z); g0[5] = bf_hi(gin[i].z); g0[6] = bf_lo(gin[i].w); g0[7] = bf_hi(gin[i].w);
            v0[0] = bf_lo(vin[i].x); v0[1] = bf_hi(vin[i].x); v0[2] = bf_lo(vin[i].y); v0[3] = bf_hi(vin[i].y); v0[4] = bf_lo(vin[i].z); v0[5] = bf_hi(vin[i].z); v0[6] = bf_lo(vin[i].w); v0[7] = bf_hi(vin[i].w);
#pragma unroll
            for (int e = 0; e < 8; ++e) {
                const float gc = bg[e] + wg[0][e] * g2[e] + wg[1][e] * g1[e] + wg[2][e] * g0[e];
                const float vc = bv[e] + wvv[0][e] * v2[e] + wvv[1][e] * v1[e] + wvv[2][e] * v0[e];
                o[e] = gc * sigmoidf_(gc) * vc;
                g2[e] = g1[e]; g1[e] = g0[e]; v2[e] = v1[e]; v1[e] = v0[e];
            }
            u32x4 ow; ow.x = cvt_pk_bf16(o[0], o[1]); ow.y = cvt_pk_bf16(o[2], o[3]); ow.z = cvt_pk_bf16(o[4], o[5]); ow.w = cvt_pk_bf16(o[6], o[7]);
            *(u32x4*)(ACT + (size_t)(row0 + i) * DFF + ch) = ow;
        }
    }
}

__device__ __forceinline__ void conv_fixup(const Frame& F, int l, int pm) {
    if ((pm & 7) == 0) return;
    ArgsCP ap = F.a; unsigned char* ws = F.ws;
    const float* wconv = (const float*)ap->in[20] + (size_t)l * 3 * NUP; const float* bconv = (const float*)ap->in[21] + (size_t)l * NUP;
    const float* UH = (const float*)(ws + WS_UHEAD) + (size_t)pm * 2 * NUP; const float* UT = (const float*)(ws + WS_UTAIL) + (size_t)(pm - 1) * 2 * NUP;
    bf16_t* ACT = (bf16_t*)(ws + WS_ACT);
    f32x4 t0[3][2], t1[3][2], h0[3][2], h1[3][2], w0[3][2], w1[3][2], w2[3][2], bb[3][2];
#pragma unroll
    for (int j = 0; j < 3; ++j) { const int cq = F.tid + 512 * j; const int c2 = (cq < DFF / 4) ? cq : 0;
        const int ch = c2 * 4, colp = (ch >> 7) * 256 + (ch & 127);
#pragma unroll
        for (int bj = 0; bj < 2; ++bj) { const int cp = colp + bj * 128, cw = ch + bj * DFF;
            t0[j][bj] = *(const f32x4*)(UT + cp); t1[j][bj] = *(const f32x4*)(UT + (size_t)NUP + cp); h0[j][bj] = *(const f32x4*)(UH + cp); h1[j][bj] = *(const f32x4*)(UH + (size_t)NUP + cp);
            w0[j][bj] = *(const f32x4*)(wconv + cw); w1[j][bj] = *(const f32x4*)(wconv + (size_t)NUP + cw); w2[j][bj] = *(const f32x4*)(wconv + (size_t)2 * NUP + cw); bb[j][bj] = *(const f32x4*)(bconv + cw); } }
#pragma unroll
    for (int j = 0; j < 3; ++j) { const int cq = F.tid + 512 * j;
        if (cq < DFF / 4) { const int ch = cq * 4;
#pragma unroll
            for (int rr = 0; rr < 2; ++rr) {
                f32x4 cv[2];
#pragma unroll
                for (int bj = 0; bj < 2; ++bj) cv[bj] = bb[j][bj] + w0[j][bj] * (rr ? t1[j][bj] : t0[j][bj]) + w1[j][bj] * (rr ? h0[j][bj] : t1[j][bj]) + w2[j][bj] * (rr ? h1[j][bj] : h0[j][bj]);
                f32x4 o;
#pragma unroll
                for (int e = 0; e < 4; ++e) { const float g = cv[0][e]; o[e] = g * sigmoidf_(g) * cv[1][e]; }
                u32x2 ow; ow.x = cvt_pk_bf16(o[0], o[1]); ow.y = cvt_pk_bf16(o[2], o[3]);
                *(u32x2*)(ACT + (size_t)(pm * 256 + rr) * DFF + ch) = ow; } } }
}

typedef ArgsCP ArgsP;
__device__ __forceinline__ Frame make_frame() {
    Frame F;
    int tid = threadIdx.x; asm volatile("" : "+v"(tid));
    int bid = blockIdx.x, G = gridDim.x; asm volatile("" : "+s"(bid), "+s"(G));
    ArgsP ap = (ArgsP)__builtin_amdgcn_kernarg_segment_ptr(); asm volatile("" : "+s"(ap));
    extern __shared__ __attribute__((aligned(16))) unsigned char lds_raw[];
    F.lds = (LAS unsigned char*)lds_raw;
    F.tid = tid; F.lane = tid & 63; F.wave = __builtin_amdgcn_readfirstlane(tid >> 6); F.G = G; F.bid = bid;
    F.a = ap; F.ws = ap->ws;
    return F;
}

__global__ void __launch_bounds__(512, 2) fwd_kernel(Args args) {
    extern __shared__ __attribute__((aligned(16))) unsigned char lds_raw[];
    volatile LAS unsigned* MISC = (volatile LAS unsigned*)((LAS unsigned char*)lds_raw + LDS_MISC);
    if (threadIdx.x < 16) MISC[threadIdx.x] = 0u;
    __syncthreads();
    const int lo = args.ph_lo, hi = args.ph_hi;
    XcdBarrier bar; bar.bar = (unsigned*)(args.ws + WS_CTL) + 4096; bar.x = 0; bar.st = MISC;
    if (hi - lo > 1) bar = xcd_barrier_post((unsigned*)(args.ws + WS_CTL) + 4096, MISC);
#ifndef ONLY_PHASE
#define ONLY_PHASE -1
#endif
#define PH_EN(p) (ONLY_PHASE < 0 || ONLY_PHASE == (p))
#ifndef REP_MASK
#define REP_MASK 0
#endif
#define REPEAT(bit) _Pragma("unroll 1") for (int _rep = 0; _rep < (((REP_MASK >> (bit)) & 1) ? 2 : 1); ++_rep)
#define IN(k) (lo <= (k) && (k) < hi)
#ifndef BAR_REP
#define BAR_REP 1
#endif
#define SEAM(k) do { if (IN(k) && IN((k) + 1)) { _Pragma("unroll 1") for (int _br = 0; _br < BAR_REP; ++_br) { XcdBarrier b2 = bar; asm volatile("" : "+s"(b2.bar), "+s"(b2.x)); xcd_barrier(b2); } } } while (0)

    if (PH_EN(100) && IN(0)) { const Frame F = make_frame(); p0a_prologue(F); }
    SEAM(0);
    if (PH_EN(101) && IN(1)) REPEAT(0) { const Frame F = make_frame(); p0b_prologue(F); }
    SEAM(1);

#pragma unroll 1
    for (int l = 0; l < DEPTH; ++l) {
        const int pb = 2 + l * NPH_LAYER;
        if (PH_EN(0) && IN(pb + 0)) REPEAT(1) { const Frame F = make_frame(); unsigned char* ws = F.ws;
            pg8::Gemm g{(const bf16_t*)(ws + WS_H8), (const bf16_t*)(ws + WS_WIN + (size_t)l * NPROJ * DM), DM / 2, DM / 2, DM / 2, 0, 0};
            pg8::StaticOrder S; S.init(MROWS, NPROJ, F.G, F.bid);
            pg8::EpiProjNorm E{(bf16_t*)(ws + WS_PROJ), NPROJ, (const fx64*)(ws + WS_SSQ) + (size_t)(l * 2 + 0) * MROWS, (const fx64*)(ws + WS_BIAS) + (size_t)l * NBATCH * NPROJ, NPROJ, (LAS float*)(F.lds + LDS_TAB), (fx64*)(ws + WS_SSQ_LAT) + (size_t)l * 2 * MROWS};
            pg8::gemm_phase(F.lds, F.tid, g, S, E);
        }
        if (PH_EN(0) && IN(pb + 0) && l + 1 < DEPTH) { const Frame F = make_frame(); tr_late(F, l + 1, (MROWS / 256) * (NPROJ / 256), late_up_tiles(F.G), late_in_tiles(F.G), LATE_IN); }
        SEAM(pb + 0);
        if (PH_EN(1) && IN(pb + 1)) {
#pragma unroll 1
            for (int s1 = 0; s1 < 2; ++s1) {
                const Frame F0 = make_frame();
                if ((((F0.bid >> 3) ^ s1) & 1) == 0) {
                    { const Frame F = make_frame(); unsigned char* ws = F.ws; const fx64* sl = (const fx64*)(ws + WS_SSQ_LAT) + (size_t)l * 2 * MROWS;
                      pg8::Gemm g{(const bf16_t*)(ws + WS_PROJ) + PC_MQL, (const bf16_t*)(ws + WS_WMQ) + (size_t)l * 1536 * 512, NPROJ, 512, 512, 0, 0};
                      pg8::StaticOrder S; S.init(MROWS, 1536, F.G, F.bid); pg8::EpiStoreBf16 E{(bf16_t*)(ws + WS_MQ), 1536, sl, 1.0f / 512.0f}; pg8::gemm_phase(F.lds, F.tid, g, S, E); }
                    { const Frame F = make_frame(); unsigned char* ws = F.ws; const fx64* sl = (const fx64*)(ws + WS_SSQ_LAT) + (size_t)l * 2 * MROWS + MROWS;
                      pg8::Gemm g{(const bf16_t*)(ws + WS_PROJ) + PC_MKVL, (const bf16_t*)(ws + WS_WMKV) + (size_t)l * 2048 * 256, NPROJ, 256, 256, 0, 0};
                      pg8::StaticOrder S; S.init(MROWS, 2048, F.G, F.bid); pg8::EpiStoreBf16 E{(bf16_t*)(ws + WS_MKV), 2048, sl, 1.0f / 256.0f}; pg8::gemm_phase(F.lds, F.tid, g, S, E); }
                } else { const Frame F = make_frame(); phase_post1(F, l); }
            }
        }
        SEAM(pb + 1);
        if (PH_EN(2) && IN(pb + 2)) {
#pragma unroll 1
            for (int s2 = 0; s2 < 2; ++s2) { const Frame F = make_frame();
                if ((((F.bid >> 3) ^ s2) & 1) == 0) phase_post2(F, l); else phase_idx(F); }
        }
        SEAM(pb + 2);
        if (PH_EN(3) && IN(pb + 3)) REPEAT(2) { const Frame F = make_frame(); phase_attn(F); }
        SEAM(pb + 3);
        if (PH_EN(4) && IN(pb + 4)) { const Frame F = make_frame(); unsigned char* ws = F.ws;
            pg8::Gemm g{(const bf16_t*)(ws + WS_OAB), (const bf16_t*)(ws + WS_WPAB) + (size_t)l * 4096 * 1024, DM, 1024, 1024, (size_t)1024 * 2, (size_t)2048 * 1024 * 2};
            pg8::PairOrder S; S.s.init(MROWS, DM, F.G, F.bid);
            pg8::EpiPab E{(const bf16_t*)(ws + WS_PROJ), (bf16_t*)(ws + WS_MERGED)};
            pg8::gemm_phase(F.lds, F.tid, g, S, E);
        }
        SEAM(pb + 4);
        if (PH_EN(5) && IN(pb + 5)) { const Frame F = make_frame(); unsigned char* ws = F.ws;
            const float* xin = (l == 0) ? (const float*)F.a->in[0] : (const float*)F.a->out;
            const float* modl = (const float*)(ws + WS_MOD) + (size_t)l * NBATCH * NADA;
            pg8::Gemm g{(const bf16_t*)(ws + WS_MERGED), (const bf16_t*)(ws + WS_WO) + (size_t)l * DM * DM, DM, DM, DM, 0, 0};
            pg8::StaticOrder S; S.init(MROWS, DM, F.G, F.bid);
            pg8::EpiResidNorm E{xin, F.a->out, modl + 2 * DM, (const float*)F.a->in[4] + l * DM, modl + 4 * DM, (bf16_t*)(ws + WS_H), (fx64*)(ws + WS_SSQ) + (size_t)(l * 2 + 1) * MROWS, 0};
            pg8::gemm_phase(F.lds, F.tid, g, S, E);
        }
        SEAM(pb + 5);
        if (PH_EN(6) && IN(pb + 6)) { const Frame F = make_frame(); unsigned char* ws = F.ws;
            pg8::Gemm g{(const bf16_t*)(ws + WS_H), (const bf16_t*)(ws + WS_WUP) + (size_t)l * NUP * DM, DM, DM, DM, 0, 0};
            pg8::StaticOrder S; S.init(MROWS, NUP, F.G, F.bid);
            pg8::EpiUpConv E{(const float*)F.a->in[20] + (size_t)l * 3 * NUP, (const float*)F.a->in[21] + (size_t)l * NUP, (bf16_t*)(ws + WS_ACT), (float*)(ws + WS_UHEAD), (float*)(ws + WS_UTAIL), (LAS float*)(F.lds + LDS_XB),
                               (const fx64*)(ws + WS_SSQ) + (size_t)(l * 2 + 1) * MROWS, (const fx64*)(ws + WS_BIAS_UP) + (size_t)l * NBATCH * NUP, (LAS float*)(F.lds + LDS_TAB), (LAS float*)(F.lds + LDS_CTAB), (LAS float*)(F.lds + LDS_TAB2), (LAS float*)(F.lds + LDS_CTAB2)};
            pg8::gemm_phase(F.lds, F.tid, g, S, E);
            if (l + 1 < DEPTH) tr_late(F, l + 1, (MROWS / 256) * (NUP / 256), 0, late_up_tiles(F.G), LATE_UP);
        }
        SEAM(pb + 6);
        if (PH_EN(7) && IN(pb + 7)) { const Frame F = make_frame(); unsigned char* ws = F.ws;
            pg8::StaticOrder S; S.init(MROWS, DM, F.G, F.bid);
            { pg8::Unit uu; for (int i = 0; S.next(i, uu); ++i) conv_fixup(F, l, uu.pm); }
            asm volatile("s_waitcnt vmcnt(0)" ::: "memory"); __syncthreads();
            const float* modl = (const float*)(ws + WS_MOD) + (size_t)l * NBATCH * NADA;
            const bool more = (l + 1 < DEPTH);
            pg8::Gemm g{(const bf16_t*)(ws + WS_ACT), (const bf16_t*)(ws + WS_WDN) + (size_t)l * DM * DFF, DFF, DFF, DFF, 0, 0};
            pg8::EpiResidNorm E{F.a->out, F.a->out, modl + 5 * DM, (const float*)F.a->in[3] + (l + 1) * DM, modl + NBATCH * NADA + DM, more ? (bf16_t*)(ws + WS_H8) : (bf16_t*)nullptr, (fx64*)(ws + WS_SSQ) + (size_t)((l + 1) * 2 + 0) * MROWS, 1};
            pg8::gemm_phase(F.lds, F.tid, g, S, E);
        }
        SEAM(pb + 7);
    }
#if ATT_PROBE
    { XcdBarrier b2 = bar; xcd_barrier(b2);
      if (blockIdx.x == ATT_PROBE_BID && threadIdx.x == ATT_PROBE_TID) { volatile LAS unsigned* MS = (volatile LAS unsigned*)((LAS unsigned char*)lds_raw + LDS_MISC); args.out[0] = (ATT_PROBE == 4) ? 1000.0f * (float)((int)((float)MS[5] / (4.0f * 36.0f * 100.0f) + ATT_PROBE_OFS) / 5 * 5) : (ATT_PROBE == 5) ? 1000.0f * (float)((int)((float)MS[4] / (float)MS[6] / 10.0f + ATT_PROBE_OFS) / 5 * 5) : 1000.0f * (float)(((int)(100.0f * (float)MS[4] / (float)MS[5]) + ATT_PROBE_OFS) / 10 * 10); } }
#endif
#undef IN
#undef SEAM
}

extern "C" void kernel_launch(void* const* d_in, const int* in_sizes, int n_in, void* d_out, int out_size, void* d_ws, size_t ws_size, hipStream_t stream) {
    static int grid = 0;
    if (grid == 0) {
        if (n_in != 23 || out_size != MROWS * DM || ws_size < WS_END) { fprintf(stderr, "kernel_launch: unexpected problem (n_in %d, out %d, ws %zu < %zu)\n", n_in, out_size, ws_size, (size_t)WS_END); grid = -1; return; }
        int dev = 0, cus = 0, per_cu = 0;
        if (hipGetDevice(&dev) != hipSuccess || hipDeviceGetAttribute(&cus, hipDeviceAttributeMultiprocessorCount, dev) != hipSuccess) { grid = -1; return; }
        if (hipFuncSetAttribute((const void*)fwd_kernel, hipFuncAttributeMaxDynamicSharedMemorySize, LDS_BYTES) != hipSuccess) { fprintf(stderr, "kernel_launch: hipFuncSetAttribute failed\n"); grid = -1; return; }
        if (hipOccupancyMaxActiveBlocksPerMultiprocessor(&per_cu, (const void*)fwd_kernel, 512, LDS_BYTES) != hipSuccess || per_cu < 1) { fprintf(stderr, "kernel_launch: occupancy query says %d\n", per_cu); }
        (void)hipGetLastError();
        grid = cus;
    }
    if (grid < 0) return;
    (void)in_sizes;
    (void)hipMemsetAsync((char*)d_ws + WS_CTL, 0, CTL_ZERO_BYTES, stream);
    (void)hipMemsetAsync((char*)d_ws + WS_BIAS, 0, BIAS_ZERO_BYTES, stream);
    Args a{};
    for (int i = 0; i < 23; ++i) a.in[i] = d_in[i];
    a.out = (float*)d_out; a.ws = (unsigned char*)d_ws;
    for (int i = 0; i < 16; ++i) a.inv_a[i] = (float)pow(500000.0, -(double)(2 * i) / 32.0);
    for (int i = 0; i < 8; ++i) a.inv_i[i] = (float)pow(500000.0, -(double)(2 * i) / 16.0);
    for (int i = 0; i < 32; ++i) a.inv_m[i] = (float)pow(500000.0, -(double)(2 * i) / 64.0);
#if MK_ONE_LAUNCH
    a.ph_lo = 0; a.ph_hi = NPHASES;
    hipLaunchKernelGGL(fwd_kernel, dim3(grid), dim3(512), LDS_BYTES, stream, a);
#else
    for (int p = 0; p < NPHASES; ++p) { a.ph_lo = p; a.ph_hi = p + 1; hipLaunchKernelGGL(fwd_kernel, dim3(grid), dim3(512), LDS_BYTES, stream, a); }
#endif
}
```

```cpp
#include <hip/hip_runtime.h>
#include <cstdio>
#include <cstdint>
#include <cmath>

#define GAS __attribute__((address_space(1)))
#define LAS __attribute__((address_space(3)))
typedef unsigned short bf16_t;
typedef short bf16x8 __attribute__((ext_vector_type(8)));
typedef short bf16x4 __attribute__((ext_vector_type(4)));
typedef float f32x4 __attribute__((ext_vector_type(4)));
typedef float f32x16 __attribute__((ext_vector_type(16)));
typedef unsigned u32x4 __attribute__((ext_vector_type(4)));
typedef unsigned u32x2 __attribute__((ext_vector_type(2)));
typedef int i32x8 __attribute__((ext_vector_type(8)));
typedef int i32x4 __attribute__((ext_vector_type(4)));

constexpr int DM = 2048, NBATCH = 4, SEQ = 2048, DEPTH = 4, MROWS = NBATCH * SEQ;
constexpr int IN_DIM = 7568, NPROJ = 7680, DFF = 5632, NUP = 2 * DFF, NADA = 6 * DM;
constexpr int PC_QA = 0, PC_KA = 1024, PC_VA = 1280, PC_QI = 1536, PC_KI = 2560, PC_WI = 2624, PC_MKR = 2640, PC_MQL = 2816, PC_MKVL = 3328, PC_GA = 3584, PC_GB = 5632;
constexpr float EPS = 1e-6f;
constexpr float W8_SCALE = 32.0f, W8_INV = 1.0f / 32.0f;
constexpr float LOG2E = 1.4426950408889634f;
constexpr int NPH_LAYER = 8, NPHASES = 2 + DEPTH * NPH_LAYER;
#ifndef MK_ONE_LAUNCH
#define MK_ONE_LAUNCH 1
#endif

constexpr size_t MiB = 1u << 20;
constexpr size_t WS_CTL = 0, CTL_ZERO_BYTES = 1 * MiB;
constexpr size_t WS_SSQ = 256 * 1024;
constexpr size_t WS_MOD = 1 * MiB;
constexpr size_t WS_ROPE = 2 * MiB;
constexpr size_t WS_WIN = 8 * MiB;
constexpr size_t WS_WMQ = 128 * MiB;
constexpr size_t WS_WMKV = 134 * MiB;
constexpr size_t WS_WPAB = 138 * MiB;
constexpr size_t WS_WO = 170 * MiB;
constexpr size_t WS_WUP = 202 * MiB;
constexpr size_t WS_WDN = 378 * MiB;
constexpr size_t WS_H = 466 * MiB;
constexpr size_t WS_PROJ = 498 * MiB;
constexpr size_t WS_QA = 618 * MiB;
constexpr size_t WS_KA = 634 * MiB;
constexpr size_t WS_VAT = 638 * MiB;
constexpr size_t WS_QI = 642 * MiB;
constexpr size_t WS_KI = 658 * MiB;
constexpr size_t WS_WI = 659 * MiB;
constexpr size_t WS_MQL = 660 * MiB;
constexpr size_t WS_MKVL = 668 * MiB;
constexpr size_t WS_MQ = 672 * MiB;
constexpr size_t WS_MKV = 696 * MiB;
constexpr size_t WS_QM = 728 * MiB;
constexpr size_t WS_KM = 752 * MiB;
constexpr size_t WS_VMT = 776 * MiB;
constexpr size_t WS_MASK = 792 * MiB;
constexpr size_t WS_OAB = 794 * MiB;
constexpr size_t WS_MERGED = 826 * MiB;
constexpr size_t WS_U = 858 * MiB;
constexpr size_t WS_ACT = 1034 * MiB;
constexpr size_t WS_UHEAD = 1122 * MiB;
constexpr size_t WS_UTAIL = 1126 * MiB;
constexpr size_t WS_BIAS = 1130 * MiB, BIAS_ZERO_BYTES = 3584 * 1024;
constexpr size_t WS_BIAS_UP = WS_BIAS + (size_t)DEPTH * NBATCH * NPROJ * 8;
constexpr size_t WS_SSQ_LAT = 1133 * MiB;
constexpr size_t WS_H8 = 1134 * MiB;
constexpr size_t WS_END = 1150 * MiB;

constexpr int LDS_BYTES = 153600;
constexpr int LDS_TAB2 = 147456, LDS_CTAB2 = 149504;
constexpr int LDS_CTAB = 131072;
constexpr int LDS_MISC = 135168;
constexpr int LDS_TAB = 136192;
constexpr int LDS_XB = 139264;

__device__ __forceinline__ unsigned cvt_pk_bf16(float lo, float hi) { unsigned r; asm("v_cvt_pk_bf16_f32 %0, %1, %2" : "=v"(r) : "v"(lo), "v"(hi)); return r; }
__device__ __forceinline__ unsigned cvt_fp8x4(float a, float b, float c, float d) { int w = __builtin_amdgcn_cvt_pk_fp8_f32(a, b, 0, false); w = __builtin_amdgcn_cvt_pk_fp8_f32(c, d, w, true); return (unsigned)w; }
__device__ __forceinline__ float bf_lo(unsigned w) { return __uint_as_float(w << 16); }
__device__ __forceinline__ float bf_hi(unsigned w) { return __uint_as_float(w & 0xffff0000u); }
__device__ __forceinline__ float bf1(bf16_t v) { return __uint_as_float(((unsigned)v) << 16); }
template <int K> __device__ __forceinline__ float swz_xor(float v) { return __int_as_float(__builtin_amdgcn_ds_swizzle(__float_as_int(v), 0x1f | (K << 10))); }
__device__ __forceinline__ float pair32_sum(float v) { auto rr = __builtin_amdgcn_permlane32_swap(__float_as_uint(v), __float_as_uint(v), false, false); return __uint_as_float(rr[0]) + __uint_as_float(rr[1]); }
__device__ __forceinline__ float pair32_max(float v) { auto rr = __builtin_amdgcn_permlane32_swap(__float_as_uint(v), __float_as_uint(v), false, false); return fmaxf(__uint_as_float(rr[0]), __uint_as_float(rr[1])); }
__device__ __forceinline__ float pair32_other(float v, bool upper) { auto rr = __builtin_amdgcn_permlane32_swap(__float_as_uint(v), __float_as_uint(v), false, false); return __uint_as_float(upper ? rr[0] : rr[1]); }
template <int CTRL> __device__ __forceinline__ float dpp_mov_f(float v) { return __int_as_float(__builtin_amdgcn_update_dpp(0, __float_as_int(v), CTRL, 0xf, 0xf, true)); }
__device__ __forceinline__ float wave_sum(float v) {
    v += dpp_mov_f<0x128>(v); v += dpp_mov_f<0x124>(v); v += dpp_mov_f<0x122>(v); v += dpp_mov_f<0x121>(v);
    v += swz_xor<16>(v);
    return pair32_sum(v);
}
__device__ __forceinline__ float fast_rsq(float x) { return __builtin_amdgcn_rsqf(x); }
__device__ __forceinline__ float fast_rcp(float x) { return __builtin_amdgcn_rcpf(x); }
__device__ __forceinline__ float fast_exp2(float x) { return __builtin_amdgcn_exp2f(x); }
typedef long long fx64;
constexpr float FX_SSQ = 4294967296.f, FX_SSQ_INV = 1.0f / 4294967296.f;
constexpr double FX_BIAS = 1099511627776.0; constexpr float FX_BIAS_INV = (float)(1.0 / 1099511627776.0);
__device__ __forceinline__ void fx_add(fx64* p, double scaled) { (void)__hip_atomic_fetch_add((unsigned long long*)p, (unsigned long long)(long long)__builtin_rint(scaled), __ATOMIC_RELAXED, __HIP_MEMORY_SCOPE_AGENT); }
__device__ __forceinline__ float sigmoidf_(float x) { return fast_rcp(1.0f + fast_exp2(-x * LOG2E)); }

#define XB_TMO      128
#define XB_XCNT(j)  (256  + 64 * (j))
#define XB_XSUB(j)  (1280 + 64 * (j))
#define XB_XGEN(j)  (2304 + 64 * (j))
#define XB_TOP      3328
#define XB_TOPGEN   3392
#define XCD_BAR_WORDS 3456
#define XB_SPIN_CAP (1u << 20)

__device__ __forceinline__ unsigned xb_ld(unsigned* p)              { return __hip_atomic_load(p, __ATOMIC_RELAXED, __HIP_MEMORY_SCOPE_AGENT); }
__device__ __forceinline__ unsigned xb_add(unsigned* p, unsigned v) { return __hip_atomic_fetch_add(p, v, __ATOMIC_RELAXED, __HIP_MEMORY_SCOPE_AGENT); }
__device__ __forceinline__ unsigned xb_xcc_id() { return (unsigned)__builtin_amdgcn_s_getreg((3 << 11) | 20) & 0xFu; }
#define XB_SPIN(cond, bar) do { unsigned _sp = 0; while (cond) { __builtin_amdgcn_s_sleep(1); \
    if ((++_sp & 255u) == 0u) { if (xb_ld(&(bar)[XB_TMO])) break; if (_sp > XB_SPIN_CAP) { atomicAdd(&(bar)[XB_TMO], 1u); break; } } } } while (0)

struct XcdBarrier { unsigned* bar; unsigned x; volatile LAS unsigned* st; };

__device__ __forceinline__ XcdBarrier xcd_barrier_post(unsigned* bar, volatile LAS unsigned* st) {
    XcdBarrier b; b.bar = bar; b.x = xb_xcc_id(); b.st = st;
    if (threadIdx.x == 0) (void)xb_add(&bar[XB_XCNT(b.x)], 1u);
    return b;
}
__device__ __forceinline__ void xcd_barrier_complete(unsigned* bar, unsigned x, unsigned& nloc, unsigned& nx) {
    const unsigned G = gridDim.x * gridDim.y * gridDim.z;
    unsigned sum, cnt, mine, sp = 0u;
    for (;;) {
        sum = 0u; cnt = 0u; mine = 0u;
#pragma unroll
        for (unsigned j = 0; j < 16; ++j) { const unsigned c = xb_ld(&bar[XB_XCNT(j)]); sum += c; cnt += (c > 0u) ? 1u : 0u; mine = (j == x) ? c : mine; }
        if (sum == G) break;
        __builtin_amdgcn_s_sleep(1);
        if ((++sp & 255u) == 0u) { if (xb_ld(&bar[XB_TMO])) break; if (sp > XB_SPIN_CAP) { atomicAdd(&bar[XB_TMO], 1u); break; } }
    }
    nloc = mine > 0u ? mine : 1u; nx = cnt > 0u ? cnt : 1u;
}
__device__ __forceinline__ void xcd_barrier(const XcdBarrier& b) {
    asm volatile("s_waitcnt vmcnt(0)" ::: "memory");
    __syncthreads();
    if (threadIdx.x == 0) {
        unsigned* bar = b.bar;
        __builtin_amdgcn_s_waitcnt(0);
        unsigned nloc = b.st[0], nx = b.st[1];
        if (nloc == 0u) { xcd_barrier_complete(bar, b.x, nloc, nx); b.st[0] = nloc; b.st[1] = nx; }
        const unsigned old = xb_add(&bar[XB_XSUB(b.x)], 1u);
        const unsigned gen = old / nloc;
        if (old + 1u == (gen + 1u) * nloc) {
            __builtin_amdgcn_fence(__ATOMIC_RELEASE, "agent");
            asm volatile("s_waitcnt vmcnt(0)" ::: "memory");
            const unsigned og = xb_add(&bar[XB_TOP], 1u);
            const unsigned tg = og / nx;
            if (og + 1u == (tg + 1u) * nx) xb_add(&bar[XB_TOPGEN], 1u);
            else XB_SPIN(xb_ld(&bar[XB_TOPGEN]) == tg, bar);
            asm volatile("buffer_inv sc1" ::: "memory");
            xb_add(&bar[XB_XGEN(b.x)], 1u);
            asm volatile("s_waitcnt vmcnt(0)" ::: "memory");
        } else {
            XB_SPIN(xb_ld(&bar[XB_XGEN(b.x)]) == gen, bar);
            __builtin_amdgcn_fence(__ATOMIC_ACQUIRE, "agent");
            asm volatile("s_waitcnt vmcnt(0)" ::: "memory");
        }
    }
    __syncthreads();
}

namespace pg8 {
constexpr int BM = 256, BK = 64, HALF = 128, HTB = HALF * BK * 2, STAGE_BYTES = 8 * HTB, NXCD = 8, WGM = 8;
__host__ __device__ __forceinline__ int lds_byte(int r, int c) { const int st = (r >> 4) * 2 + (c >> 5), rr = r & 15, cc = c & 31, ob = rr * 64 + cc * 2; return st * 1024 + (ob ^ (((ob >> 9) & 1) << 5)); }
__host__ __device__ __forceinline__ void stage_rc(int b, int& R, int& C) { const int st = b / 1024, sb = b % 1024, swz = sb ^ (((sb >> 9) & 1) << 5); R = (st >> 1) * 16 + swz / 64; C = (st & 1) * 32 + (swz % 64) / 2; }
__host__ __device__ __forceinline__ int perm32(int rho) { const int n = rho >> 4, i = rho & 15; return 8 * (i >> 2) + 4 * n + (i & 3); }

struct Unit { int pm, pn, z; };
struct Gemm { const bf16_t* A; const bf16_t* Bt; int lda, ldb, K; size_t azs, bzs; };

struct StaticOrder {
    int nM, nN, nwg, G, c;
    __host__ __device__ __forceinline__ void init(int M, int N, int G_, int c_) { nM = M / BM; nN = N / BM; nwg = nM * nN; G = G_; c = c_; }
    __host__ __device__ __forceinline__ bool next(int i, Unit& u) const {
        const long L = (long)i * G + c; if (L >= nwg) return false;
        int wgid = (int)L; { const int q = nwg / NXCD, r = nwg % NXCD, xcd = wgid % NXCD, off = wgid / NXCD; wgid = (xcd < r ? xcd * (q + 1) : r * (q + 1) + (xcd - r) * q) + off; }
        const int nig = WGM * nN, gid = wgid / nig, fm = gid * WGM, gsz = (nM - fm) < WGM ? (nM - fm) : WGM;
        u.pm = fm + ((wgid % nig) % gsz); u.pn = (wgid % nig) / gsz; u.z = 0; return true;
    }
};
struct PairOrder {
    StaticOrder s;
    __host__ __device__ __forceinline__ bool next(int i, Unit& u) const { if (!s.next(i >> 1, u)) return false; u.z = i & 1; return true; }
};

template <class Epi, class Sched, bool ALIGN_EPI = true, bool SP2 = true>
__device__ __forceinline__ void gemm_phase(LAS unsigned char* lds, const int tid, const Gemm g, const Sched& S, const Epi& E) {
    const int wid = __builtin_amdgcn_readfirstlane(tid >> 6), lane = tid & 63, wr = wid >> 2, wc = wid & 3, fr = lane & 15, fq = lane >> 4;
    const int K = g.K, nt = K / BK;
    unsigned voffA[2], voffB[2];
#pragma unroll
    for (int i = 0; i < 2; ++i) { int R, C; stage_rc(tid * 16 + i * 8192, R, C); const int Rb = Epi::PERM ? ((R & ~31) + perm32(R & 31)) : R;
        const int Ra = Epi::PERM_A ? ((R & 64) | ((R & 15) << 2) | ((R >> 4) & 3)) : R;
        voffA[i] = (unsigned)(Ra * g.lda + C) * 2u; voffB[i] = (unsigned)(Rb * g.ldb + C) * 2u; }
    const size_t kstep = (size_t)(BK * 2);
    const size_t hstepA = (size_t)HALF * g.lda * 2, hstepB = (size_t)HALF * g.ldb * 2;
    const size_t tstepA = 2 * hstepA, tstepB = 2 * hstepB;
    const unsigned ldsw = (unsigned)wid * 1024u;
    const int aoff = lds_byte(wr * 64 + fr, fq * 8), boff = lds_byte(wc * 32 + fr, fq * 8);
#define PG8_SA(b, h) (((b) * 2 + (h)) * HTB)
#define PG8_SB(b, h) ((4 + (b) * 2 + (h)) * HTB)
#define PG8_STAGE(bufoff, gbase, voff) do { _Pragma("unroll") for (int _i = 0; _i < 2; ++_i) \
        __builtin_amdgcn_global_load_lds((const unsigned*)((const char*)(gbase) + (voff)[_i]), (LAS unsigned*)(lds + (bufoff) + ldsw + _i * 8192), 16, 0, 0); } while (0)
#define PG8_LDA(dst, b, h) do { _Pragma("unroll") for (int m = 0; m < 4; ++m) { const i32x4 lo_ = *(const LAS i32x4*)(lds + PG8_SA(b, h) + aoff + m * 2048), hi_ = *(const LAS i32x4*)(lds + PG8_SA(b, h) + aoff + m * 2048 + 1024); \
        dst[m] = __builtin_shufflevector(lo_, hi_, 0, 1, 2, 3, 4, 5, 6, 7); } } while (0)
#define PG8_LDB(dst, b, h) do { _Pragma("unroll") for (int n = 0; n < 2; ++n) { const i32x4 lo_ = *(const LAS i32x4*)(lds + PG8_SB(b, h) + boff + n * 2048), hi_ = *(const LAS i32x4*)(lds + PG8_SB(b, h) + boff + n * 2048 + 1024); \
        dst[n] = __builtin_shufflevector(lo_, hi_, 0, 1, 2, 3, 4, 5, 6, 7); } } while (0)
#define PG8_MMA(ai, bj, At, Bt) do { __builtin_amdgcn_s_setprio(1); \
        _Pragma("unroll") for (int m = 0; m < 4; ++m) _Pragma("unroll") for (int n = 0; n < 2; ++n) { \
            if constexpr (Epi::FP8) asm volatile("v_mfma_scale_f32_16x16x128_f8f6f4 %0, %1, %2, %0, %3, %3 op_sel_hi:[0,0,0]" : "+v"(acc[ai][bj][m][n]) : "v"(Bt[n]), "v"(At[m]), "v"(sc1_));     \
            else { acc[ai][bj][m][n] = __builtin_amdgcn_mfma_f32_16x16x32_bf16(__builtin_bit_cast(bf16x8, __builtin_shufflevector(Bt[n], Bt[n], 0, 1, 2, 3)), __builtin_bit_cast(bf16x8, __builtin_shufflevector(At[m], At[m], 0, 1, 2, 3)), acc[ai][bj][m][n], 0, 0, 0); \
                   acc[ai][bj][m][n] = __builtin_amdgcn_mfma_f32_16x16x32_bf16(__builtin_bit_cast(bf16x8, __builtin_shufflevector(Bt[n], Bt[n], 4, 5, 6, 7)), __builtin_bit_cast(bf16x8, __builtin_shufflevector(At[m], At[m], 4, 5, 6, 7)), acc[ai][bj][m][n], 0, 0, 0); } } \
        __builtin_amdgcn_s_setprio(0); } while (0)
#define PG8_WAIT_V(n) asm volatile("s_waitcnt vmcnt(" #n ")" ::: "memory")
#define PG8_WAIT_L(n) asm volatile("s_waitcnt lgkmcnt(" #n ")" ::: "memory")
#define PG8_BAR __builtin_amdgcn_s_barrier()
#define PG8_SCHED __builtin_amdgcn_sched_barrier(0)
    Unit cur, nxt; int ui = 0;
    if (!S.next(0, cur)) return;
    f32x4 acc[2][2][4][2];
#pragma unroll
    for (int a = 0; a < 2; ++a)
#pragma unroll
        for (int b = 0; b < 2; ++b)
#pragma unroll
            for (int m = 0; m < 4; ++m)
#pragma unroll
                for (int n = 0; n < 2; ++n) acc[a][b][m][n] = (f32x4){0.f, 0.f, 0.f, 0.f};
    i32x8 At[4], B0[2], B1[2];
    const int sc1_ = 0x7f7f7f7f;
    const char* cA = (const char*)g.A + (size_t)cur.z * g.azs + (size_t)cur.pm * tstepA; const char* cB = (const char*)g.Bt + (size_t)cur.z * g.bzs + (size_t)cur.pn * tstepB;
    if constexpr (SP2) {
        PG8_STAGE(PG8_SB(0, 0), cB, voffB); PG8_STAGE(PG8_SB(0, 1), cB + hstepB, voffB); PG8_STAGE(PG8_SA(0, 0), cA, voffA); PG8_STAGE(PG8_SA(0, 1), cA + hstepA, voffA);
        if (wr == 1) PG8_BAR;
        PG8_WAIT_V(2); PG8_BAR;
        PG8_STAGE(PG8_SB(1, 0), cB + kstep, voffB); PG8_STAGE(PG8_SA(1, 0), cA + kstep, voffA); PG8_STAGE(PG8_SB(1, 1), cB + hstepB + kstep, voffB);
        PG8_WAIT_V(6); PG8_BAR;
    } else {
        PG8_STAGE(PG8_SB(0, 0), cB, voffB); PG8_STAGE(PG8_SA(0, 0), cA, voffA); PG8_STAGE(PG8_SB(0, 1), cB + hstepB, voffB); PG8_STAGE(PG8_SA(0, 1), cA + hstepA, voffA);
        if (wr == 1) PG8_BAR;
        PG8_WAIT_V(4); PG8_BAR;
        PG8_STAGE(PG8_SB(1, 0), cB + kstep, voffB); PG8_STAGE(PG8_SA(1, 0), cA + kstep, voffA); PG8_STAGE(PG8_SB(1, 1), cB + hstepB + kstep, voffB);
        PG8_WAIT_V(6); PG8_BAR;
    }
    for (;;) {
        const bool has_next = S.next(ui + 1, nxt);
        const char* nA = has_next ? (const char*)g.A + (size_t)nxt.z * g.azs + (size_t)nxt.pm * tstepA : cA; const char* nB = has_next ? (const char*)g.Bt + (size_t)nxt.z * g.bzs + (size_t)nxt.pn * tstepB : cB;
        for (int t = 0; t < nt; t += 2) {
            const bool last = (t == nt - 2);
            const char* a1 = cA + (size_t)(t + 1) * kstep;
            const char* a2 = last ? nA : cA + (size_t)(t + 2) * kstep; const char* b2 = last ? nB : cB + (size_t)(t + 2) * kstep;
            const char* a3 = a2 + kstep; const char* b3 = b2 + kstep;
            if constexpr (SP2) {
            PG8_LDB(B0, 0, 0); PG8_LDB(B1, 0, 1); PG8_SCHED; PG8_LDA(At, 0, 0); PG8_STAGE(PG8_SA(1, 1), a1 + hstepA, voffA);
            PG8_WAIT_V(8); PG8_WAIT_L(0); PG8_BAR; PG8_MMA(0, 0, At, B0); PG8_MMA(0, 1, At, B1); PG8_BAR; PG8_SCHED;
            PG8_LDA(At, 0, 1); PG8_STAGE(PG8_SB(0, 0), b2, voffB); PG8_STAGE(PG8_SB(0, 1), b2 + hstepB, voffB); PG8_STAGE(PG8_SA(0, 0), a2, voffA);
            PG8_WAIT_V(8); PG8_WAIT_L(0); PG8_BAR; PG8_MMA(1, 0, At, B0); PG8_MMA(1, 1, At, B1); PG8_BAR; PG8_SCHED;
            PG8_LDB(B0, 1, 0); PG8_LDB(B1, 1, 1); PG8_SCHED; PG8_LDA(At, 1, 0); PG8_STAGE(PG8_SA(0, 1), a2 + hstepA, voffA);
            PG8_WAIT_V(8); PG8_WAIT_L(0); PG8_BAR; PG8_MMA(0, 0, At, B0); PG8_MMA(0, 1, At, B1); PG8_BAR; PG8_SCHED;
            PG8_LDA(At, 1, 1); PG8_STAGE(PG8_SB(1, 0), b3, voffB); PG8_STAGE(PG8_SB(1, 1), b3 + hstepB, voffB); PG8_STAGE(PG8_SA(1, 0), a3, voffA);
            PG8_WAIT_V(8); PG8_WAIT_L(0); PG8_BAR; PG8_MMA(1, 0, At, B0); PG8_MMA(1, 1, At, B1); PG8_BAR; PG8_SCHED;
            } else {
            PG8_LDB(B0, 0, 0); PG8_SCHED; PG8_LDA(At, 0, 0); PG8_STAGE(PG8_SA(1, 1), a1 + hstepA, voffA);
            PG8_WAIT_L(8); PG8_BAR; PG8_WAIT_L(0); PG8_MMA(0, 0, At, B0); PG8_BAR; PG8_SCHED;
            PG8_LDB(B1, 0, 1); PG8_STAGE(PG8_SB(0, 0), b2, voffB);
            PG8_BAR; PG8_WAIT_L(0); PG8_MMA(0, 1, At, B1); PG8_BAR;
            PG8_LDA(At, 0, 1); PG8_STAGE(PG8_SA(0, 0), a2, voffA);
            PG8_BAR; PG8_WAIT_L(0); PG8_MMA(1, 0, At, B0); PG8_BAR; PG8_SCHED;
            PG8_STAGE(PG8_SB(0, 1), b2 + hstepB, voffB);
            PG8_WAIT_V(6); PG8_BAR; PG8_MMA(1, 1, At, B1); PG8_BAR;
            PG8_LDB(B0, 1, 0); PG8_SCHED; PG8_LDA(At, 1, 0); PG8_STAGE(PG8_SA(0, 1), a2 + hstepA, voffA);
            PG8_WAIT_L(8); PG8_BAR; PG8_WAIT_L(0); PG8_MMA(0, 0, At, B0); PG8_BAR; PG8_SCHED;
            PG8_LDB(B1, 1, 1); PG8_STAGE(PG8_SB(1, 0), b3, voffB);
            PG8_BAR; PG8_WAIT_L(0); PG8_MMA(0, 1, At, B1); PG8_BAR;
            PG8_LDA(At, 1, 1); PG8_STAGE(PG8_SA(1, 0), a3, voffA);
            PG8_BAR; PG8_WAIT_L(0); PG8_MMA(1, 0, At, B0); PG8_BAR; PG8_SCHED;
            PG8_STAGE(PG8_SB(1, 1), b3 + hstepB, voffB);
            PG8_WAIT_V(6); PG8_BAR; PG8_MMA(1, 1, At, B1); PG8_BAR;
            }
        }
        if constexpr (ALIGN_EPI) { if (wr == 0) PG8_BAR; }
        if constexpr (Epi::NEXT_HOOK) E(acc, cur, wr, wc, fr, fq, ui, has_next, nxt); else E(acc, cur, wr, wc, fr, fq);
        if (!has_next) break;
#pragma unroll
        for (int a = 0; a < 2; ++a)
#pragma unroll
            for (int b = 0; b < 2; ++b)
#pragma unroll
                for (int m = 0; m < 4; ++m)
#pragma unroll
                    for (int n = 0; n < 2; ++n) acc[a][b][m][n] = (f32x4){0.f, 0.f, 0.f, 0.f};
        cur = nxt; cA = nA; cB = nB; ++ui;
        if constexpr (ALIGN_EPI) { if (wr == 1) PG8_BAR; }
    }
    PG8_WAIT_V(0);
    if constexpr (!ALIGN_EPI) { if (wr == 0) PG8_BAR; }
    PG8_BAR;
#undef PG8_SA
#undef PG8_SB
#undef PG8_STAGE
#undef PG8_LDA
#undef PG8_LDB
#undef PG8_MMA
#undef PG8_WAIT_V
#undef PG8_WAIT_L
#undef PG8_BAR
#undef PG8_SCHED
}

struct EpiStoreBf16 {
    static constexpr bool NEXT_HOOK = false;
    static constexpr bool PERM = true, PERM_A = false, FP8 = false;
    bf16_t* O; int ldc; const fx64* ssq; float invk;
    __device__ __forceinline__ void operator()(const f32x4 (&acc)[2][2][4][2], const Unit& u, int wr, int wc, int fr, int fq) const {
        const int row0 = u.pm * BM + wr * 64 + fr, col0 = u.pn * BM + wc * 32 + 8 * fq;
        fx64 sv[2][4];
#pragma unroll
        for (int ai = 0; ai < 2; ++ai)
#pragma unroll
            for (int m = 0; m < 4; ++m) sv[ai][m] = ssq[row0 + ai * HALF + m * 16];
#pragma unroll
        for (int ai = 0; ai < 2; ++ai)
#pragma unroll
            for (int m = 0; m < 4; ++m) { bf16_t* rowp = O + (size_t)(row0 + ai * HALF + m * 16) * ldc + col0;
                const float rs = fast_rsq((float)sv[ai][m] * (FX_SSQ_INV * invk) + EPS);
#pragma unroll
                for (int bj = 0; bj < 2; ++bj) { const f32x4 v0 = acc[ai][bj][m][0] * rs, v1 = acc[ai][bj][m][1] * rs;
                    u32x4 w; w.x = cvt_pk_bf16(v0[0], v0[1]); w.y = cvt_pk_bf16(v0[2], v0[3]); w.z = cvt_pk_bf16(v1[0], v1[1]); w.w = cvt_pk_bf16(v1[2], v1[3]);
                    *(u32x4*)(rowp + bj * HALF) = w; } }
    }
};
struct EpiPab {
    static constexpr bool NEXT_HOOK = false;
    static constexpr bool PERM = true, PERM_A = false, FP8 = false;
    const bf16_t* proj; bf16_t* merged;
    __device__ __forceinline__ void operator()(const f32x4 (&acc)[2][2][4][2], const Unit& u, int wr, int wc, int fr, int fq) const {
        const int row0 = u.pm * BM + wr * 64 + fr, col0 = u.pn * BM + wc * 32 + 8 * fq;
        const int gcol = (u.z ? PC_GB : PC_GA) + col0;
        const bool z1 = (u.z != 0);
        u32x4 gw[2][2][2], pw[2][2][2];
#define PAB_LOAD(bt, buf) do { _Pragma("unroll") for (int mm = 0; mm < 2; ++mm) { const size_t r = (size_t)(row0 + ((bt) >> 1) * HALF + (((bt) & 1) * 2 + mm) * 16); \
            _Pragma("unroll") for (int bj = 0; bj < 2; ++bj) { gw[buf][mm][bj] = *(const u32x4*)(proj + r * NPROJ + gcol + bj * HALF); \
                pw[buf][mm][bj] = (u32x4){0u, 0u, 0u, 0u}; if (z1) pw[buf][mm][bj] = *(const u32x4*)(merged + r * DM + col0 + bj * HALF); } } } while (0)
        PAB_LOAD(0, 0);
#pragma unroll
        for (int bt = 0; bt < 4; ++bt) {
            __builtin_amdgcn_sched_barrier(0);
            if (bt + 1 < 4) { if ((bt & 1) == 0) PAB_LOAD(bt + 1, 1); else PAB_LOAD(bt + 1, 0); }
            __builtin_amdgcn_sched_barrier(0);
            const int ai = bt >> 1, buf = bt & 1;
#pragma unroll
            for (int mm = 0; mm < 2; ++mm) { const int m = (bt & 1) * 2 + mm; const size_t r = (size_t)(row0 + ai * HALF + m * 16);
#pragma unroll
                for (int bj = 0; bj < 2; ++bj) {
                    const u32x4 g = gw[buf][mm][bj], p = pw[buf][mm][bj];
                    const f32x4 v0 = acc[ai][bj][m][0], v1 = acc[ai][bj][m][1];
                    float o[8];
                    o[0] = sigmoidf_(bf_lo(g.x)) * v0[0]; o[1] = sigmoidf_(bf_hi(g.x)) * v0[1]; o[2] = sigmoidf_(bf_lo(g.y)) * v0[2]; o[3] = sigmoidf_(bf_hi(g.y)) * v0[3];
                    o[4] = sigmoidf_(bf_lo(g.z)) * v1[0]; o[5] = sigmoidf_(bf_hi(g.z)) * v1[1]; o[6] = sigmoidf_(bf_lo(g.w)) * v1[2]; o[7] = sigmoidf_(bf_hi(g.w)) * v1[3];
                    if (z1) { o[0] += bf_lo(p.x); o[1] += bf_hi(p.x); o[2] += bf_lo(p.y); o[3] += bf_hi(p.y); o[4] += bf_lo(p.z); o[5] += bf_hi(p.z); o[6] += bf_lo(p.w); o[7] += bf_hi(p.w); }
                    u32x4 w; w.x = cvt_pk_bf16(o[0], o[1]); w.y = cvt_pk_bf16(o[2], o[3]); w.z = cvt_pk_bf16(o[4], o[5]); w.w = cvt_pk_bf16(o[6], o[7]);
                    *(u32x4*)(merged + r * DM + col0 + bj * HALF) = w; } }
        }
#undef PAB_LOAD
    }
};
struct EpiResid {
    static constexpr bool NEXT_HOOK = false;
    static constexpr bool PERM = false, PERM_A = false, FP8 = false;
    const float* xsrc; float* out; const float* gate;
    __device__ __forceinline__ void operator()(const f32x4 (&acc)[2][2][4][2], const Unit& u, int wr, int wc, int fr, int fq) const {
        const int row0 = u.pm * BM + wr * 64 + fr, col0 = u.pn * BM + wc * 32 + 4 * fq;
        const float* gp = gate + (size_t)(u.pm >> 3) * NADA + col0;
        f32x4 gv[2][2];
#pragma unroll
        for (int bj = 0; bj < 2; ++bj)
#pragma unroll
            for (int n = 0; n < 2; ++n) gv[bj][n] = *(const f32x4*)(gp + bj * HALF + n * 16);
#pragma unroll
        for (int ai = 0; ai < 2; ++ai)
#pragma unroll
            for (int m = 0; m < 4; ++m) { const size_t off = (size_t)(row0 + ai * HALF + m * 16) * DM + col0;
#pragma unroll
                for (int bj = 0; bj < 2; ++bj)
#pragma unroll
                    for (int n = 0; n < 2; ++n) { const f32x4 xv = *(const f32x4*)(xsrc + off + bj * HALF + n * 16);
                        *(f32x4*)(out + off + bj * HALF + n * 16) = xv + gv[bj][n] * acc[ai][bj][m][n]; }
                if (m & 1) asm volatile("" ::: "memory"); }
    }
};

struct EpiProjNorm {
    static constexpr bool NEXT_HOOK = false;
    static constexpr bool PERM = true, PERM_A = false, FP8 = true;
    bf16_t* O; int ldc; const fx64* ssq; const fx64* bias; int ldb; LAS float* tab; fx64* ssq_lat;
    __device__ __forceinline__ void operator()(const f32x4 (&acc)[2][2][4][2], const Unit& u, int wr, int wc, int fr, int fq) const {
        { const int t = (int)threadIdx.x;
          if (t < 256) tab[t] = fast_rsq((float)ssq[u.pm * BM + t] * (FX_SSQ_INV / DM) + EPS) * W8_INV;
          else tab[t] = (float)bias[(size_t)(u.pm >> 3) * ldb + u.pn * BM + (t - 256)] * FX_BIAS_INV;
          asm volatile("s_waitcnt lgkmcnt(0)" ::: "memory"); __builtin_amdgcn_s_barrier(); asm volatile("" ::: "memory"); }
        const int rl = wr * 64 + fr, cl = wc * 32 + 8 * fq;
        const int row0 = u.pm * BM + rl, col0 = u.pn * BM + cl;
        const bool lat = (u.pn * BM >= PC_MQL && u.pn * BM < PC_GA);
        float sqr[8];
#pragma unroll
        for (int ai = 0; ai < 2; ++ai)
#pragma unroll
            for (int m = 0; m < 4; ++m) { const int row = row0 + ai * HALF + m * 16; bf16_t* rowp = O + (size_t)row * ldc + col0;
                const float rs = tab[rl + ai * HALF + m * 16];
                float sq = 0.f;
#pragma unroll
                for (int bj = 0; bj < 2; ++bj) { const f32x4 b0 = *(const LAS f32x4*)(tab + 256 + cl + bj * HALF), b1 = *(const LAS f32x4*)(tab + 256 + cl + bj * HALF + 4);
                    const f32x4 v0 = acc[ai][bj][m][0] * rs + b0, v1 = acc[ai][bj][m][1] * rs + b1;
                    if (lat) sq += v0[0] * v0[0] + v0[1] * v0[1] + v0[2] * v0[2] + v0[3] * v0[3] + v1[0] * v1[0] + v1[1] * v1[1] + v1[2] * v1[2] + v1[3] * v1[3];
                    u32x4 w; w.x = cvt_pk_bf16(v0[0], v0[1]); w.y = cvt_pk_bf16(v0[2], v0[3]); w.z = cvt_pk_bf16(v1[0], v1[1]); w.w = cvt_pk_bf16(v1[2], v1[3]);
                    *(u32x4*)(rowp + bj * HALF) = w; }
                if (lat) { sq += swz_xor<16>(sq); sq = pair32_sum(sq); }
                sqr[ai * 4 + m] = sq; }
        if (lat && fq == 0) { fx64* sl = ssq_lat + (u.pn * BM >= PC_MKVL ? MROWS : 0);
#pragma unroll
            for (int j = 0; j < 8; ++j) fx_add(sl + row0 + (j >> 2) * HALF + (j & 3) * 16, (double)sqr[j] * (double)FX_SSQ); }
        asm volatile("" ::: "memory");
    }
};
struct EpiResidNorm {
    static constexpr bool NEXT_HOOK = false;
    static constexpr bool PERM = false, PERM_A = false, FP8 = false;
    const float* xsrc; float* out; const float* gate;
    const float* gn; const float* scn; bf16_t* hn; fx64* ssq; int h8;
    __device__ __forceinline__ void operator()(const f32x4 (&acc)[2][2][4][2], const Unit& u, int wr, int wc, int fr, int fq) const {
        const int row0 = u.pm * BM + wr * 64 + fr, col0 = u.pn * BM + wc * 32 + 4 * fq;
        const float* gp = gate + (size_t)(u.pm >> 3) * NADA + col0;
        f32x4 gv[2][2], gs[2][2];
#pragma unroll
        for (int bj = 0; bj < 2; ++bj)
#pragma unroll
            for (int n = 0; n < 2; ++n) { gv[bj][n] = *(const f32x4*)(gp + bj * HALF + n * 16);
                gs[bj][n] = hn ? *(const f32x4*)(gn + col0 + bj * HALF + n * 16) * (*(const f32x4*)(scn + (size_t)(u.pm >> 3) * NADA + col0 + bj * HALF + n * 16) + 1.0f) : (f32x4){0.f, 0.f, 0.f, 0.f}; }
        f32x4 xv[3][2][2];
        float sqr[8];
#define RN_LOAD(g, buf) do { const size_t off = (size_t)(row0 + ((g) >> 2) * HALF + ((g) & 3) * 16) * DM + col0; \
            _Pragma("unroll") for (int bj = 0; bj < 2; ++bj) _Pragma("unroll") for (int n = 0; n < 2; ++n) xv[buf][bj][n] = *(const f32x4*)(xsrc + off + bj * HALF + n * 16); } while (0)
        RN_LOAD(0, 0); RN_LOAD(1, 1);
#pragma unroll
        for (int g = 0; g < 8; ++g) {
            __builtin_amdgcn_sched_barrier(0);
            if (g + 2 < 8) { if ((g + 2) % 3 == 0) RN_LOAD(g + 2, 0); else if ((g + 2) % 3 == 1) RN_LOAD(g + 2, 1); else RN_LOAD(g + 2, 2); }
            __builtin_amdgcn_sched_barrier(0);
            const int ai = g >> 2, m = g & 3, buf = g % 3;
            const int row = row0 + ai * HALF + m * 16; const size_t off = (size_t)row * DM + col0;
            float sq = 0.f;
#pragma unroll
            for (int bj = 0; bj < 2; ++bj)
#pragma unroll
                for (int n = 0; n < 2; ++n) {
                    const f32x4 o = xv[buf][bj][n] + gv[bj][n] * acc[ai][bj][m][n];
                    *(f32x4*)(out + off + bj * HALF + n * 16) = o;
                    if (hn) { sq += o[0] * o[0] + o[1] * o[1] + o[2] * o[2] + o[3] * o[3];
                        const f32x4 hv = o * gs[bj][n];
                        if (h8) *(unsigned*)((unsigned char*)hn + off + bj * HALF + n * 16) = cvt_fp8x4(hv[0], hv[1], hv[2], hv[3]);
                        else { u32x2 w; w.x = cvt_pk_bf16(hv[0], hv[1]); w.y = cvt_pk_bf16(hv[2], hv[3]); *(u32x2*)(hn + off + bj * HALF + n * 16) = w; } } }
            if (hn) { sq += swz_xor<16>(sq); sq = pair32_sum(sq); }
            sqr[g] = sq;
        }
#undef RN_LOAD
        if (hn && fq == 0) {
#pragma unroll
            for (int j = 0; j < 8; ++j) fx_add(ssq + row0 + (j >> 2) * HALF + (j & 3) * 16, (double)sqr[j] * (double)FX_SSQ); }
    }
};

template <int CTRL> __device__ __forceinline__ float dpp_old_f(float oldv, float v) { return __int_as_float(__builtin_amdgcn_update_dpp(__float_as_int(oldv), __float_as_int(v), CTRL, 0xf, 0xf, false)); }
struct EpiUpConv {
    static constexpr bool NEXT_HOOK = true;
    static constexpr bool PERM = true, PERM_A = true, FP8 = false;
    const float* wconv; const float* bconv; bf16_t* act; float* uhead; float* utail; LAS float* xb; const fx64* ssq; const fx64* bias; LAS float* tab0; LAS float* ctab0; LAS float* tab1; LAS float* ctab1;
    __device__ __forceinline__ static int xidx(int ai, int rr, int wr, int wc, int bj, int n, int fq) { return ((((((ai * 2 + rr) * 2 + wr) * 4 + wc) * 2 + bj) * 2 + n) * 4 + fq) * 4; }
    __device__ __forceinline__ void tab_load(const Unit& uu, int t, fx64& v, float& c0, float& c1) const {
        v = (t < 256) ? ssq[uu.pm * BM + t] : bias[(size_t)(uu.pm >> 3) * NUP + uu.pn * BM + (t - 256)];
        { const int e = t, tap = e >> 8, half = (e >> 7) & 1, c = e & 127; c0 = (wconv + (size_t)tap * NUP)[uu.pn * HALF + half * DFF + c]; }
        { const int e = t + 512, tap = e >> 8, half = (e >> 7) & 1, c = e & 127; const float* sp = (tap < 3) ? (wconv + (size_t)tap * NUP) : bconv; c1 = sp[uu.pn * HALF + half * DFF + c]; } }
    __device__ __forceinline__ static void tab_store(LAS float* tb, LAS float* ct, int t, fx64 v, float c0, float c1) {
        if (t < 256) tb[t] = fast_rsq((float)v * (FX_SSQ_INV / DM) + EPS); else tb[t] = (float)v * FX_BIAS_INV;
        ct[t] = c0; ct[t + 512] = c1; }
    __device__ __forceinline__ void operator()(f32x4 (&acc)[2][2][4][2], const Unit& u, int wr, int wc, int fr, int fq, int ui, bool has_next, const Unit& nxt) const {
        LAS float* tab = (ui & 1) ? tab1 : tab0; LAS float* ctab = (ui & 1) ? ctab1 : ctab0;
        const int t = ((wr * 4 + wc) << 6) + (fq << 4) + fr;
        const int colp = u.pn * BM + wc * 32 + 8 * fq;
        const int ch0 = u.pn * HALF + wc * 32 + 8 * fq;
        {
            if (ui == 0) { fx64 v; float c0, c1; tab_load(u, t, v, c0, c1); tab_store(tab, ctab, t, v, c0, c1);
                asm volatile("s_waitcnt lgkmcnt(0)" ::: "memory"); __builtin_amdgcn_s_barrier(); asm volatile("" ::: "memory"); }
            f32x4 rs[2];
#pragma unroll
            for (int ai = 0; ai < 2; ++ai) rs[ai] = *(const LAS f32x4*)(tab + ai * HALF + wr * 64 + 4 * fr);
#pragma unroll
            for (int bj = 0; bj < 2; ++bj)
#pragma unroll
                for (int n = 0; n < 2; ++n) { const f32x4 bv = *(const LAS f32x4*)(tab + 256 + wc * 32 + 8 * fq + bj * HALF + 4 * n);
#pragma unroll
                    for (int ai = 0; ai < 2; ++ai)
#pragma unroll
                        for (int m = 0; m < 4; ++m) acc[ai][bj][m][n] = acc[ai][bj][m][n] * rs[ai][m] + bv; }
        }
        fx64 nv = 0; float nc0 = 0.f, nc1 = 0.f;
        if (has_next) tab_load(nxt, t, nv, nc0, nc1);
        if (fr == 15) {
#pragma unroll
            for (int ai = 0; ai < 2; ++ai)
#pragma unroll
                for (int bj = 0; bj < 2; ++bj)
#pragma unroll
                    for (int n = 0; n < 2; ++n) { *(LAS f32x4*)(xb + xidx(ai, 0, wr, wc, bj, n, fq)) = acc[ai][bj][2][n]; *(LAS f32x4*)(xb + xidx(ai, 1, wr, wc, bj, n, fq)) = acc[ai][bj][3][n]; }
            if (wr == 1) {
#pragma unroll
                for (int bj = 0; bj < 2; ++bj)
#pragma unroll
                    for (int n = 0; n < 2; ++n) { *(f32x4*)(utail + (size_t)(u.pm * 2 + 0) * NUP + colp + bj * HALF + 4 * n) = acc[1][bj][2][n]; *(f32x4*)(utail + (size_t)(u.pm * 2 + 1) * NUP + colp + bj * HALF + 4 * n) = acc[1][bj][3][n]; }
            }
        }
        if (fr == 0 && wr == 0) {
#pragma unroll
            for (int bj = 0; bj < 2; ++bj)
#pragma unroll
                for (int n = 0; n < 2; ++n) { *(f32x4*)(uhead + (size_t)(u.pm * 2 + 0) * NUP + colp + bj * HALF + 4 * n) = acc[0][bj][0][n]; *(f32x4*)(uhead + (size_t)(u.pm * 2 + 1) * NUP + colp + bj * HALF + 4 * n) = acc[0][bj][1][n]; }
        }
        asm volatile("s_waitcnt lgkmcnt(0)" ::: "memory"); __builtin_amdgcn_s_barrier(); asm volatile("" ::: "memory");
        const bool skip01 = (wr == 0) && (fr == 0) && ((u.pm & 7) != 0);
        const LAS float* cl = ctab + wc * 32 + 8 * fq;
        f32x4 cg[4];
#pragma unroll
        for (int it = 0; it < 8; ++it) {
            const int n = it >> 2, ai = (it >> 1) & 1, bj = it & 1;
            const f32x4 w0 = *(const LAS f32x4*)(cl + (0 * 2 + bj) * 128 + 4 * n), w1 = *(const LAS f32x4*)(cl + (1 * 2 + bj) * 128 + 4 * n), w2 = *(const LAS f32x4*)(cl + (2 * 2 + bj) * 128 + 4 * n), bb = *(const LAS f32x4*)(cl + (3 * 2 + bj) * 128 + 4 * n);
            f32x4 p1 = (f32x4){0.f, 0.f, 0.f, 0.f}, p2 = p1;
            if (wr == 1 || ai == 1) {
                const int sai = (wr == 1) ? ai : 0, swr = (wr == 1) ? 0 : 1;
                p2 = *(const LAS f32x4*)(xb + xidx(sai, 0, swr, wc, bj, n, fq)); p1 = *(const LAS f32x4*)(xb + xidx(sai, 1, swr, wc, bj, n, fq));
            }
            const f32x4 v0 = acc[ai][bj][0][n], v1 = acc[ai][bj][1][n], v2 = acc[ai][bj][2][n], v3 = acc[ai][bj][3][n];
            f32x4 s3, s2;
#pragma unroll
            for (int e = 0; e < 4; ++e) { s3[e] = dpp_old_f<0x111>(p1[e], v3[e]); s2[e] = dpp_old_f<0x111>(p2[e], v2[e]); }
#pragma unroll
            for (int m = 0; m < 4; ++m) {
                const f32x4 v = (m == 0) ? v0 : (m == 1) ? v1 : (m == 2) ? v2 : v3;
                const f32x4 q1 = (m == 0) ? s3 : (m == 1) ? v0 : (m == 2) ? v1 : v2;
                const f32x4 q2 = (m == 0) ? s2 : (m == 1) ? s3 : (m == 2) ? v0 : v1;
                const f32x4 cvv = bb + w0 * q2 + w1 * q1 + w2 * v;
                if (bj == 0) cg[m] = cvv;
                else {
                    float o[4];
#pragma unroll
                    for (int e = 0; e < 4; ++e) { const float g = cg[m][e]; o[e] = g * sigmoidf_(g) * cvv[e]; }
                    u32x2 ow; ow.x = cvt_pk_bf16(o[0], o[1]); ow.y = cvt_pk_bf16(o[2], o[3]);
                    const int row = u.pm * BM + ai * HALF + wr * 64 + 4 * fr + m;
                    if (!(skip01 && ai == 0 && m < 2)) *(u32x2*)(act + (size_t)row * DFF + ch0 + 4 * n) = ow;
                }
            }
        }
        if (has_next) tab_store((ui & 1) ? tab0 : tab1, (ui & 1) ? ctab0 : ctab1, t, nv, nc0, nc1);
    }
};
}

struct Args { const void* in[23]; float* out; unsigned char* ws; float inv_a[16]; float inv_i[8]; float inv_m[32]; int ph_lo, ph_hi; };
static_assert(sizeof(Args) == 23 * 8 + 16 + 56 * 4 + 8, "Args has no padding");

typedef const __attribute__((address_space(4))) struct Args* ArgsCP;
struct Frame {
    LAS unsigned char* lds; int tid, lane, wave, G, bid;
    unsigned char* ws; ArgsCP a;
};

__device__ __forceinline__ void sincos_d(double a, float& s, float& c) {
    const double q = __builtin_rint(a * 0.63661977236758134308);
    double r = __builtin_fma(-q, 1.57079632673412561417e+00, a);
    r = __builtin_fma(-q, 6.07710050650619224932e-11, r);
    const double r2 = r * r;
    double sp = -7.6471637318198164759e-13; sp = sp * r2 + 1.6059043836821614599e-10; sp = sp * r2 - 2.5052108385441718775e-08; sp = sp * r2 + 2.7557319223985890653e-06;
    sp = sp * r2 - 1.9841269841269841270e-04; sp = sp * r2 + 8.3333333333333333333e-03; sp = sp * r2 - 1.6666666666666666667e-01; const double sr = r + r * r2 * sp;
    double cp = 4.7794773323873852974e-14; cp = cp * r2 - 1.1470745597729724714e-11; cp = cp * r2 + 2.0876756987868098979e-09; cp = cp * r2 - 2.7557319223985890653e-07;
    cp = cp * r2 + 2.4801587301587301587e-05; cp = cp * r2 - 1.3888888888888888889e-03; cp = cp * r2 + 4.1666666666666666667e-02; cp = cp * r2 - 0.5; const double cr = 1.0 + r2 * cp;
    const int qi = ((int)q) & 3;
    const double sv = (qi == 0) ? sr : (qi == 1) ? cr : (qi == 2) ? -sr : -cr;
    const double cv = (qi == 0) ? cr : (qi == 1) ? -sr : (qi == 2) ? -cr : sr;
    s = (float)sv; c = (float)cv;
}

__device__ __forceinline__ int cmap_in(int n) {
    if (n < 2640) return n;
    if (n < 2704) return 3408 + (n - 2640);
    if (n < 2816) return -1;
    if (n < 3328) return 2640 + (n - 2816);
    if (n < 3584) return 3152 + (n - 3328);
    return 3472 + (n - 3584);
}
__device__ __forceinline__ int cmap_up(int n) { const int j = n >> 8, w = n & 255; return (w < 128) ? (128 * j + w) : (DFF + 128 * j + (w - 128)); }

struct TileDesc { const float* src; bf16_t* dst; const float* shift; fx64* bias; const float* gk; int ldsrc, K, k0, n0, mode, ldbias; float w8; };
__device__ __forceinline__ void tile_load(const Frame& F, const TileDesc& d, f32x4 (&v)[8], float& shv) {
    const int a = F.tid >> 5, n4 = F.tid & 31; const int n = d.n0 + 4 * n4;
    const int c = (d.mode == 0) ? n : (d.mode == 1) ? cmap_in(n) : cmap_up(n);
#pragma unroll
    for (int i = 0; i < 8; ++i) v[i] = (c >= 0) ? *(const f32x4*)(d.src + (size_t)(d.k0 + 8 * a + i) * d.ldsrc + c) : (f32x4){0.f, 0.f, 0.f, 0.f};
    shv = d.bias ? d.shift[(size_t)(F.tid >> 7) * NADA + d.k0 + (F.tid & 127)] : 0.f;
}
constexpr int TR_SH = 69632, TR_RED = 73728;
__device__ __forceinline__ void tile_to_lds(const Frame& F, const TileDesc& d, const f32x4 (&v)[8], float shv) {
    LAS unsigned char* O = F.lds;
    const int a = F.tid >> 5, n4 = F.tid & 31;
    if (d.w8 != 0.f) {
        const int pos = a ^ ((n4 & 7) << 1);
#pragma unroll
        for (int e = 0; e < 4; ++e) { u32x2 w; w.x = cvt_fp8x4(v[0][e] * d.w8, v[1][e] * d.w8, v[2][e] * d.w8, v[3][e] * d.w8); w.y = cvt_fp8x4(v[4][e] * d.w8, v[5][e] * d.w8, v[6][e] * d.w8, v[7][e] * d.w8);
            *(LAS u32x2*)(O + (4 * n4 + e) * 128 + pos * 8) = w; }
    } else {
        const int pos = a ^ (n4 & 15);
        f32x4 g0 = (f32x4){1.f, 1.f, 1.f, 1.f}, g1 = g0;
        if (d.gk) { g0 = *(const f32x4*)(d.gk + d.k0 + 8 * a); g1 = *(const f32x4*)(d.gk + d.k0 + 8 * a + 4); }
#pragma unroll
        for (int e = 0; e < 4; ++e) { u32x4 w; w.x = cvt_pk_bf16(v[0][e] * g0[0], v[1][e] * g0[1]); w.y = cvt_pk_bf16(v[2][e] * g0[2], v[3][e] * g0[3]); w.z = cvt_pk_bf16(v[4][e] * g1[0], v[5][e] * g1[1]); w.w = cvt_pk_bf16(v[6][e] * g1[2], v[7][e] * g1[3]);
            *(LAS u32x4*)(O + (4 * n4 + e) * 256 + pos * 16) = w; }
    }
    if (d.bias) ((LAS float*)(F.lds + TR_SH))[F.tid] = shv;
}
__device__ __forceinline__ void tile_bias(const Frame& F, const TileDesc& d, const f32x4 (&v)[8], float (&pb)[16]) {
#pragma unroll
    for (int x = 0; x < 16; ++x) pb[x] = 0.f;
    if (d.bias) { const LAS float* SH = (const LAS float*)(F.lds + TR_SH); const int a = F.tid >> 5;
#pragma unroll
        for (int b = 0; b < 4; ++b) { const f32x4 s0 = *(const LAS f32x4*)(SH + b * 128 + 8 * a), s1 = *(const LAS f32x4*)(SH + b * 128 + 8 * a + 4);
#pragma unroll
            for (int e = 0; e < 4; ++e) pb[b * 4 + e] = v[0][e] * s0[0] + v[1][e] * s0[1] + v[2][e] * s0[2] + v[3][e] * s0[3] + v[4][e] * s1[0] + v[5][e] * s1[1] + v[6][e] * s1[2] + v[7][e] * s1[3]; } }
}
__device__ __forceinline__ void tile_finish(const Frame& F, const TileDesc& d, float (&pb)[16]) {
    const LAS unsigned char* O = F.lds; LAS float* RED = (LAS float*)(F.lds + TR_RED);
    if (d.bias) {
#pragma unroll
        for (int x = 0; x < 16; ++x) pb[x] = pair32_sum(pb[x]);
        if (F.lane < 32) {
#pragma unroll
            for (int b = 0; b < 4; ++b) *(LAS f32x4*)(RED + (F.wave * 4 + b) * 128 + 4 * F.lane) = (f32x4){pb[b * 4 + 0], pb[b * 4 + 1], pb[b * 4 + 2], pb[b * 4 + 3]}; }
    }
    if (d.w8 != 0.f) {
#pragma unroll
        for (int p = 0; p < 2; ++p) { const int n = 64 * p + (F.tid >> 3), c16 = F.tid & 7; const int m = c16 ^ ((n >> 2) & 7);
            const u32x4 w = *(const LAS u32x4*)(O + n * 128 + m * 16);
            *(u32x4*)((unsigned char*)d.dst + (size_t)(d.n0 + n) * d.K + d.k0 + 16 * c16) = w; }
    } else {
#pragma unroll
        for (int p = 0; p < 4; ++p) { const int n = 32 * p + (F.tid >> 4), c = F.tid & 15; const int pos = c ^ ((n >> 2) & 15);
            const u32x4 w = *(const LAS u32x4*)(O + n * 256 + pos * 16);
            *(u32x4*)(d.dst + (size_t)(d.n0 + n) * d.K + d.k0 + 8 * c) = w; }
    }
    if (d.bias) {
        __syncthreads();
        const int b = F.tid >> 7, n = F.tid & 127;
        float sum = 0.f;
#pragma unroll
        for (int w = 0; w < 8; ++w) sum += RED[(w * 4 + b) * 128 + n];
        fx_add(d.bias + (size_t)b * d.ldbias + d.n0 + n, (double)sum * FX_BIAS);
    }
}

constexpr int TR_IN = 960, TR_MQ = 48, TR_MKV = 32, TR_PA = 128, TR_PB = 128, TR_WO = 256, TR_UP = 1408, TR_DN = 704;
constexpr int TR_C1 = TR_IN, TR_C2 = TR_C1 + TR_MQ, TR_C3 = TR_C2 + TR_MKV, TR_C4 = TR_C3 + TR_PA, TR_C5 = TR_C4 + TR_PB, TR_C6 = TR_C5 + TR_WO, TR_C7 = TR_C6 + TR_UP, TR_C8 = TR_C7 + TR_DN;
__device__ __forceinline__ TileDesc tr_make(const Frame& F, const int l, const int r) {
    ArgsCP ap = F.a; unsigned char* ws = F.ws;
    const float* modl = (const float*)(ws + WS_MOD) + (size_t)l * NBATCH * NADA;
    fx64* bias_in = (fx64*)(ws + WS_BIAS); fx64* bias_up = (fx64*)(ws + WS_BIAS_UP);
    TileDesc d; d.shift = nullptr; d.bias = nullptr; d.gk = nullptr; d.ldbias = 0; d.mode = 0; d.w8 = 0.f;
    if (r < TR_C1) { const int ti = r; d.src = (const float*)ap->in[7] + (size_t)l * DM * IN_DIM; d.ldsrc = IN_DIM; d.K = DM; d.dst = (bf16_t*)(ws + WS_WIN + (size_t)l * NPROJ * DM); d.w8 = W8_SCALE; d.k0 = (ti / 60) * 128; d.n0 = (ti % 60) * 128; d.mode = 1; d.shift = modl; d.bias = bias_in + (size_t)l * NBATCH * NPROJ; d.ldbias = NPROJ; }
    else if (r < TR_C2) { const int ti = r - TR_C1; d.src = (const float*)ap->in[11] + (size_t)l * 512 * 1536; d.ldsrc = 1536; d.K = 512; d.dst = (bf16_t*)(ws + WS_WMQ) + (size_t)l * 1536 * 512; d.k0 = (ti / 12) * 128; d.n0 = (ti % 12) * 128; d.gk = (const float*)ap->in[10] + l * 512; }
    else if (r < TR_C3) { const int ti = r - TR_C2; d.src = (const float*)ap->in[13] + (size_t)l * 256 * 2048; d.ldsrc = 2048; d.K = 256; d.dst = (bf16_t*)(ws + WS_WMKV) + (size_t)l * 2048 * 256; d.k0 = (ti / 16) * 128; d.n0 = (ti % 16) * 128; d.gk = (const float*)ap->in[12] + l * 256; }
    else if (r < TR_C4) { const int ti = r - TR_C3; d.src = (const float*)ap->in[16] + (size_t)l * 1024 * 2048; d.ldsrc = 2048; d.K = 1024; d.dst = (bf16_t*)(ws + WS_WPAB) + (size_t)l * 4096 * 1024; d.k0 = (ti / 16) * 128; d.n0 = (ti % 16) * 128; }
    else if (r < TR_C5) { const int ti = r - TR_C4; d.src = (const float*)ap->in[17] + (size_t)l * 1024 * 2048; d.ldsrc = 2048; d.K = 1024; d.dst = (bf16_t*)(ws + WS_WPAB) + (size_t)l * 4096 * 1024 + (size_t)2048 * 1024; d.k0 = (ti / 16) * 128; d.n0 = (ti % 16) * 128; }
    else if (r < TR_C6) { const int ti = r - TR_C5; d.src = (const float*)ap->in[18] + (size_t)l * 2048 * 2048; d.ldsrc = 2048; d.K = 2048; d.dst = (bf16_t*)(ws + WS_WO) + (size_t)l * 2048 * 2048; d.k0 = (ti / 16) * 128; d.n0 = (ti % 16) * 128; }
    else if (r < TR_C7) { const int ti = r - TR_C6; d.src = (const float*)ap->in[19] + (size_t)l * DM * NUP; d.ldsrc = NUP; d.K = DM; d.dst = (bf16_t*)(ws + WS_WUP) + (size_t)l * NUP * DM; d.k0 = (ti / 88) * 128; d.n0 = (ti % 88) * 128; d.mode = 2; d.shift = modl + 3 * DM; d.bias = bias_up + (size_t)l * NBATCH * NUP; d.ldbias = NUP; }
    else { const int ti = r - TR_C7; d.src = (const float*)ap->in[22] + (size_t)l * DFF * DM; d.ldsrc = DM; d.K = DFF; d.dst = (bf16_t*)(ws + WS_WDN) + (size_t)l * DM * DFF; d.k0 = (ti / 16) * 128; d.n0 = (ti % 16) * 128; }
    return d;
}
template <class Map>
__device__ __forceinline__ void tr_run(const Frame& F, const int n, const Map& map) {
    int k = 0;
    bool hasA = 0 < n, hasB = 1 < n;
    TileDesc dA, dB; f32x4 vA[8], vB[8]; float sA = 0.f, sB = 0.f;
    if (hasA) { int l, r; map(0, l, r); dA = tr_make(F, l, r); tile_load(F, dA, vA, sA); }
    if (hasB) { int l, r; map(1, l, r); dB = tr_make(F, l, r); tile_load(F, dB, vB, sB); }
#pragma unroll 1
    while (hasA) {
        __syncthreads();
        tile_to_lds(F, dA, vA, sA);
        __syncthreads();
        { const TileDesc dc = dA; hasA = k + 2 < n; float pb[16]; tile_bias(F, dc, vA, pb);
          if (hasA) { int l, r; map(k + 2, l, r); dA = tr_make(F, l, r); tile_load(F, dA, vA, sA); }
          tile_finish(F, dc, pb); }
        if (!hasB) break;
        __syncthreads();
        tile_to_lds(F, dB, vB, sB);
        __syncthreads();
        { const TileDesc dc = dB; hasB = k + 3 < n; float pb[16]; tile_bias(F, dc, vB, pb);
          if (hasB) { int l, r; map(k + 3, l, r); dB = tr_make(F, l, r); tile_load(F, dB, vB, sB); }
          tile_finish(F, dc, pb); }
        k += 2;
    }
    __syncthreads();
}
constexpr int LATE_UP = 7, LATE_IN = 3;
__device__ __forceinline__ int late_up_tiles(int G) { const int rem = ((MROWS / 256) * (NUP / 256)) % G; if (rem == 0) return 0; const int t = (G - rem) * LATE_UP; return t < TR_UP ? t : TR_UP; }
__device__ __forceinline__ int late_in_tiles(int G) { const int rem = ((MROWS / 256) * (NPROJ / 256)) % G; if (rem == 0) return 0; const int t = (G - rem) * LATE_IN, left = TR_UP - late_up_tiles(G); return t < left ? t : left; }
struct TrMapPrologue { int bid, G, late;
    __device__ __forceinline__ void operator()(int k, int& l, int& r) const { const int j = bid + k * G, early = TR_C8 - late;
        if (j < TR_C8) { l = 0; r = j; } else { const int jj = j - TR_C8; l = 1 + jj / early; r = jj % early; if (r >= TR_C6) r += late; } } };
struct TrMapLate { int l1, first, stride;
    __device__ __forceinline__ void operator()(int k, int& l, int& r) const { l = l1; r = TR_C6 + first + k * stride; } };
__device__ __forceinline__ void tr_late(const Frame& F, int l1, int ntiles_phase, int base, int count, int per) {
    const int rem = ntiles_phase % F.G;
    if (rem == 0 || F.bid < rem || count <= 0) return;
    const int nshort = F.G - rem, first = F.bid - rem;
    int n = (count - first + nshort - 1) / nshort; if (n > per) n = per; if (n <= 0) return;
    const TrMapLate map{l1, base + first, nshort};
    tr_run(F, n, map);
}

__device__ __forceinline__ void p0a_prologue(const Frame& F) {
    ArgsCP ap = F.a;
    unsigned char* ws = F.ws;
    {
        LAS float* CAct = (LAS float*)F.lds;
        LAS float* RED = (LAS float*)(F.lds + 32768);
        const float* c = (const float*)ap->in[1];
        for (int i = F.tid; i < NBATCH * DM; i += 512) { const float x = c[i]; CAct[i] = x * sigmoidf_(x); }
        __syncthreads();
        const float* w_ada = (const float*)ap->in[5]; const float* b_ada = (const float*)ap->in[6];
        float* mod = (float*)(ws + WS_MOD);
        const int rg = F.lane >> 4, cq = F.lane & 15;
        for (int it = F.bid; it < DEPTH * (NADA / 64); it += F.G) {
            const int l = it / (NADA / 64), n0 = (it % (NADA / 64)) * 64;
            const float* wp = w_ada + (size_t)l * DM * NADA + n0 + 4 * cq;
            const int kb = F.wave * 256 + rg * 64;
            f32x4 acc[4];
#pragma unroll
            for (int b = 0; b < 4; ++b) acc[b] = (f32x4){0.f, 0.f, 0.f, 0.f};
            for (int i0 = 0; i0 < 64; i0 += 16) {
                f32x4 wv[16];
#pragma unroll
                for (int i = 0; i < 16; ++i) wv[i] = *(const f32x4*)(wp + (size_t)(kb + i0 + i) * NADA);
#pragma unroll
                for (int i = 0; i < 16; ++i) {
#pragma unroll
                    for (int b = 0; b < 4; ++b) acc[b] += CAct[b * DM + kb + i0 + i] * wv[i]; }
            }
#pragma unroll
            for (int b = 0; b < 4; ++b)
#pragma unroll
                for (int j = 0; j < 4; ++j) { float v = acc[b][j]; v += swz_xor<16>(v); v = pair32_sum(v); acc[b][j] = v; }
            if (rg == 0) {
#pragma unroll
                for (int b = 0; b < 4; ++b) *(LAS f32x4*)(RED + (F.wave * 4 + b) * 64 + 4 * cq) = acc[b]; }
            __syncthreads();
            if (F.tid < 256) { const int b = F.tid >> 6, col = F.tid & 63; float s = b_ada[(size_t)l * NADA + n0 + col];
#pragma unroll
                for (int w = 0; w < 8; ++w) s += RED[(w * 4 + b) * 64 + col];
                mod[((size_t)l * NBATCH + b) * NADA + n0 + col] = s; }
            __syncthreads();
        }
    }
    {
        const int* pos = (const int*)ap->in[2];
        float* CA = (float*)(ws + WS_ROPE); float* SA = CA + MROWS * 16; float* CI = SA + MROWS * 16; float* SI = CI + MROWS * 8; float* CM = SI + MROWS * 8; float* SM = CM + MROWS * 32;
        for (int i = F.bid * 512 + F.tid; i < MROWS * 56; i += F.G * 512) {
            const int r = i / 56, j = i % 56;
            const float p = (float)pos[r];
            float inv; float* cd; float* sd;
            if (j < 16) { inv = ap->inv_a[j]; cd = CA + r * 16 + j; sd = SA + r * 16 + j; }
            else if (j < 24) { inv = ap->inv_i[j - 16]; cd = CI + r * 8 + (j - 16); sd = SI + r * 8 + (j - 16); }
            else { inv = ap->inv_m[j - 24]; cd = CM + r * 32 + (j - 24); sd = SM + r * 32 + (j - 24); }
            const float ang = p * inv;
            float s, c; sincos_d((double)ang, s, c);
            *cd = c; *sd = s;
        }
    }
}

__device__ __forceinline__ void p0b_prologue(const Frame& F) {
    ArgsCP ap = F.a;
    unsigned char* ws = F.ws;
    const float* mod = (const float*)(ws + WS_MOD);
    {
        const float* x = (const float*)ap->in[0]; const float* g = (const float*)ap->in[3];
        unsigned char* h8 = ws + WS_H8; fx64* ssq = (fx64*)(ws + WS_SSQ);
        const int stride = F.G * 8;
        f32x4 gv[8];
#pragma unroll
        for (int i = 0; i < 8; ++i) gv[i] = *(const f32x4*)(g + (i * 64 + F.lane) * 4);
        for (int row0 = F.bid * 8 + F.wave; row0 < MROWS; row0 += 4 * stride) {
            f32x4 v[4][8];
#pragma unroll
            for (int k = 0; k < 4; ++k) { const int row = row0 + k * stride;
                if (row < MROWS) {
#pragma unroll
                    for (int i = 0; i < 8; ++i) v[k][i] = *(const f32x4*)(x + (size_t)row * DM + (i * 64 + F.lane) * 4); } }
#pragma unroll
            for (int k = 0; k < 4; ++k) { const int row = row0 + k * stride;
                if (row < MROWS) {
                    const float* mp = mod + (size_t)(row >> 11) * NADA + DM;
                    f32x4 sc[8];
#pragma unroll
                    for (int i = 0; i < 8; ++i) sc[i] = *(const f32x4*)(mp + (i * 64 + F.lane) * 4);
                    __builtin_amdgcn_sched_barrier(0);
                    float ss = 0.f;
#pragma unroll
                    for (int i = 0; i < 8; ++i) ss += v[k][i][0] * v[k][i][0] + v[k][i][1] * v[k][i][1] + v[k][i][2] * v[k][i][2] + v[k][i][3] * v[k][i][3];
                    ss = wave_sum(ss);
                    if (F.lane == 0) ssq[row] = (fx64)__builtin_rint((double)ss * (double)FX_SSQ);
#pragma unroll
                    for (int i = 0; i < 8; ++i) { const int c = (i * 64 + F.lane) * 4;
                        const f32x4 y = v[k][i] * gv[i] * (sc[i] + 1.0f);
                        *(unsigned*)(h8 + (size_t)row * DM + c) = cvt_fp8x4(y[0], y[1], y[2], y[3]); }
                } }
        }
    }
    {
        const int late = late_up_tiles(F.G) + late_in_tiles(F.G);
        const int NT = TR_C8 + (DEPTH - 1) * (TR_C8 - late);
        const TrMapPrologue map{F.bid, F.G, late};
        tr_run(F, (NT - F.bid + F.G - 1) / F.G, map);
        __syncthreads();
    }
}

__device__ __forceinline__ void phase_norm(const Frame& F, const float* x, const float* g, const float* modl  , int sh_off, int sc_off, bf16_t* h) {
    const int stride = F.G * 8;
    for (int row0 = F.bid * 8 + F.wave; row0 < MROWS; row0 += 4 * stride) {
        f32x4 v[4][8];
#pragma unroll
        for (int k = 0; k < 4; ++k) { const int row = row0 + k * stride;
            if (row < MROWS) {
#pragma unroll
                for (int i = 0; i < 8; ++i) v[k][i] = *(const f32x4*)(x + (size_t)row * DM + (i * 64 + F.lane) * 4); } }
#pragma unroll
        for (int k = 0; k < 4; ++k) { const int row = row0 + k * stride;
            if (row < MROWS) {
                const int b = row >> 11;
                float ss = 0.f;
#pragma unroll
                for (int i = 0; i < 8; ++i) ss += v[k][i][0] * v[k][i][0] + v[k][i][1] * v[k][i][1] + v[k][i][2] * v[k][i][2] + v[k][i][3] * v[k][i][3];
                ss = wave_sum(ss);
                const float rs = fast_rsq(ss * (1.0f / DM) + EPS);
                const float* mp = modl + (size_t)b * NADA;
#pragma unroll
                for (int i = 0; i < 8; ++i) { const int c = (i * 64 + F.lane) * 4;
                    const f32x4 gv = *(const f32x4*)(g + c), sc = *(const f32x4*)(mp + sc_off + c), sh = *(const f32x4*)(mp + sh_off + c);
                    const f32x4 y = (v[k][i] * rs) * gv * (sc + 1.0f) + sh;
                    u32x2 w; w.x = cvt_pk_bf16(y[0], y[1]); w.y = cvt_pk_bf16(y[2], y[3]);
                    *(u32x2*)(h + (size_t)row * DM + c) = w; }
            } }
    }
}

__device__ __forceinline__ void vt_load(const Frame& F, const bf16_t* src  , int lds_, u32x4& a0, u32x4& a1) {
    const int sl = F.tid >> 3, dq = F.tid & 7;
    a0 = *(const u32x4*)(src + (size_t)sl * lds_ + dq * 16); a1 = *(const u32x4*)(src + (size_t)sl * lds_ + dq * 16 + 8);
}
__device__ __forceinline__ void vt_finish(const Frame& F, const u32x4 a0, const u32x4 a1, bf16_t* dst  ) {
    LAS bf16_t* T = (LAS bf16_t*)F.lds;
    const int sl = F.tid >> 3, dq = F.tid & 7;
    __syncthreads();
    *(LAS u32x4*)(T + sl * 136 + dq * 16) = a0; *(LAS u32x4*)(T + sl * 136 + dq * 16 + 8) = a1;
    __syncthreads();
    const int d = F.tid >> 2, sq = F.tid & 3;
    unsigned w[8];
#pragma unroll
    for (int i = 0; i < 8; ++i) { const int p = 2 * i, sa = (p & 3) | ((p & 4) << 1) | ((p & 8) >> 1);
        const unsigned lo = T[(sq * 16 + sa) * 136 + d], hi = T[(sq * 16 + sa + 1) * 136 + d]; w[i] = lo | (hi << 16); }
    bf16_t* dp = dst + (size_t)d * SEQ + sq * 16;
    *(u32x4*)dp = (u32x4){w[0], w[1], w[2], w[3]}; *(u32x4*)(dp + 8) = (u32x4){w[4], w[5], w[6], w[7]};
}
__device__ __forceinline__ void vt_tile(const Frame& F, const bf16_t* src, int lds_, bf16_t* dst) { u32x4 a0, a1; vt_load(F, src, lds_, a0, a1); vt_finish(F, a0, a1, dst); }

__device__ __forceinline__ void phase_post1(const Frame& F, int l) {
    ArgsCP ap = F.a; unsigned char* ws = F.ws;
    const bf16_t* proj = (const bf16_t*)(ws + WS_PROJ);
    bf16_t* QA = (bf16_t*)(ws + WS_QA); bf16_t* KA = (bf16_t*)(ws + WS_KA); bf16_t* QI = (bf16_t*)(ws + WS_QI); bf16_t* KI = (bf16_t*)(ws + WS_KI);
    float* WI = (float*)(ws + WS_WI);
    const float* CA = (const float*)(ws + WS_ROPE); const float* SA = CA + MROWS * 16; const float* CI = SA + MROWS * 16; const float* SI = CI + MROWS * 8;
    const float* g_qa = (const float*)ap->in[8] + l * 128; const float* g_ka = (const float*)ap->in[9] + l * 128;
    const int L = F.lane;
    const float qscale = 0.08838834764831845f * LOG2E;
    const float gq0 = g_qa[2 * L], gq1 = g_qa[2 * L + 1], gk0 = g_ka[2 * L], gk1 = g_ka[2 * L + 1];
    const int Lh = L & 31;
#define P1_LOAD(R, r_) do { const int rr_ = (r_); const bf16_t* p = proj + (size_t)rr_ * NPROJ; \
        _Pragma("unroll") for (int hh = 0; hh < 10; ++hh) R.wqk[hh] = *(const unsigned*)(p + hh * 128 + 2 * L); \
        _Pragma("unroll") for (int ch = 0; ch < 9; ++ch) { R.wqi[ch] = 0u; if (ch < 8 || L < 32) R.wqi[ch] = *(const unsigned*)(p + PC_QI + ch * 128 + 2 * L); }       \
        R.c0 = 0.f; R.c1 = 0.f; R.s0 = 0.f; R.s1 = 0.f; \
        if (L < 16) { const int dd = 2 * (L & 7); R.c0 = CA[rr_ * 16 + dd]; R.c1 = CA[rr_ * 16 + dd + 1]; R.s0 = SA[rr_ * 16 + dd]; R.s1 = SA[rr_ * 16 + dd + 1]; } \
        R.ci0 = 0.f; R.ci1 = 0.f; R.si0 = 0.f; R.si1 = 0.f; \
        if (Lh < 8) { const int dd = 2 * (Lh & 3); R.ci0 = CI[rr_ * 8 + dd]; R.ci1 = CI[rr_ * 8 + dd + 1]; R.si0 = SI[rr_ * 8 + dd]; R.si1 = SI[rr_ * 8 + dd + 1]; } \
        R.wi = 0; if (L < 16) R.wi = p[PC_WI + L]; } while (0)
#define P1_ROW(R, r_) do { const int r = (r_); \
          \
        { const float c0 = R.c0, c1 = R.c1, s0 = R.s0, s1 = R.s1; \
        _Pragma("unroll") for (int hh = 0; hh < 10; ++hh) { \
            const unsigned w = R.wqk[hh]; \
            const float a0 = bf_lo(w), a1 = bf_hi(w); \
            const float ss = wave_sum(a0 * a0 + a1 * a1); \
            const float rs = fast_rsq(ss * (1.0f / 128.0f) + EPS); \
            float y0 = a0 * rs * (hh < 8 ? gq0 : gk0), y1 = a1 * rs * (hh < 8 ? gq1 : gk1); \
            const float o0 = swz_xor<8>(y0), o1 = swz_xor<8>(y1); \
            if (L < 8) { y0 = y0 * c0 - o0 * s0; y1 = y1 * c1 - o1 * s1; } \
            else if (L < 16) { y0 = y0 * c0 + o0 * s0; y1 = y1 * c1 + o1 * s1; } \
            if (hh < 8) *(unsigned*)(QA + (size_t)r * 1024 + hh * 128 + 2 * L) = cvt_pk_bf16(y0 * qscale, y1 * qscale); \
            else *(unsigned*)(KA + (size_t)r * 256 + (hh - 8) * 128 + 2 * L) = cvt_pk_bf16(y0, y1); \
        } } \
          \
        { const float ci0 = R.ci0, ci1 = R.ci1, si0 = R.si0, si1 = R.si1; \
        _Pragma("unroll") for (int ch = 0; ch < 9; ++ch) { \
            const unsigned w = R.wqi[ch]; \
            float y0 = bf_lo(w), y1 = bf_hi(w); \
            const float o0 = swz_xor<4>(y0), o1 = swz_xor<4>(y1); \
            if (Lh < 4) { y0 = y0 * ci0 - o0 * si0; y1 = y1 * ci1 - o1 * si1; } \
            else if (Lh < 8) { y0 = y0 * ci0 + o0 * si0; y1 = y1 * ci1 + o1 * si1; } \
              \
              \
            const int fo = (Lh >> 4) * 512 + (((Lh >> 2) & 3) * 16 + (r & 15)) * 8 + 2 * (Lh & 3); \
            if (ch < 8) *(unsigned*)(QI + (size_t)(r & ~15) * 1024 + (ch * 2 + (L >> 5)) * 1024 + fo) = cvt_pk_bf16(y0, y1); \
            else if (L < 32) *(unsigned*)(KI + (size_t)(r & ~15) * 64 + fo) = cvt_pk_bf16(y0, y1); \
        } } \
          \
        if (L < 16) WI[(size_t)r * 16 + L] = bf1(R.wi) * 0.03125f; \
        } while (0)
    {
        struct P1Row { unsigned wqk[10], wqi[9]; float c0, c1, s0, s1, ci0, ci1, si0, si1; bf16_t wi; };
        const int step = F.G * 8; int r0 = F.bid * 8 + F.wave;
        if (r0 < MROWS) {
            P1Row A, B;
            P1_LOAD(A, r0);
#pragma unroll 1
            for (;;) {
                const int rb = r0 + step; const bool hb = rb < MROWS;
                __builtin_amdgcn_sched_barrier(0);
                P1_LOAD(B, hb ? rb : r0);
                __builtin_amdgcn_sched_barrier(0);
                P1_ROW(A, r0);
                if (!hb) break;
                const int ra = rb + step; const bool ha = ra < MROWS;
                __builtin_amdgcn_sched_barrier(0);
                P1_LOAD(A, ha ? ra : rb);
                __builtin_amdgcn_sched_barrier(0);
                P1_ROW(B, rb);
                if (!ha) break;
                r0 = ra;
            }
        }
    }
#undef P1_LOAD
#undef P1_ROW
    bf16_t* VAT = (bf16_t*)(ws + WS_VAT);
    for (int it = F.bid; it < NBATCH * 2 * (SEQ / 64); it += F.G) {
        const int sb = it % (SEQ / 64), g = (it / (SEQ / 64)) & 1, b = it / (2 * (SEQ / 64));
        vt_tile(F, proj + (size_t)(b * SEQ + sb * 64) * NPROJ + PC_VA + g * 128, NPROJ, VAT + (size_t)(b * 2 + g) * 128 * SEQ + sb * 64);
    }
    __syncthreads();
}

__device__ __forceinline__ void phase_post2(const Frame& F, int l) {
    ArgsCP ap = F.a; unsigned char* ws = F.ws;
    const bf16_t* proj = (const bf16_t*)(ws + WS_PROJ); const bf16_t* MQ = (const bf16_t*)(ws + WS_MQ); const bf16_t* MKV = (const bf16_t*)(ws + WS_MKV);
    bf16_t* QM = (bf16_t*)(ws + WS_QM); bf16_t* KM = (bf16_t*)(ws + WS_KM);
    const float* CM = (const float*)(ws + WS_ROPE) + MROWS * 48; const float* SM = CM + MROWS * 32;
    const float* g_qm = (const float*)ap->in[14] + l * 192; const float* g_km = (const float*)ap->in[15] + l * 192;
    const int L = F.lane;
    const float qscale = 0.07216878364870322f * LOG2E;
    const int Lr = L & 31, Lc = L & 15;
    const float gqn0 = g_qm[2 * L], gqn1 = g_qm[2 * L + 1], gqr0 = g_qm[128 + 2 * Lr], gqr1 = g_qm[128 + 2 * Lr + 1];
    const float gkn0 = g_km[2 * L], gkn1 = g_km[2 * L + 1], gkr0 = g_km[128 + 2 * Lr], gkr1 = g_km[128 + 2 * Lr + 1];
#define P2_LOAD(R, r_) do { const int rr_ = (r_); \
        R.c0 = CM[rr_ * 32 + 2 * Lc]; R.c1 = CM[rr_ * 32 + 2 * Lc + 1]; R.s0 = SM[rr_ * 32 + 2 * Lc]; R.s1 = SM[rr_ * 32 + 2 * Lc + 1]; \
        R.kr = *(const unsigned*)(proj + (size_t)rr_ * NPROJ + PC_MKR + 2 * Lr); \
        _Pragma("unroll") for (int h = 0; h < 8; ++h) { const bf16_t* qp = MQ + (size_t)rr_ * 1536 + h * 192; const bf16_t* kp = MKV + (size_t)rr_ * 2048 + h * 256; \
            R.qn[h] = *(const unsigned*)(qp + 2 * L); R.qr[h] = *(const unsigned*)(qp + 128 + 2 * Lr); R.kn[h] = *(const unsigned*)(kp + 2 * L); } } while (0)
#define P2_HEAD(wn_, wr_, gn0_, gn1_, gr0_, gr1_, sc_, dst_) do { \
        const float a0 = bf_lo(wn_), a1 = bf_hi(wn_); const float b0 = (L < 32) ? bf_lo(wr_) : 0.f, b1 = (L < 32) ? bf_hi(wr_) : 0.f; \
        const float ss = wave_sum(a0 * a0 + a1 * a1 + b0 * b0 + b1 * b1); \
        const float rs = fast_rsq(ss * (1.0f / 192.0f) + EPS); \
        const float y0 = a0 * rs * gn0_, y1 = a1 * rs * gn1_; float z0 = b0 * rs * gr0_, z1 = b1 * rs * gr1_; \
        const float o0 = swz_xor<16>(z0), o1 = swz_xor<16>(z1); \
        if (L < 16) { z0 = z0 * c0 - o0 * s0; z1 = z1 * c1 - o1 * s1; } else { z0 = z0 * c0 + o0 * s0; z1 = z1 * c1 + o1 * s1; } \
        bf16_t* dp = (dst_); \
        *(unsigned*)(dp + 2 * L) = cvt_pk_bf16(y0 * (sc_), y1 * (sc_)); \
        if (L < 32) *(unsigned*)(dp + 128 + 2 * L) = cvt_pk_bf16(z0 * (sc_), z1 * (sc_)); } while (0)
#define P2_ROW(R, r_) do { const int r = (r_); const float c0 = R.c0, c1 = R.c1, s0 = R.s0, s1 = R.s1; \
        _Pragma("unroll") for (int h = 0; h < 8; ++h) { \
            P2_HEAD(R.qn[h], R.qr[h], gqn0, gqn1, gqr0, gqr1, qscale, QM + (size_t)r * 1536 + h * 192);            \
            P2_HEAD(R.kn[h], R.kr, gkn0, gkn1, gkr0, gkr1, 1.0f, KM + (size_t)r * 1536 + h * 192);                  \
        } } while (0)
    {
        struct P2Row { unsigned qn[8], qr[8], kn[8]; unsigned kr; float c0, c1, s0, s1; };
        const int step = F.G * 8; int r0 = F.bid * 8 + F.wave;
        if (r0 < MROWS) {
            P2Row A, B;
            P2_LOAD(A, r0);
#pragma unroll 1
            for (;;) {
                const int rb = r0 + step; const bool hb = rb < MROWS;
                __builtin_amdgcn_sched_barrier(0);
                P2_LOAD(B, hb ? rb : r0);
                __builtin_amdgcn_sched_barrier(0);
                P2_ROW(A, r0);
                if (!hb) break;
                const int ra = rb + step; const bool ha = ra < MROWS;
                __builtin_amdgcn_sched_barrier(0);
                P2_LOAD(A, ha ? ra : rb);
                __builtin_amdgcn_sched_barrier(0);
                P2_ROW(B, rb);
                if (!ha) break;
                r0 = ra;
            }
        }
    }
#undef P2_LOAD
#undef P2_HEAD
#undef P2_ROW
    bf16_t* VMT = (bf16_t*)(ws + WS_VMT);
    {
        constexpr int NVT = NBATCH * 8 * (SEQ / 64);
#define VMT_SRC(it_) (MKV + (size_t)(((it_) / (8 * (SEQ / 64))) * SEQ + ((it_) % (SEQ / 64)) * 64) * 2048 + (((it_) / (SEQ / 64)) & 7) * 256 + 128)
        int it = F.bid;
        if (it < NVT) {
            u32x4 a0, a1; vt_load(F, VMT_SRC(it), 2048, a0, a1);
#pragma unroll 1
            for (; it < NVT; it += F.G) {
                const int nx = (it + F.G < NVT) ? it + F.G : it;
                u32x4 n0, n1; vt_load(F, VMT_SRC(nx), 2048, n0, n1);
                const int sb = it % (SEQ / 64), h = (it / (SEQ / 64)) & 7, b = it / (8 * (SEQ / 64));
                vt_finish(F, a0, a1, VMT + (size_t)(b * 8 + h) * 128 * SEQ + sb * 64);
                a0 = n0; a1 = n1;
            }
        }
#undef VMT_SRC
    }
    __syncthreads();
}

__device__ __forceinline__ float fma_scalar(float a, float b, float c) { float d; asm("v_fma_f32 %0, %1, %2, %3" : "=v"(d) : "v"(a), "v"(b), "v"(c)); return d; }
constexpr int SC_STRIDE = 2052, RD = 4;
template <int NJ>
__device__ __forceinline__ void idx_select(const Frame& F, LAS float* SC, const int t0, const size_t row0, unsigned* MASK) {
    const int L = F.lane;
    {
        const int qrA = F.wave * 2, qrB = qrA + 1, tA = t0 + qrA, tB = t0 + qrB;
        unsigned keyA[NJ], keyB[NJ];
#pragma unroll
        for (int j = 0; j < NJ; ++j) { const int s = j * 64 + L;
            unsigned ua = __float_as_uint(SC[qrA * SC_STRIDE + s]), ub = __float_as_uint(SC[qrB * SC_STRIDE + s]);
            ua = (ua & 0x80000000u) ? ~ua : (ua | 0x80000000u); ub = (ub & 0x80000000u) ? ~ub : (ub | 0x80000000u);
            keyA[j] = (s <= tA) ? ua : 0u; keyB[j] = (s <= tB) ? ub : 0u; }
#define IDX_WAVE_TOTAL(c) (c += __builtin_amdgcn_update_dpp(0, c, 0x128, 0xf, 0xf, true), c += __builtin_amdgcn_update_dpp(0, c, 0x124, 0xf, 0xf, true), c += __builtin_amdgcn_update_dpp(0, c, 0x122, 0xf, 0xf, true), \
        c += __builtin_amdgcn_update_dpp(0, c, 0x121, 0xf, 0xf, true), __builtin_amdgcn_readlane(c, 0) + __builtin_amdgcn_readlane(c, 16) + __builtin_amdgcn_readlane(c, 32) + __builtin_amdgcn_readlane(c, 48))
        unsigned TA = 1u, TB = 1u; bool actA = (tA >= 256), actB = (tB >= 256);
        if (actA) TA = 0u;
        if (actB) TB = 0u;
#pragma unroll 1
        for (int bit = 31; bit >= 0 && (actA || actB); --bit) {
            const unsigned cA = __builtin_amdgcn_readfirstlane(TA | (1u << bit)), cB = __builtin_amdgcn_readfirstlane(TB | (1u << bit));
            int nA = 0, nB = 0;
#pragma unroll
            for (int j = 0; j < NJ; ++j) { nA += (keyA[j] >= cA) ? 1 : 0; nB += (keyB[j] >= cB) ? 1 : 0; }
            const int totA = IDX_WAVE_TOTAL(nA), totB = IDX_WAVE_TOTAL(nB);
            if (actA) { if (totA >= 256) TA = cA; if (totA == 256) actA = false; }
            if (actB) { if (totB >= 256) TB = cB; if (totB == 256) actB = false; }
        }
#pragma unroll 1
        for (int qq = 0; qq < 2; ++qq) {
            const unsigned T = qq ? TB : TA; const int t = qq ? tB : tA, qr = qq ? qrB : qrA;
            int need = 1 << 30;
            if (t >= 256) { int gt = 0;
#pragma unroll
                for (int j = 0; j < NJ; ++j) gt += __builtin_popcountll(__ballot((qq ? keyB[j] : keyA[j]) > T));
                need = 256 - gt; }
            int run = 0; unsigned long long mymask = 0ull;
#pragma unroll
            for (int j = 0; j < NJ; ++j) {
                const unsigned kj = qq ? keyB[j] : keyA[j];
                const unsigned long long eq = __ballot(kj == T);
                const int rank = run + (int)__builtin_amdgcn_mbcnt_hi((unsigned)(eq >> 32), __builtin_amdgcn_mbcnt_lo((unsigned)eq, 0u));
                const bool sel = (kj > T) || (kj == T && rank < need);
                run += __builtin_popcountll(eq);
                const unsigned long long m = __ballot(sel);
                if (L == j) mymask = m;
            }
            if (L < 32) *(unsigned long long*)(MASK + (row0 + qr) * 64 + 2 * L) = mymask;
        }
#undef IDX_WAVE_TOTAL
    }
}
__device__ __forceinline__ void idx_unit(const Frame& F, int b, int tb) {
    unsigned char* ws = F.ws;
    const bf16_t* QI = (const bf16_t*)(ws + WS_QI); const bf16_t* KI = (const bf16_t*)(ws + WS_KI); const float* WI = (const float*)(ws + WS_WI);
    unsigned* MASK = (unsigned*)(ws + WS_MASK);
    LAS float* SC = (LAS float*)F.lds;
    const int L = F.lane, q = L & 15, hq = L >> 4;
    const int t0 = tb * 16; const size_t row0 = (size_t)b * SEQ + t0;
    __syncthreads();
    const int nkt = tb + 1;
    const bf16_t* kbase = KI + (size_t)b * SEQ * 64 + L * 8;
    const int nmy = (nkt - F.wave + 7) >> 3;
#ifndef IDX_REP_SCORE
#define IDX_REP_SCORE 1
#endif
#ifndef IDX_REP_SEL
#define IDX_REP_SEL 1
#endif
#pragma unroll 1
    for (int hp = 0; hp < IDX_REP_SCORE; ++hp) {
        bf16x8 qf[16][2]; float wv[16];
#pragma unroll
        for (int hh = 0; hh < 16; ++hh) {
#pragma unroll
            for (int ks = 0; ks < 2; ++ks) qf[hh][ks] = *(const bf16x8*)(QI + row0 * 1024 + hh * 1024 + ks * 512 + L * 8); }
        {
#pragma unroll
          for (int k4 = 0; k4 < 4; ++k4) { const f32x4 w0 = *(const f32x4*)(WI + (row0 + q) * 16 + 4 * k4); wv[4 * k4 + 0] = w0[0]; wv[4 * k4 + 1] = w0[1]; wv[4 * k4 + 2] = w0[2]; wv[4 * k4 + 3] = w0[3]; } }
        __builtin_amdgcn_sched_barrier(0);
        if (nmy > 0) {
            const int lastk = nmy - 1;
            bf16x8 kr[RD][2];
#pragma unroll
            for (int s8 = 0; s8 < RD; ++s8) { const int ic = s8 < lastk ? s8 : lastk; const bf16_t* kp = kbase + (size_t)(F.wave + 8 * ic) * 16 * 64; kr[s8][0] = *(const bf16x8*)kp; kr[s8][1] = *(const bf16x8*)(kp + 512); }
#pragma unroll 1
            for (int base = 0; base < nmy; base += RD) {
#pragma unroll
                for (int s8 = 0; s8 < RD; ++s8) {
                    const int i = base + s8;
                    if (i < nmy) {
                        const int kt = F.wave + 8 * i;
                        LAS f32x4* sp = (LAS f32x4*)(SC + q * SC_STRIDE + kt * 16 + 4 * hq);
                        f32x4 sc = (f32x4){0.f, 0.f, 0.f, 0.f};
#pragma unroll
                        for (int hh = 0; hh < 16; ++hh) {
                            f32x4 d = __builtin_amdgcn_mfma_f32_16x16x32_bf16(kr[s8][0], qf[hh][0], (f32x4){0.f, 0.f, 0.f, 0.f}, 0, 0, 0);
                            d = __builtin_amdgcn_mfma_f32_16x16x32_bf16(kr[s8][1], qf[hh][1], d, 0, 0, 0);
#pragma unroll
                            for (int j = 0; j < 4; ++j) { const int di = __float_as_int(d[j]); sc[j] = fma_scalar(wv[hh], __int_as_float(di > 0 ? di : 0), sc[j]); }
                        }
                        *sp = sc;
                    }
                    __builtin_amdgcn_sched_barrier(0);
                    { const int ic = (i + RD) < lastk ? (i + RD) : lastk; const bf16_t* kp = kbase + (size_t)(F.wave + 8 * ic) * 16 * 64; kr[s8][0] = *(const bf16x8*)kp; kr[s8][1] = *(const bf16x8*)(kp + 512); }
                    __builtin_amdgcn_sched_barrier(0);
                }
            }
        }
    }
    __syncthreads();
    {
        const int njv = (t0 + 16 + 63) >> 6;
        if (njv <= 8) idx_select<8>(F, SC, t0, row0, MASK);
        else if (njv <= 16) idx_select<16>(F, SC, t0, row0, MASK);
        else if (njv <= 24) idx_select<24>(F, SC, t0, row0, MASK);
        else idx_select<32>(F, SC, t0, row0, MASK);
    }
}
__device__ __forceinline__ void phase_idx(const Frame& F) {
    for (int u = F.bid; u < 256; u += F.G) { const int b = u >> 6, i = u & 63; idx_unit(F, b, i); idx_unit(F, b, 127 - i); }
    __syncthreads();
}

#ifndef ATT_PROBE
#define ATT_PROBE 0
#endif
#ifndef ATT_PROBE_OFS
#define ATT_PROBE_OFS 0
#endif
#ifndef ATT_PROBE_BID
#define ATT_PROBE_BID 0
#endif
#ifndef ATT_PROBE_TID
#define ATT_PROBE_TID 0
#endif
template <int DQK, bool DSA>
__device__ __forceinline__ void attn_unit(const Frame& F, const bf16_t* Q, int ldq, const bf16_t* Kg, int ldk, const bf16_t* Vt, const unsigned* maskb, bf16_t* O, int ldo, int q0) {
    constexpr int NST = DQK / 16;
    constexpr int KA_BYTES = 64 * 256, KB_BYTES = (DQK == 192) ? 64 * 128 : 0, V_OFF = KA_BYTES + KB_BYTES, STAGE = V_OFF + 128 * 128;
    static_assert(3 * STAGE <= 131072, "three attention stages fit the phase scratch");
    int L = F.lane; asm volatile("" : "+v"(L));
    const int r = L & 31, hf = L >> 5, w = F.wave;
    const int qw0 = q0 + 32 * w, tq = qw0 + r;
    const int ntiles = (q0 + 256) / 64;
    const int lkA = r * 256 + ((((r & 15) ^ hf)) << 4), lkB = r * 128 + ((hf ^ ((r >> 1) & 7)) << 4);
#define ATT_KADDR(sbo, kh, st) (((st) < 8) ? (F.lds + (((sbo) + (kh) * 8192 + lkA) ^ ((st) << 5))) : (F.lds + (((sbo) + KA_BYTES + (kh) * 4096 + lkB) ^ ((2 * (st) - 16) << 4))))
#define ATT_VADDR(sbo, kh, s2, dt) (F.lds + ((((sbo) + V_OFF + lkB) ^ ((4 * (kh) + 2 * (s2)) << 4)) + (dt) * 4096))
    auto issue = [&](int kt, int buf) {
        int Li = L; asm volatile("" : "+v"(Li));
        LAS unsigned char* sb = F.lds + buf * STAGE;
        const char* kb = (const char*)Kg + (size_t)kt * 64 * ldk * 2; const char* vb = (const char*)Vt + (size_t)kt * 128;
#pragma unroll
        for (int i = 0; i < 2; ++i) { const int chunk = w + 8 * i, row = chunk * 4 + (Li >> 4), slot = Li & 15, piece = slot ^ (row & 15);
            __builtin_amdgcn_global_load_lds((const unsigned*)(kb + (unsigned)(row * ldk + piece * 8) * 2u), (LAS unsigned*)(sb + chunk * 1024), 16, 0, 0); }
        if (DQK == 192) { const int row = w * 8 + (Li >> 3), slot = Li & 7, piece = 16 + (slot ^ ((row >> 1) & 7));
            __builtin_amdgcn_global_load_lds((const unsigned*)(kb + (unsigned)(row * ldk + piece * 8) * 2u), (LAS unsigned*)(sb + KA_BYTES + w * 1024), 16, 0, 0); }
#pragma unroll
        for (int i = 0; i < 2; ++i) { const int chunk = w + 8 * i, row = chunk * 8 + (Li >> 3), slot = Li & 7, piece = slot ^ ((row >> 1) & 7);
            __builtin_amdgcn_global_load_lds((const unsigned*)(vb + (unsigned)(row * SEQ + piece * 8) * 2u), (LAS unsigned*)(sb + V_OFF + chunk * 1024), 16, 0, 0); }
    };
    bf16x8 qf[NST];
    f32x16 oacc[4];
    f32x16 sacc[2];
    float lsum = 0.f;
    f32x16 negm;
#pragma unroll
    for (int i = 0; i < 16; ++i) negm[i] = 0.f;
    constexpr int PFD = 2;
#define ATT_QK(sbo) do { \
        _Pragma("unroll") for (int kh = 0; kh < 2; ++kh) { \
            sacc[kh] = negm; \
            _Pragma("unroll") for (int st = 0; st < NST; ++st) \
                sacc[kh] = __builtin_amdgcn_mfma_f32_32x32x16_bf16(*(const LAS bf16x8*)ATT_KADDR(sbo, kh, st), qf[st], sacc[kh], 0, 0, 0); } \
        __builtin_amdgcn_sched_group_barrier(0x100, PFD, 0); \
        _Pragma("unroll") for (int x = 0; x < 2 * NST - PFD; ++x) { __builtin_amdgcn_sched_group_barrier(0x008, 1, 0); __builtin_amdgcn_sched_group_barrier(0x100, 1, 0); } \
        __builtin_amdgcn_sched_group_barrier(0x008, PFD, 0); } while (0)

    __syncthreads();
#if ATT_PROBE
    unsigned long long pr_t0 = __builtin_amdgcn_s_memtime(), pr_w = 0ull; unsigned pr_n = 0u;
#endif
    u32x2 mw = (u32x2){0u, 0u};
    if (DSA) mw = *(const u32x2*)(maskb + (size_t)tq * 64);
    issue(0, 0);
    if (ntiles > 1) issue(1, 1);
#pragma unroll
    for (int st = 0; st < NST; ++st) qf[st] = *(const bf16x8*)(Q + (size_t)tq * ldq + st * 16 + hf * 8);
#pragma unroll
    for (int dt = 0; dt < 4; ++dt)
#pragma unroll
        for (int i = 0; i < 16; ++i) oacc[dt][i] = 0.f;
    asm volatile("s_waitcnt vmcnt(0)" ::: "memory");
    __syncthreads();
    const bool late = (w >= 4);
    const int wlim = (qw0 + 31) >> 6;
    if (late) ATT_QK(0);
#pragma clang loop unroll(disable)
    for (int kt = 0; kt < ntiles; ++kt) {
#if ATT_PROBE
        const unsigned long long pr_a = __builtin_amdgcn_s_memtime();
#endif
        if (kt > 0) {
#if ATT_PROBE == 2
            __syncthreads();
#else
            asm volatile("s_waitcnt vmcnt(0)" ::: "memory");
#endif
#if ATT_PROBE
            const unsigned long long pr_b = __builtin_amdgcn_s_memtime(); pr_w += pr_b - pr_a;
#endif
#if ATT_PROBE == 2
            asm volatile("s_waitcnt vmcnt(0)" ::: "memory");
#else
            __syncthreads();
#endif
        }
        const u32x2 mcur = mw;
        if (DSA && kt + 1 < ntiles) mw = *(const u32x2*)(maskb + (size_t)tq * 64 + (kt + 1) * 2);
        if (kt + 2 < ntiles) issue(kt + 2, (kt + 2) % 3);
        const int sbc = (kt % 3) * STAGE;
#if ATT_PROBE == 5
        __builtin_amdgcn_sched_barrier(0); const unsigned long long pr_q = __builtin_amdgcn_s_memtime(); __builtin_amdgcn_sched_barrier(0);
#endif
        if (!late && kt <= wlim) ATT_QK(sbc);
#if ATT_PROBE == 5
        if (!late && kt <= wlim) { __builtin_amdgcn_sched_barrier(0); asm volatile("" :: "v"(sacc[1][15])); pr_w += __builtin_amdgcn_s_memtime() - pr_q; pr_n += 1; __builtin_amdgcn_sched_barrier(0); }
#endif
        if (kt <= wlim) {
            if (!DSA && kt * 64 + 63 > qw0) { const int lim = tq - kt * 64 - 4 * hf;
#pragma unroll
                for (int i = 0; i < 16; ++i) { const int ko = (i & 3) + 8 * (i >> 2);
                    sacc[0][i] = (ko <= lim) ? sacc[0][i] : -INFINITY; sacc[1][i] = (ko + 32 <= lim) ? sacc[1][i] : -INFINITY; } }
#if ATT_PROBE == 3
            __builtin_amdgcn_sched_barrier(0); const unsigned long long pr_c = __builtin_amdgcn_s_memtime(); __builtin_amdgcn_sched_barrier(0);
#endif
            float mx = sacc[0][0];
#pragma unroll
            for (int i = 1; i < 16; ++i) mx = fmaxf(mx, sacc[0][i]);
#pragma unroll
            for (int i = 0; i < 16; ++i) mx = fmaxf(mx, sacc[1][i]);
            mx = pair32_max(mx);
            const bool grew = (kt == 0) || (mx > 8.0f);
            if (__builtin_amdgcn_ballot_w64(grew) != 0ull) {
                const float d = grew ? mx : 0.f;
                const float alpha = (kt == 0) ? 0.f : fast_exp2(-d);
#pragma unroll
                for (int i = 0; i < 16; ++i) { sacc[0][i] -= d; sacc[1][i] -= d; negm[i] -= d; }
                lsum *= alpha;
#pragma unroll
                for (int dt = 0; dt < 4; ++dt)
#pragma unroll
                    for (int i = 0; i < 16; ++i) oacc[dt][i] *= alpha;
            }
            float ps = 0.f;
            if (DSA) {
                const unsigned m0 = mcur.x >> (4 * hf), m1 = mcur.y >> (4 * hf);
#pragma unroll
                for (int i = 0; i < 16; ++i) { const int kb = (i & 3) + 8 * (i >> 2);
                    const float p0 = __int_as_float(__float_as_int(fast_exp2(sacc[0][i])) & __builtin_amdgcn_sbfe((int)m0, kb, 1)), p1 = __int_as_float(__float_as_int(fast_exp2(sacc[1][i])) & __builtin_amdgcn_sbfe((int)m1, kb, 1));
                    sacc[0][i] = p0; sacc[1][i] = p1; ps += p0 + p1; }
            } else {
#pragma unroll
                for (int kh = 0; kh < 2; ++kh)
#pragma unroll
                    for (int i = 0; i < 16; ++i) { const float pv = fast_exp2(sacc[kh][i]); sacc[kh][i] = pv; ps += pv; }
            }
            lsum += ps;
            bf16x8 pf[2][2];
#pragma unroll
            for (int kh = 0; kh < 2; ++kh)
#pragma unroll
                for (int s2 = 0; s2 < 2; ++s2) { u32x4 pw;
                    pw.x = cvt_pk_bf16(sacc[kh][8 * s2 + 0], sacc[kh][8 * s2 + 1]); pw.y = cvt_pk_bf16(sacc[kh][8 * s2 + 2], sacc[kh][8 * s2 + 3]);
                    pw.z = cvt_pk_bf16(sacc[kh][8 * s2 + 4], sacc[kh][8 * s2 + 5]); pw.w = cvt_pk_bf16(sacc[kh][8 * s2 + 6], sacc[kh][8 * s2 + 7]);
                    pf[kh][s2] = __builtin_bit_cast(bf16x8, pw); }
#if ATT_PROBE == 3
            __builtin_amdgcn_sched_barrier(0); asm volatile("" :: "v"(pf[1][1])); pr_w += __builtin_amdgcn_s_memtime() - pr_c; __builtin_amdgcn_sched_barrier(0);
#endif
#pragma unroll
            for (int dt = 0; dt < 4; ++dt)
#pragma unroll
                for (int kh = 0; kh < 2; ++kh)
#pragma unroll
                    for (int s2 = 0; s2 < 2; ++s2)
                        oacc[dt] = __builtin_amdgcn_mfma_f32_32x32x16_bf16(*(const LAS bf16x8*)ATT_VADDR(sbc, kh, s2, dt), pf[kh][s2], oacc[dt], 0, 0, 0);
            __builtin_amdgcn_sched_group_barrier(0x100, PFD, 1);
#pragma unroll
            for (int x = 0; x < 16 - PFD; ++x) { __builtin_amdgcn_sched_group_barrier(0x008, 1, 1); __builtin_amdgcn_sched_group_barrier(0x100, 1, 1); }
            __builtin_amdgcn_sched_group_barrier(0x008, PFD, 1);
        }
        if (late && kt + 1 <= wlim) ATT_QK(((kt + 1) % 3) * STAGE);
    }
#undef ATT_QK
#undef ATT_KADDR
#undef ATT_VADDR
#if ATT_PROBE
    if (F.tid == ATT_PROBE_TID) { volatile LAS unsigned* MS = (volatile LAS unsigned*)(F.lds + LDS_MISC); MS[4] += (unsigned)pr_w; MS[5] += (unsigned)(__builtin_amdgcn_s_memtime() - pr_t0); MS[6] += pr_n; }
#endif
    __builtin_amdgcn_s_setprio(0);
    const float ltot = pair32_sum(lsum);
    const float inv = fast_rcp(ltot);
    bf16_t* op = O + (size_t)tq * ldo + 4 * hf;
#pragma unroll
    for (int dt = 0; dt < 4; ++dt)
#pragma unroll
        for (int g4 = 0; g4 < 4; ++g4) { u32x2 ow; ow.x = cvt_pk_bf16(oacc[dt][4 * g4 + 0] * inv, oacc[dt][4 * g4 + 1] * inv); ow.y = cvt_pk_bf16(oacc[dt][4 * g4 + 2] * inv, oacc[dt][4 * g4 + 3] * inv);
            *(u32x2*)(op + dt * 32 + g4 * 8) = ow; }
}

#ifndef ATT_ENABLE_MLA
#define ATT_ENABLE_MLA 1
#endif
#ifndef ATT_ENABLE_DSA
#define ATT_ENABLE_DSA 1
#endif
__device__ __forceinline__ void phase_attn(const Frame& F) {
    unsigned char* ws = F.ws;
    const bf16_t* QA = (const bf16_t*)(ws + WS_QA); const bf16_t* KA = (const bf16_t*)(ws + WS_KA); const bf16_t* VAT = (const bf16_t*)(ws + WS_VAT);
    const bf16_t* QM = (const bf16_t*)(ws + WS_QM); const bf16_t* KM = (const bf16_t*)(ws + WS_KM); const bf16_t* VMT = (const bf16_t*)(ws + WS_VMT);
    const unsigned* MASK = (const unsigned*)(ws + WS_MASK); bf16_t* OAB = (bf16_t*)(ws + WS_OAB);
    for (int u0 = F.bid; u0 < 256; u0 += F.G) {
        const int u = (F.G == 256) ? ((u0 & 7) * 32 + (u0 >> 3)) : u0;
        const int b = u >> 6, h = (u >> 3) & 7, qb = u & 7;
        const size_t rb = (size_t)b * SEQ;
        if (ATT_ENABLE_DSA) attn_unit<128, true>(F, QA + rb * 1024 + h * 128, 1024, KA + rb * 256 + (h >> 2) * 128, 256, VAT + (size_t)(b * 2 + (h >> 2)) * 128 * SEQ, MASK + rb * 64, OAB + rb * DM + h * 128, DM, qb * 256);
        if (ATT_ENABLE_MLA) attn_unit<192, false>(F, QM + rb * 1536 + h * 192, 1536, KM + rb * 1536 + h * 192, 1536, VMT + (size_t)(b * 8 + h) * 128 * SEQ, nullptr, OAB + rb * DM + 1024 + h * 128, DM, (7 - qb) * 256);
    }
    __syncthreads();
}

__device__ __forceinline__ void phase_conv(const Frame& F, int l) {
    ArgsCP ap = F.a; unsigned char* ws = F.ws;
    const bf16_t* U = (const bf16_t*)(ws + WS_U); bf16_t* ACT = (bf16_t*)(ws + WS_ACT);
    const float* wconv = (const float*)ap->in[20] + (size_t)l * 3 * NUP; const float* bconv = (const float*)ap->in[21] + (size_t)l * NUP;
    const int cg = F.tid & 15, rs = F.tid >> 4;
    for (int it = F.bid; it < 32 * 44; it += F.G) {
        const int j = it % 44, pm = it / 44;
        const int ch = 128 * j + 8 * cg;
        const int row0 = pm * 256 + rs * 8;
        float wg[3][8], wvv[3][8], bg[8], bv[8];
#pragma unroll
        for (int k = 0; k < 3; ++k) { const f32x4 x0 = *(const f32x4*)(wconv + (size_t)k * NUP + ch), x1 = *(const f32x4*)(wconv + (size_t)k * NUP + ch + 4), y0 = *(const f32x4*)(wconv + (size_t)k * NUP + DFF + ch), y1 = *(const f32x4*)(wconv + (size_t)k * NUP + DFF + ch + 4);
#pragma unroll
            for (int e = 0; e < 4; ++e) { wg[k][e] = x0[e]; wg[k][4 + e] = x1[e]; wvv[k][e] = y0[e]; wvv[k][4 + e] = y1[e]; } }
        { const f32x4 x0 = *(const f32x4*)(bconv + ch), x1 = *(const f32x4*)(bconv + ch + 4), y0 = *(const f32x4*)(bconv + DFF + ch), y1 = *(const f32x4*)(bconv + DFF + ch + 4);
#pragma unroll
            for (int e = 0; e < 4; ++e) { bg[e] = x0[e]; bg[4 + e] = x1[e]; bv[e] = y0[e]; bv[4 + e] = y1[e]; } }
        const bf16_t* up = U + (size_t)row0 * NUP + 256 * j + 8 * cg;
        float g2[8], g1[8], v2[8], v1[8];
        const bool has_prev = (row0 & (SEQ - 1)) != 0;
#pragma unroll
        for (int e = 0; e < 8; ++e) { g2[e] = 0.f; g1[e] = 0.f; v2[e] = 0.f; v1[e] = 0.f; }
        if (has_prev) {
            const u32x4 a2 = *(const u32x4*)(up - 2 * (size_t)NUP), a1 = *(const u32x4*)(up - (size_t)NUP), c2 = *(const u32x4*)(up - 2 * (size_t)NUP + 128), c1 = *(const u32x4*)(up - (size_t)NUP + 128);
            g2[0] = bf_lo(a2.x); g2[1] = bf_hi(a2.x); g2[2] = bf_lo(a2.y); g2[3] = bf_hi(a2.y); g2[4] = bf_lo(a2.z); g2[5] = bf_hi(a2.z); g2[6] = bf_lo(a2.w); g2[7] = bf_hi(a2.w);
            g1[0] = bf_lo(a1.x); g1[1] = bf_hi(a1.x); g1[2] = bf_lo(a1.y); g1[3] = bf_hi(a1.y); g1[4] = bf_lo(a1.z); g1[5] = bf_hi(a1.z); g1[6] = bf_lo(a1.w); g1[7] = bf_hi(a1.w);
            v2[0] = bf_lo(c2.x); v2[1] = bf_hi(c2.x); v2[2] = bf_lo(c2.y); v2[3] = bf_hi(c2.y); v2[4] = bf_lo(c2.z); v2[5] = bf_hi(c2.z); v2[6] = bf_lo(c2.w); v2[7] = bf_hi(c2.w);
            v1[0] = bf_lo(c1.x); v1[1] = bf_hi(c1.x); v1[2] = bf_lo(c1.y); v1[3] = bf_hi(c1.y); v1[4] = bf_lo(c1.z); v1[5] = bf_hi(c1.z); v1[6] = bf_lo(c1.w); v1[7] = bf_hi(c1.w);
        }
        u32x4 gin[8], vin[8];
#pragma unroll
        for (int i = 0; i < 8; ++i) { gin[i] = *(const u32x4*)(up + (size_t)i * NUP); vin[i] = *(const u32x4*)(up + (size_t)i * NUP + 128); }
#pragma unroll
        for (int i = 0; i < 8; ++i) {
            float g0[8], v0[8], o[8];
            g0[0] = bf_lo(gin[i].x); g0[1] = bf_hi(gin[i].x); g0[2] = bf_lo(gin[i].y); g0[3] = bf_hi(gin[i].y); g0[4] = bf_lo(gin[i].z); g0[5] = bf_hi(gin[i].z); g0[6] = bf_lo(gin[i].w); g0[7] = bf_hi(gin[i].w);
            v0[0] = bf_lo(vin[i].x); v0[1] = bf_hi(vin[i].x); v0[2] = bf_lo(vin[i].y); v0[3] = bf_hi(vin[i].y); v0[4] = bf_lo(vin[i].z); v0[5] = bf_hi(vin[i].z); v0[6] = bf_lo(vin[i].w); v0[7] = bf_hi(vin[i].w);
#pragma unroll
            for (int e = 0; e < 8; ++e) {
                const float gc = bg[e] + wg[0][e] * g2[e] + wg[1][e] * g1[e] + wg[2][e] * g0[e];
                const float vc = bv[e] + wvv[0][e] * v2[e] + wvv[1][e] * v1[e] + wvv[2][e] * v0[e];
                o[e] = gc * sigmoidf_(gc) * vc;
                g2[e] = g1[e]; g1[e] = g0[e]; v2[e] = v1[e]; v1[e] = v0[e];
            }
            u32x4 ow; ow.x = cvt_pk_bf16(o[0], o[1]); ow.y = cvt_pk_bf16(o[2], o[3]); ow.z = cvt_pk_bf16(o[4], o[5]); ow.w = cvt_pk_bf16(o[6], o[7]);
            *(u32x4*)(ACT + (size_t)(row0 + i) * DFF + ch) = ow;
        }
    }
}

__device__ __forceinline__ void conv_fixup(const Frame& F, int l, int pm) {
    if ((pm & 7) == 0) return;
    ArgsCP ap = F.a; unsigned char* ws = F.ws;
    const float* wconv = (const float*)ap->in[20] + (size_t)l * 3 * NUP; const float* bconv = (const float*)ap->in[21] + (size_t)l * NUP;
    const float* UH = (const float*)(ws + WS_UHEAD) + (size_t)pm * 2 * NUP; const float* UT = (const float*)(ws + WS_UTAIL) + (size_t)(pm - 1) * 2 * NUP;
    bf16_t* ACT = (bf16_t*)(ws + WS_ACT);
    f32x4 t0[3][2], t1[3][2], h0[3][2], h1[3][2], w0[3][2], w1[3][2], w2[3][2], bb[3][2];
#pragma unroll
    for (int j = 0; j < 3; ++j) { const int cq = F.tid + 512 * j; const int c2 = (cq < DFF / 4) ? cq : 0;
        const int ch = c2 * 4, colp = (ch >> 7) * 256 + (ch & 127);
#pragma unroll
        for (int bj = 0; bj < 2; ++bj) { const int cp = colp + bj * 128, cw = ch + bj * DFF;
            t0[j][bj] = *(const f32x4*)(UT + cp); t1[j][bj] = *(const f32x4*)(UT + (size_t)NUP + cp); h0[j][bj] = *(const f32x4*)(UH + cp); h1[j][bj] = *(const f32x4*)(UH + (size_t)NUP + cp);
            w0[j][bj] = *(const f32x4*)(wconv + cw); w1[j][bj] = *(const f32x4*)(wconv + (size_t)NUP + cw); w2[j][bj] = *(const f32x4*)(wconv + (size_t)2 * NUP + cw); bb[j][bj] = *(const f32x4*)(bconv + cw); } }
#pragma unroll
    for (int j = 0; j < 3; ++j) { const int cq = F.tid + 512 * j;
        if (cq < DFF / 4) { const int ch = cq * 4;
#pragma unroll
            for (int rr = 0; rr < 2; ++rr) {
                f32x4 cv[2];
#pragma unroll
                for (int bj = 0; bj < 2; ++bj) cv[bj] = bb[j][bj] + w0[j][bj] * (rr ? t1[j][bj] : t0[j][bj]) + w1[j][bj] * (rr ? h0[j][bj] : t1[j][bj]) + w2[j][bj] * (rr ? h1[j][bj] : h0[j][bj]);
                f32x4 o;
#pragma unroll
                for (int e = 0; e < 4; ++e) { const float g = cv[0][e]; o[e] = g * sigmoidf_(g) * cv[1][e]; }
                u32x2 ow; ow.x = cvt_pk_bf16(o[0], o[1]); ow.y = cvt_pk_bf16(o[2], o[3]);
                *(u32x2*)(ACT + (size_t)(pm * 256 + rr) * DFF + ch) = ow; } } }
}

typedef ArgsCP ArgsP;
__device__ __forceinline__ Frame make_frame() {
    Frame F;
    int tid = threadIdx.x; asm volatile("" : "+v"(tid));
    int bid = blockIdx.x, G = gridDim.x; asm volatile("" : "+s"(bid), "+s"(G));
    ArgsP ap = (ArgsP)__builtin_amdgcn_kernarg_segment_ptr(); asm volatile("" : "+s"(ap));
    extern __shared__ __attribute__((aligned(16))) unsigned char lds_raw[];
    F.lds = (LAS unsigned char*)lds_raw;
    F.tid = tid; F.lane = tid & 63; F.wave = __builtin_amdgcn_readfirstlane(tid >> 6); F.G = G; F.bid = bid;
    F.a = ap; F.ws = ap->ws;
    return F;
}

__global__ void __launch_bounds__(512, 2) fwd_kernel(Args args) {
    extern __shared__ __attribute__((aligned(16))) unsigned char lds_raw[];
    volatile LAS unsigned* MISC = (volatile LAS unsigned*)((LAS unsigned char*)lds_raw + LDS_MISC);
    if (threadIdx.x < 16) MISC[threadIdx.x] = 0u;
    __syncthreads();
    const int lo = args.ph_lo, hi = args.ph_hi;
    XcdBarrier bar; bar.bar = (unsigned*)(args.ws + WS_CTL) + 4096; bar.x = 0; bar.st = MISC;
    if (hi - lo > 1) bar = xcd_barrier_post((unsigned*)(args.ws + WS_CTL) + 4096, MISC);
#ifndef ONLY_PHASE
#define ONLY_PHASE -1
#endif
#define PH_EN(p) (ONLY_PHASE < 0 || ONLY_PHASE == (p))
#ifndef REP_MASK
#define REP_MASK 0
#endif
#define REPEAT(bit) _Pragma("unroll 1") for (int _rep = 0; _rep < (((REP_MASK >> (bit)) & 1) ? 2 : 1); ++_rep)
#define IN(k) (lo <= (k) && (k) < hi)
#ifndef BAR_REP
#define BAR_REP 1
#endif
#define SEAM(k) do { if (IN(k) && IN((k) + 1)) { _Pragma("unroll 1") for (int _br = 0; _br < BAR_REP; ++_br) { XcdBarrier b2 = bar; asm volatile("" : "+s"(b2.bar), "+s"(b2.x)); xcd_barrier(b2); } } } while (0)

    if (PH_EN(100) && IN(0)) { const Frame F = make_frame(); p0a_prologue(F); }
    SEAM(0);
    if (PH_EN(101) && IN(1)) REPEAT(0) { const Frame F = make_frame(); p0b_prologue(F); }
    SEAM(1);

#pragma unroll 1
    for (int l = 0; l < DEPTH; ++l) {
        const int pb = 2 + l * NPH_LAYER;
        if (PH_EN(0) && IN(pb + 0)) REPEAT(1) { const Frame F = make_frame(); unsigned char* ws = F.ws;
            pg8::Gemm g{(const bf16_t*)(ws + WS_H8), (const bf16_t*)(ws + WS_WIN + (size_t)l * NPROJ * DM), DM / 2, DM / 2, DM / 2, 0, 0};
            pg8::StaticOrder S; S.init(MROWS, NPROJ, F.G, F.bid);
            pg8::EpiProjNorm E{(bf16_t*)(ws + WS_PROJ), NPROJ, (const fx64*)(ws + WS_SSQ) + (size_t)(l * 2 + 0) * MROWS, (const fx64*)(ws + WS_BIAS) + (size_t)l * NBATCH * NPROJ, NPROJ, (LAS float*)(F.lds + LDS_TAB), (fx64*)(ws + WS_SSQ_LAT) + (size_t)l * 2 * MROWS};
            pg8::gemm_phase(F.lds, F.tid, g, S, E);
        }
        if (PH_EN(0) && IN(pb + 0) && l + 1 < DEPTH) { const Frame F = make_frame(); tr_late(F, l + 1, (MROWS / 256) * (NPROJ / 256), late_up_tiles(F.G), late_in_tiles(F.G), LATE_IN); }
        SEAM(pb + 0);
        if (PH_EN(1) && IN(pb + 1)) {
#pragma unroll 1
            for (int s1 = 0; s1 < 2; ++s1) {
                const Frame F0 = make_frame();
                if ((((F0.bid >> 3) ^ s1) & 1) == 0) {
                    { const Frame F = make_frame(); unsigned char* ws = F.ws; const fx64* sl = (const fx64*)(ws + WS_SSQ_LAT) + (size_t)l * 2 * MROWS;
                      pg8::Gemm g{(const bf16_t*)(ws + WS_PROJ) + PC_MQL, (const bf16_t*)(ws + WS_WMQ) + (size_t)l * 1536 * 512, NPROJ, 512, 512, 0, 0};
                      pg8::StaticOrder S; S.init(MROWS, 1536, F.G, F.bid); pg8::EpiStoreBf16 E{(bf16_t*)(ws + WS_MQ), 1536, sl, 1.0f / 512.0f}; pg8::gemm_phase(F.lds, F.tid, g, S, E); }
                    { const Frame F = make_frame(); unsigned char* ws = F.ws; const fx64* sl = (const fx64*)(ws + WS_SSQ_LAT) + (size_t)l * 2 * MROWS + MROWS;
                      pg8::Gemm g{(const bf16_t*)(ws + WS_PROJ) + PC_MKVL, (const bf16_t*)(ws + WS_WMKV) + (size_t)l * 2048 * 256, NPROJ, 256, 256, 0, 0};
                      pg8::StaticOrder S; S.init(MROWS, 2048, F.G, F.bid); pg8::EpiStoreBf16 E{(bf16_t*)(ws + WS_MKV), 2048, sl, 1.0f / 256.0f}; pg8::gemm_phase(F.lds, F.tid, g, S, E); }
                } else { const Frame F = make_frame(); phase_post1(F, l); }
            }
        }
        SEAM(pb + 1);
        if (PH_EN(2) && IN(pb + 2)) {
#pragma unroll 1
            for (int s2 = 0; s2 < 2; ++s2) { const Frame F = make_frame();
                if ((((F.bid >> 3) ^ s2) & 1) == 0) phase_post2(F, l); else phase_idx(F); }
        }
        SEAM(pb + 2);
        if (PH_EN(3) && IN(pb + 3)) REPEAT(2) { const Frame F = make_frame(); phase_attn(F); }
        SEAM(pb + 3);
        if (PH_EN(4) && IN(pb + 4)) { const Frame F = make_frame(); unsigned char* ws = F.ws;
            pg8::Gemm g{(const bf16_t*)(ws + WS_OAB), (const bf16_t*)(ws + WS_WPAB) + (size_t)l * 4096 * 1024, DM, 1024, 1024, (size_t)1024 * 2, (size_t)2048 * 1024 * 2};
            pg8::PairOrder S; S.s.init(MROWS, DM, F.G, F.bid);
            pg8::EpiPab E{(const bf16_t*)(ws + WS_PROJ), (bf16_t*)(ws + WS_MERGED)};
            pg8::gemm_phase(F.lds, F.tid, g, S, E);
        }
        SEAM(pb + 4);
        if (PH_EN(5) && IN(pb + 5)) { const Frame F = make_frame(); unsigned char* ws = F.ws;
            const float* xin = (l == 0) ? (const float*)F.a->in[0] : (const float*)F.a->out;
            const float* modl = (const float*)(ws + WS_MOD) + (size_t)l * NBATCH * NADA;
            pg8::Gemm g{(const bf16_t*)(ws + WS_MERGED), (const bf16_t*)(ws + WS_WO) + (size_t)l * DM * DM, DM, DM, DM, 0, 0};
            pg8::StaticOrder S; S.init(MROWS, DM, F.G, F.bid);
            pg8::EpiResidNorm E{xin, F.a->out, modl + 2 * DM, (const float*)F.a->in[4] + l * DM, modl + 4 * DM, (bf16_t*)(ws + WS_H), (fx64*)(ws + WS_SSQ) + (size_t)(l * 2 + 1) * MROWS, 0};
            pg8::gemm_phase(F.lds, F.tid, g, S, E);
        }
        SEAM(pb + 5);
        if (PH_EN(6) && IN(pb + 6)) { const Frame F = make_frame(); unsigned char* ws = F.ws;
            pg8::Gemm g{(const bf16_t*)(ws + WS_H), (const bf16_t*)(ws + WS_WUP) + (size_t)l * NUP * DM, DM, DM, DM, 0, 0};
            pg8::StaticOrder S; S.init(MROWS, NUP, F.G, F.bid);
            pg8::EpiUpConv E{(const float*)F.a->in[20] + (size_t)l * 3 * NUP, (const float*)F.a->in[21] + (size_t)l * NUP, (bf16_t*)(ws + WS_ACT), (float*)(ws + WS_UHEAD), (float*)(ws + WS_UTAIL), (LAS float*)(F.lds + LDS_XB),
                               (const fx64*)(ws + WS_SSQ) + (size_t)(l * 2 + 1) * MROWS, (const fx64*)(ws + WS_BIAS_UP) + (size_t)l * NBATCH * NUP, (LAS float*)(F.lds + LDS_TAB), (LAS float*)(F.lds + LDS_CTAB), (LAS float*)(F.lds + LDS_TAB2), (LAS float*)(F.lds + LDS_CTAB2)};
            pg8::gemm_phase(F.lds, F.tid, g, S, E);
            if (l + 1 < DEPTH) tr_late(F, l + 1, (MROWS / 256) * (NUP / 256), 0, late_up_tiles(F.G), LATE_UP);
        }
        SEAM(pb + 6);
        if (PH_EN(7) && IN(pb + 7)) { const Frame F = make_frame(); unsigned char* ws = F.ws;
            pg8::StaticOrder S; S.init(MROWS, DM, F.G, F.bid);
            { pg8::Unit uu; for (int i = 0; S.next(i, uu); ++i) conv_fixup(F, l, uu.pm); }
            asm volatile("s_waitcnt vmcnt(0)" ::: "memory"); __syncthreads();
            const float* modl = (const float*)(ws + WS_MOD) + (size_t)l * NBATCH * NADA;
            const bool more = (l + 1 < DEPTH);
            pg8::Gemm g{(const bf16_t*)(ws + WS_ACT), (const bf16_t*)(ws + WS_WDN) + (size_t)l * DM * DFF, DFF, DFF, DFF, 0, 0};
            pg8::EpiResidNorm E{F.a->out, F.a->out, modl + 5 * DM, (const float*)F.a->in[3] + (l + 1) * DM, modl + NBATCH * NADA + DM, more ? (bf16_t*)(ws + WS_H8) : (bf16_t*)nullptr, (fx64*)(ws + WS_SSQ) + (size_t)((l + 1) * 2 + 0) * MROWS, 1};
            pg8::gemm_phase(F.lds, F.tid, g, S, E);
        }
        SEAM(pb + 7);
    }
#if ATT_PROBE
    { XcdBarrier b2 = bar; xcd_barrier(b2);
      if (blockIdx.x == ATT_PROBE_BID && threadIdx.x == ATT_PROBE_TID) { volatile LAS unsigned* MS = (volatile LAS unsigned*)((LAS unsigned char*)lds_raw + LDS_MISC); args.out[0] = (ATT_PROBE == 4) ? 1000.0f * (float)((int)((float)MS[5] / (4.0f * 36.0f * 100.0f) + ATT_PROBE_OFS) / 5 * 5) : (ATT_PROBE == 5) ? 1000.0f * (float)((int)((float)MS[4] / (float)MS[6] / 10.0f + ATT_PROBE_OFS) / 5 * 5) : 1000.0f * (float)(((int)(100.0f * (float)MS[4] / (float)MS[5]) + ATT_PROBE_OFS) / 10 * 10); } }
#endif
#undef IN
#undef SEAM
}

extern "C" void kernel_launch(void* const* d_in, const int* in_sizes, int n_in, void* d_out, int out_size, void* d_ws, size_t ws_size, hipStream_t stream) {
    static int grid = 0;
    if (grid == 0) {
        if (n_in != 23 || out_size != MROWS * DM || ws_size < WS_END) { fprintf(stderr, "kernel_launch: unexpected problem (n_in %d, out %d, ws %zu < %zu)\n", n_in, out_size, ws_size, (size_t)WS_END); grid = -1; return; }
        int dev = 0, cus = 0, per_cu = 0;
        if (hipGetDevice(&dev) != hipSuccess || hipDeviceGetAttribute(&cus, hipDeviceAttributeMultiprocessorCount, dev) != hipSuccess) { grid = -1; return; }
        if (hipFuncSetAttribute((const void*)fwd_kernel, hipFuncAttributeMaxDynamicSharedMemorySize, LDS_BYTES) != hipSuccess) { fprintf(stderr, "kernel_launch: hipFuncSetAttribute failed\n"); grid = -1; return; }
        if (hipOccupancyMaxActiveBlocksPerMultiprocessor(&per_cu, (const void*)fwd_kernel, 512, LDS_BYTES) != hipSuccess || per_cu < 1) { fprintf(stderr, "kernel_launch: occupancy query says %d\n", per_cu); }
        (void)hipGetLastError();
        grid = cus;
    }
    if (grid < 0) return;
    (void)in_sizes;
    (void)hipMemsetAsync((char*)d_ws + WS_CTL, 0, CTL_ZERO_BYTES, stream);
    (void)hipMemsetAsync((char*)d_ws + WS_BIAS, 0, BIAS_ZERO_BYTES, stream);
    Args a{};
    for (int i = 0; i < 23; ++i) a.in[i] = d_in[i];
    a.out = (float*)d_out; a.ws = (unsigned char*)d_ws;
    for (int i = 0; i < 16; ++i) a.inv_a[i] = (float)pow(500000.0, -(double)(2 * i) / 32.0);
    for (int i = 0; i < 8; ++i) a.inv_i[i] = (float)pow(500000.0, -(double)(2 * i) / 16.0);
    for (int i = 0; i < 32; ++i) a.inv_m[i] = (float)pow(500000.0, -(double)(2 * i) / 64.0);
#if MK_ONE_LAUNCH
    a.ph_lo = 0; a.ph_hi = NPHASES;
    hipLaunchKernelGGL(fwd_kernel, dim3(grid), dim3(512), LDS_BYTES, stream, a);
#else
    for (int p = 0; p < NPHASES; ++p) { a.ph_lo = p; a.ph_hi = p + 1; hipLaunchKernelGGL(fwd_kernel, dim3(grid), dim3(512), LDS_BYTES, stream, a); }
#endif
}
```

```cpp
#include <hip/hip_runtime.h>
#include <cstdio>
#include <cstdint>
#include <cmath>

#define GAS __attribute__((address_space(1)))
#define LAS __attribute__((address_space(3)))
typedef unsigned short bf16_t;
typedef short bf16x8 __attribute__((ext_vector_type(8)));
typedef short bf16x4 __attribute__((ext_vector_type(4)));
typedef float f32x4 __attribute__((ext_vector_type(4)));
typedef float f32x16 __attribute__((ext_vector_type(16)));
typedef unsigned u32x4 __attribute__((ext_vector_type(4)));
typedef unsigned u32x2 __attribute__((ext_vector_type(2)));
typedef int i32x8 __attribute__((ext_vector_type(8)));
typedef int i32x4 __attribute__((ext_vector_type(4)));

constexpr int DM = 2048, NBATCH = 4, SEQ = 2048, DEPTH = 4, MROWS = NBATCH * SEQ;
constexpr int IN_DIM = 7568, NPROJ = 7680, DFF = 5632, NUP = 2 * DFF, NADA = 6 * DM;
constexpr int PC_QA = 0, PC_KA = 1024, PC_VA = 1280, PC_QI = 1536, PC_KI = 2560, PC_WI = 2624, PC_MKR = 2640, PC_MQL = 2816, PC_MKVL = 3328, PC_GA = 3584, PC_GB = 5632;
constexpr float EPS = 1e-6f;
constexpr float W8_SCALE = 32.0f, W8_INV = 1.0f / 32.0f;
constexpr float LOG2E = 1.4426950408889634f;
constexpr int NPH_LAYER = 8, NPHASES = 2 + DEPTH * NPH_LAYER;
#ifndef MK_ONE_LAUNCH
#define MK_ONE_LAUNCH 1
#endif

constexpr size_t MiB = 1u << 20;
constexpr size_t WS_CTL = 0, CTL_ZERO_BYTES = 1 * MiB;
constexpr size_t WS_SSQ = 256 * 1024;
constexpr size_t WS_MOD = 1 * MiB;
constexpr size_t WS_ROPE = 2 * MiB;
constexpr size_t WS_WIN = 8 * MiB;
constexpr size_t WS_WMQ = 128 * MiB;
constexpr size_t WS_WMKV = 134 * MiB;
constexpr size_t WS_WPAB = 138 * MiB;
constexpr size_t WS_WO = 170 * MiB;
constexpr size_t WS_WUP = 202 * MiB;
constexpr size_t WS_WDN = 378 * MiB;
constexpr size_t WS_H = 466 * MiB;
constexpr size_t WS_PROJ = 498 * MiB;
constexpr size_t WS_QA = 618 * MiB;
constexpr size_t WS_KA = 634 * MiB;
constexpr size_t WS_VAT = 638 * MiB;
constexpr size_t WS_QI = 642 * MiB;
constexpr size_t WS_KI = 658 * MiB;
constexpr size_t WS_WI = 659 * MiB;
constexpr size_t WS_MQL = 660 * MiB;
constexpr size_t WS_MKVL = 668 * MiB;
constexpr size_t WS_MQ = 672 * MiB;
constexpr size_t WS_MKV = 696 * MiB;
constexpr size_t WS_QM = 728 * MiB;
constexpr size_t WS_KM = 752 * MiB;
constexpr size_t WS_VMT = 776 * MiB;
constexpr size_t WS_MASK = 792 * MiB;
constexpr size_t WS_OAB = 794 * MiB;
constexpr size_t WS_MERGED = 826 * MiB;
constexpr size_t WS_U = 858 * MiB;
constexpr size_t WS_ACT = 1034 * MiB;
constexpr size_t WS_UHEAD = 1122 * MiB;
constexpr size_t WS_UTAIL = 1126 * MiB;
constexpr size_t WS_BIAS = 1130 * MiB, BIAS_ZERO_BYTES = 3584 * 1024;
constexpr size_t WS_BIAS_UP = WS_BIAS + (size_t)DEPTH * NBATCH * NPROJ * 8;
constexpr size_t WS_SSQ_LAT = 1133 * MiB;
constexpr size_t WS_H8 = 1134 * MiB;
constexpr size_t WS_END = 1150 * MiB;

constexpr int LDS_BYTES = 153600;
constexpr int LDS_TAB2 = 147456, LDS_CTAB2 = 149504;
constexpr int LDS_CTAB = 131072;
constexpr int LDS_MISC = 135168;
constexpr int LDS_TAB = 136192;
constexpr int LDS_XB = 139264;

__device__ __forceinline__ unsigned cvt_pk_bf16(float lo, float hi) { unsigned r; asm("v_cvt_pk_bf16_f32 %0, %1, %2" : "=v"(r) : "v"(lo), "v"(hi)); return r; }
__device__ __forceinline__ unsigned cvt_fp8x4(float a, float b, float c, float d) { int w = __builtin_amdgcn_cvt_pk_fp8_f32(a, b, 0, false); w = __builtin_amdgcn_cvt_pk_fp8_f32(c, d, w, true); return (unsigned)w; }
__device__ __forceinline__ float bf_lo(unsigned w) { return __uint_as_float(w << 16); }
__device__ __forceinline__ float bf_hi(unsigned w) { return __uint_as_float(w & 0xffff0000u); }
__device__ __forceinline__ float bf1(bf16_t v) { return __uint_as_float(((unsigned)v) << 16); }
template <int K> __device__ __forceinline__ float swz_xor(float v) { return __int_as_float(__builtin_amdgcn_ds_swizzle(__float_as_int(v), 0x1f | (K << 10))); }
__device__ __forceinline__ float pair32_sum(float v) { auto rr = __builtin_amdgcn_permlane32_swap(__float_as_uint(v), __float_as_uint(v), false, false); return __uint_as_float(rr[0]) + __uint_as_float(rr[1]); }
__device__ __forceinline__ float pair32_max(float v) { auto rr = __builtin_amdgcn_permlane32_swap(__float_as_uint(v), __float_as_uint(v), false, false); return fmaxf(__uint_as_float(rr[0]), __uint_as_float(rr[1])); }
__device__ __forceinline__ float pair32_other(float v, bool upper) { auto rr = __builtin_amdgcn_permlane32_swap(__float_as_uint(v), __float_as_uint(v), false, false); return __uint_as_float(upper ? rr[0] : rr[1]); }
template <int CTRL> __device__ __forceinline__ float dpp_mov_f(float v) { return __int_as_float(__builtin_amdgcn_update_dpp(0, __float_as_int(v), CTRL, 0xf, 0xf, true)); }
__device__ __forceinline__ float wave_sum(float v) {
    v += dpp_mov_f<0x128>(v); v += dpp_mov_f<0x124>(v); v += dpp_mov_f<0x122>(v); v += dpp_mov_f<0x121>(v);
    v += swz_xor<16>(v);
    return pair32_sum(v);
}
__device__ __forceinline__ float fast_rsq(float x) { return __builtin_amdgcn_rsqf(x); }
__device__ __forceinline__ float fast_rcp(float x) { return __builtin_amdgcn_rcpf(x); }
__device__ __forceinline__ float fast_exp2(float x) { return __builtin_amdgcn_exp2f(x); }
typedef long long fx64;
constexpr float FX_SSQ = 4294967296.f, FX_SSQ_INV = 1.0f / 4294967296.f;
constexpr double FX_BIAS = 1099511627776.0; constexpr float FX_BIAS_INV = (float)(1.0 / 1099511627776.0);
__device__ __forceinline__ void fx_add(fx64* p, double scaled) { (void)__hip_atomic_fetch_add((unsigned long long*)p, (unsigned long long)(long long)__builtin_rint(scaled), __ATOMIC_RELAXED, __HIP_MEMORY_SCOPE_AGENT); }
__device__ __forceinline__ float sigmoidf_(float x) { return fast_rcp(1.0f + fast_exp2(-x * LOG2E)); }

#define XB_TMO      128
#define XB_XCNT(j)  (256  + 64 * (j))
#define XB_XSUB(j)  (1280 + 64 * (j))
#define XB_XGEN(j)  (2304 + 64 * (j))
#define XB_TOP      3328
#define XB_TOPGEN   3392
#define XCD_BAR_WORDS 3456
#define XB_SPIN_CAP (1u << 20)

__device__ __forceinline__ unsigned xb_ld(unsigned* p)              { return __hip_atomic_load(p, __ATOMIC_RELAXED, __HIP_MEMORY_SCOPE_AGENT); }
__device__ __forceinline__ unsigned xb_add(unsigned* p, unsigned v) { return __hip_atomic_fetch_add(p, v, __ATOMIC_RELAXED, __HIP_MEMORY_SCOPE_AGENT); }
__device__ __forceinline__ unsigned xb_xcc_id() { return (unsigned)__builtin_amdgcn_s_getreg((3 << 11) | 20) & 0xFu; }
#define XB_SPIN(cond, bar) do { unsigned _sp = 0; while (cond) { __builtin_amdgcn_s_sleep(1); \
    if ((++_sp & 255u) == 0u) { if (xb_ld(&(bar)[XB_TMO])) break; if (_sp > XB_SPIN_CAP) { atomicAdd(&(bar)[XB_TMO], 1u); break; } } } } while (0)

struct XcdBarrier { unsigned* bar; unsigned x; volatile LAS unsigned* st; };

__device__ __forceinline__ XcdBarrier xcd_barrier_post(unsigned* bar, volatile LAS unsigned* st) {
    XcdBarrier b; b.bar = bar; b.x = xb_xcc_id(); b.st = st;
    if (threadIdx.x == 0) (void)xb_add(&bar[XB_XCNT(b.x)], 1u);
    return b;
}
__device__ __forceinline__ void xcd_barrier_complete(unsigned* bar, unsigned x, unsigned& nloc, unsigned& nx) {
    const unsigned G = gridDim.x * gridDim.y * gridDim.z;
    unsigned sum, cnt, mine, sp = 0u;
    for (;;) {
        sum = 0u; cnt = 0u; mine = 0u;
#pragma unroll
        for (unsigned j = 0; j < 16; ++j) { const unsigned c = xb_ld(&bar[XB_XCNT(j)]); sum += c; cnt += (c > 0u) ? 1u : 0u; mine = (j == x) ? c : mine; }
        if (sum == G) break;
        __builtin_amdgcn_s_sleep(1);
        if ((++sp & 255u) == 0u) { if (xb_ld(&bar[XB_TMO])) break; if (sp > XB_SPIN_CAP) { atomicAdd(&bar[XB_TMO], 1u); break; } }
    }
    nloc = mine > 0u ? mine : 1u; nx = cnt > 0u ? cnt : 1u;
}
__device__ __forceinline__ void xcd_barrier(const XcdBarrier& b) {
    asm volatile("s_waitcnt vmcnt(0)" ::: "memory");
    __syncthreads();
    if (threadIdx.x == 0) {
        unsigned* bar = b.bar;
        __builtin_amdgcn_s_waitcnt(0);
        unsigned nloc = b.st[0], nx = b.st[1];
        if (nloc == 0u) { xcd_barrier_complete(bar, b.x, nloc, nx); b.st[0] = nloc; b.st[1] = nx; }
        const unsigned old = xb_add(&bar[XB_XSUB(b.x)], 1u);
        const unsigned gen = old / nloc;
        if (old + 1u == (gen + 1u) * nloc) {
            __builtin_amdgcn_fence(__ATOMIC_RELEASE, "agent");
            asm volatile("s_waitcnt vmcnt(0)" ::: "memory");
            const unsigned og = xb_add(&bar[XB_TOP], 1u);
            const unsigned tg = og / nx;
            if (og + 1u == (tg + 1u) * nx) xb_add(&bar[XB_TOPGEN], 1u);
            else XB_SPIN(xb_ld(&bar[XB_TOPGEN]) == tg, bar);
            asm volatile("buffer_inv sc1" ::: "memory");
            xb_add(&bar[XB_XGEN(b.x)], 1u);
            asm volatile("s_waitcnt vmcnt(0)" ::: "memory");
        } else {
            XB_SPIN(xb_ld(&bar[XB_XGEN(b.x)]) == gen, bar);
            __builtin_amdgcn_fence(__ATOMIC_ACQUIRE, "agent");
            asm volatile("s_waitcnt vmcnt(0)" ::: "memory");
        }
    }
    __syncthreads();
}

namespace pg8 {
constexpr int BM = 256, BK = 64, HALF = 128, HTB = HALF * BK * 2, STAGE_BYTES = 8 * HTB, NXCD = 8, WGM = 8;
__host__ __device__ __forceinline__ int lds_byte(int r, int c) { const int st = (r >> 4) * 2 + (c >> 5), rr = r & 15, cc = c & 31, ob = rr * 64 + cc * 2; return st * 1024 + (ob ^ (((ob >> 9) & 1) << 5)); }
__host__ __device__ __forceinline__ void stage_rc(int b, int& R, int& C) { const int st = b / 1024, sb = b % 1024, swz = sb ^ (((sb >> 9) & 1) << 5); R = (st >> 1) * 16 + swz / 64; C = (st & 1) * 32 + (swz % 64) / 2; }
__host__ __device__ __forceinline__ int perm32(int rho) { const int n = rho >> 4, i = rho & 15; return 8 * (i >> 2) + 4 * n + (i & 3); }

struct Unit { int pm, pn, z; };
struct Gemm { const bf16_t* A; const bf16_t* Bt; int lda, ldb, K; size_t azs, bzs; };

struct StaticOrder {
    int nM, nN, nwg, G, c;
    __host__ __device__ __forceinline__ void init(int M, int N, int G_, int c_) { nM = M / BM; nN = N / BM; nwg = nM * nN; G = G_; c = c_; }
    __host__ __device__ __forceinline__ bool next(int i, Unit& u) const {
        const long L = (long)i * G + c; if (L >= nwg) return false;
        int wgid = (int)L; { const int q = nwg / NXCD, r = nwg % NXCD, xcd = wgid % NXCD, off = wgid / NXCD; wgid = (xcd < r ? xcd * (q + 1) : r * (q + 1) + (xcd - r) * q) + off; }
        const int nig = WGM * nN, gid = wgid / nig, fm = gid * WGM, gsz = (nM - fm) < WGM ? (nM - fm) : WGM;
        u.pm = fm + ((wgid % nig) % gsz); u.pn = (wgid % nig) / gsz; u.z = 0; return true;
    }
};
struct PairOrder {
    StaticOrder s;
    __host__ __device__ __forceinline__ bool next(int i, Unit& u) const { if (!s.next(i >> 1, u)) return false; u.z = i & 1; return true; }
};

template <class Epi, class Sched, bool ALIGN_EPI = true, bool SP2 = true>
__device__ __forceinline__ void gemm_phase(LAS unsigned char* lds, const int tid, const Gemm g, const Sched& S, const Epi& E) {
    const int wid = __builtin_amdgcn_readfirstlane(tid >> 6), lane = tid & 63, wr = wid >> 2, wc = wid & 3, fr = lane & 15, fq = lane >> 4;
    const int K = g.K, nt = K / BK;
    unsigned voffA[2], voffB[2];
#pragma unroll
    for (int i = 0; i < 2; ++i) { int R, C; stage_rc(tid * 16 + i * 8192, R, C); const int Rb = Epi::PERM ? ((R & ~31) + perm32(R & 31)) : R;
        const int Ra = Epi::PERM_A ? ((R & 64) | ((R & 15) << 2) | ((R >> 4) & 3)) : R;
        voffA[i] = (unsigned)(Ra * g.lda + C) * 2u; voffB[i] = (unsigned)(Rb * g.ldb + C) * 2u; }
    const size_t kstep = (size_t)(BK * 2);
    const size_t hstepA = (size_t)HALF * g.lda * 2, hstepB = (size_t)HALF * g.ldb * 2;
    const size_t tstepA = 2 * hstepA, tstepB = 2 * hstepB;
    const unsigned ldsw = (unsigned)wid * 1024u;
    const int aoff = lds_byte(wr * 64 + fr, fq * 8), boff = lds_byte(wc * 32 + fr, fq * 8);
#define PG8_SA(b, h) (((b) * 2 + (h)) * HTB)
#define PG8_SB(b, h) ((4 + (b) * 2 + (h)) * HTB)
#define PG8_STAGE(bufoff, gbase, voff) do { _Pragma("unroll") for (int _i = 0; _i < 2; ++_i) \
        __builtin_amdgcn_global_load_lds((const unsigned*)((const char*)(gbase) + (voff)[_i]), (LAS unsigned*)(lds + (bufoff) + ldsw + _i * 8192), 16, 0, 0); } while (0)
#define PG8_LDA(dst, b, h) do { _Pragma("unroll") for (int m = 0; m < 4; ++m) { const i32x4 lo_ = *(const LAS i32x4*)(lds + PG8_SA(b, h) + aoff + m * 2048), hi_ = *(const LAS i32x4*)(lds + PG8_SA(b, h) + aoff + m * 2048 + 1024); \
        dst[m] = __builtin_shufflevector(lo_, hi_, 0, 1, 2, 3, 4, 5, 6, 7); } } while (0)
#define PG8_LDB(dst, b, h) do { _Pragma("unroll") for (int n = 0; n < 2; ++n) { const i32x4 lo_ = *(const LAS i32x4*)(lds + PG8_SB(b, h) + boff + n * 2048), hi_ = *(const LAS i32x4*)(lds + PG8_SB(b, h) + boff + n * 2048 + 1024); \
        dst[n] = __builtin_shufflevector(lo_, hi_, 0, 1, 2, 3, 4, 5, 6, 7); } } while (0)
#define PG8_MMA(ai, bj, At, Bt) do { __builtin_amdgcn_s_setprio(1); \
        _Pragma("unroll") for (int m = 0; m < 4; ++m) _Pragma("unroll") for (int n = 0; n < 2; ++n) { \
            if constexpr (Epi::FP8) asm volatile("v_mfma_scale_f32_16x16x128_f8f6f4 %0, %1, %2, %0, %3, %3 op_sel_hi:[0,0,0]" : "+v"(acc[ai][bj][m][n]) : "v"(Bt[n]), "v"(At[m]), "v"(sc1_));     \
            else { acc[ai][bj][m][n] = __builtin_amdgcn_mfma_f32_16x16x32_bf16(__builtin_bit_cast(bf16x8, __builtin_shufflevector(Bt[n], Bt[n], 0, 1, 2, 3)), __builtin_bit_cast(bf16x8, __builtin_shufflevector(At[m], At[m], 0, 1, 2, 3)), acc[ai][bj][m][n], 0, 0, 0); \
                   acc[ai][bj][m][n] = __builtin_amdgcn_mfma_f32_16x16x32_bf16(__builtin_bit_cast(bf16x8, __builtin_shufflevector(Bt[n], Bt[n], 4, 5, 6, 7)), __builtin_bit_cast(bf16x8, __builtin_shufflevector(At[m], At[m], 4, 5, 6, 7)), acc[ai][bj][m][n], 0, 0, 0); } } \
        __builtin_amdgcn_s_setprio(0); } while (0)
#define PG8_WAIT_V(n) asm volatile("s_waitcnt vmcnt(" #n ")" ::: "memory")
#define PG8_WAIT_L(n) asm volatile("s_waitcnt lgkmcnt(" #n ")" ::: "memory")
#define PG8_BAR __builtin_amdgcn_s_barrier()
#define PG8_SCHED __builtin_amdgcn_sched_barrier(0)
    Unit cur, nxt; int ui = 0;
    if (!S.next(0, cur)) return;
    f32x4 acc[2][2][4][2];
#pragma unroll
    for (int a = 0; a < 2; ++a)
#pragma unroll
        for (int b = 0; b < 2; ++b)
#pragma unroll
            for (int m = 0; m < 4; ++m)
#pragma unroll
                for (int n = 0; n < 2; ++n) acc[a][b][m][n] = (f32x4){0.f, 0.f, 0.f, 0.f};
    i32x8 At[4], B0[2], B1[2];
    const int sc1_ = 0x7f7f7f7f;
    const char* cA = (const char*)g.A + (size_t)cur.z * g.azs + (size_t)cur.pm * tstepA; const char* cB = (const char*)g.Bt + (size_t)cur.z * g.bzs + (size_t)cur.pn * tstepB;
    if constexpr (SP2) {
        PG8_STAGE(PG8_SB(0, 0), cB, voffB); PG8_STAGE(PG8_SB(0, 1), cB + hstepB, voffB); PG8_STAGE(PG8_SA(0, 0), cA, voffA); PG8_STAGE(PG8_SA(0, 1), cA + hstepA, voffA);
        if (wr == 1) PG8_BAR;
        PG8_WAIT_V(2); PG8_BAR;
        PG8_STAGE(PG8_SB(1, 0), cB + kstep, voffB); PG8_STAGE(PG8_SA(1, 0), cA + kstep, voffA); PG8_STAGE(PG8_SB(1, 1), cB + hstepB + kstep, voffB);
        PG8_WAIT_V(6); PG8_BAR;
    } else {
        PG8_STAGE(PG8_SB(0, 0), cB, voffB); PG8_STAGE(PG8_SA(0, 0), cA, voffA); PG8_STAGE(PG8_SB(0, 1), cB + hstepB, voffB); PG8_STAGE(PG8_SA(0, 1), cA + hstepA, voffA);
        if (wr == 1) PG8_BAR;
        PG8_WAIT_V(4); PG8_BAR;
        PG8_STAGE(PG8_SB(1, 0), cB + kstep, voffB); PG8_STAGE(PG8_SA(1, 0), cA + kstep, voffA); PG8_STAGE(PG8_SB(1, 1), cB + hstepB + kstep, voffB);
        PG8_WAIT_V(6); PG8_BAR;
    }
    for (;;) {
        const bool has_next = S.next(ui + 1, nxt);
        const char* nA = has_next ? (const char*)g.A + (size_t)nxt.z * g.azs + (size_t)nxt.pm * tstepA : cA; const char* nB = has_next ? (const char*)g.Bt + (size_t)nxt.z * g.bzs + (size_t)nxt.pn * tstepB : cB;
        for (int t = 0; t < nt; t += 2) {
            const bool last = (t == nt - 2);
            const char* a1 = cA + (size_t)(t + 1) * kstep;
            const char* a2 = last ? nA : cA + (size_t)(t + 2) * kstep; const char* b2 = last ? nB : cB + (size_t)(t + 2) * kstep;
            const char* a3 = a2 + kstep; const char* b3 = b2 + kstep;
            if constexpr (SP2) {
            PG8_LDB(B0, 0, 0); PG8_LDB(B1, 0, 1); PG8_SCHED; PG8_LDA(At, 0, 0); PG8_STAGE(PG8_SA(1, 1), a1 + hstepA, voffA);
            PG8_WAIT_V(8); PG8_WAIT_L(0); PG8_BAR; PG8_MMA(0, 0, At, B0); PG8_MMA(0, 1, At, B1); PG8_BAR; PG8_SCHED;
            PG8_LDA(At, 0, 1); PG8_STAGE(PG8_SB(0, 0), b2, voffB); PG8_STAGE(PG8_SB(0, 1), b2 + hstepB, voffB); PG8_STAGE(PG8_SA(0, 0), a2, voffA);
            PG8_WAIT_V(8); PG8_WAIT_L(0); PG8_BAR; PG8_MMA(1, 0, At, B0); PG8_MMA(1, 1, At, B1); PG8_BAR; PG8_SCHED;
            PG8_LDB(B0, 1, 0); PG8_LDB(B1, 1, 1); PG8_SCHED; PG8_LDA(At, 1, 0); PG8_STAGE(PG8_SA(0, 1), a2 + hstepA, voffA);
            PG8_WAIT_V(8); PG8_WAIT_L(0); PG8_BAR; PG8_MMA(0, 0, At, B0); PG8_MMA(0, 1, At, B1); PG8_BAR; PG8_SCHED;
            PG8_LDA(At, 1, 1); PG8_STAGE(PG8_SB(1, 0), b3, voffB); PG8_STAGE(PG8_SB(1, 1), b3 + hstepB, voffB); PG8_STAGE(PG8_SA(1, 0), a3, voffA);
            PG8_WAIT_V(8); PG8_WAIT_L(0); PG8_BAR; PG8_MMA(1, 0, At, B0); PG8_MMA(1, 1, At, B1); PG8_BAR; PG8_SCHED;
            } else {
            PG8_LDB(B0, 0, 0); PG8_SCHED; PG8_LDA(At, 0, 0); PG8_STAGE(PG8_SA(1, 1), a1 + hstepA, voffA);
            PG8_WAIT_L(8); PG8_BAR; PG8_WAIT_L(0); PG8_MMA(0, 0, At, B0); PG8_BAR; PG8_SCHED;
            PG8_LDB(B1, 0, 1); PG8_STAGE(PG8_SB(0, 0), b2, voffB);
            PG8_BAR; PG8_WAIT_L(0); PG8_MMA(0, 1, At, B1); PG8_BAR;
            PG8_LDA(At, 0, 1); PG8_STAGE(PG8_SA(0, 0), a2, voffA);
            PG8_BAR; PG8_WAIT_L(0); PG8_MMA(1, 0, At, B0); PG8_BAR; PG8_SCHED;
            PG8_STAGE(PG8_SB(0, 1), b2 + hstepB, voffB);
            PG8_WAIT_V(6); PG8_BAR; PG8_MMA(1, 1, At, B1); PG8_BAR;
            PG8_LDB(B0, 1, 0); PG8_SCHED; PG8_LDA(At, 1, 0); PG8_STAGE(PG8_SA(0, 1), a2 + hstepA, voffA);
            PG8_WAIT_L(8); PG8_BAR; PG8_WAIT_L(0); PG8_MMA(0, 0, At, B0); PG8_BAR; PG8_SCHED;
            PG8_LDB(B1, 1, 1); PG8_STAGE(PG8_SB(1, 0), b3, voffB);
            PG8_BAR; PG8_WAIT_L(0); PG8_MMA(0, 1, At, B1); PG8_BAR;
            PG8_LDA(At, 1, 1); PG8_STAGE(PG8_SA(1, 0), a3, voffA);
            PG8_BAR; PG8_WAIT_L(0); PG8_MMA(1, 0, At, B0); PG8_BAR; PG8_SCHED;
            PG8_STAGE(PG8_SB(1, 1), b3 + hstepB, voffB);
            PG8_WAIT_V(6); PG8_BAR; PG8_MMA(1, 1, At, B1); PG8_BAR;
            }
        }
        if constexpr (ALIGN_EPI) { if (wr == 0) PG8_BAR; }
        if constexpr (Epi::NEXT_HOOK) E(acc, cur, wr, wc, fr, fq, ui, has_next, nxt); else E(acc, cur, wr, wc, fr, fq);
        if (!has_next) break;
#pragma unroll
        for (int a = 0; a < 2; ++a)
#pragma unroll
            for (int b = 0; b < 2; ++b)
#pragma unroll
                for (int m = 0; m < 4; ++m)
#pragma unroll
                    for (int n = 0; n < 2; ++n) acc[a][b][m][n] = (f32x4){0.f, 0.f, 0.f, 0.f};
        cur = nxt; cA = nA; cB = nB; ++ui;
        if constexpr (ALIGN_EPI) { if (wr == 1) PG8_BAR; }
    }
    PG8_WAIT_V(0);
    if constexpr (!ALIGN_EPI) { if (wr == 0) PG8_BAR; }
    PG8_BAR;
#undef PG8_SA
#undef PG8_SB
#undef PG8_STAGE
#undef PG8_LDA
#undef PG8_LDB
#undef PG8_MMA
#undef PG8_WAIT_V
#undef PG8_WAIT_L
#undef PG8_BAR
#undef PG8_SCHED
}

struct EpiStoreBf16 {
    static constexpr bool NEXT_HOOK = false;
    static constexpr bool PERM = true, PERM_A = false, FP8 = false;
    bf16_t* O; int ldc; const fx64* ssq; float invk;
    __device__ __forceinline__ void operator()(const f32x4 (&acc)[2][2][4][2], const Unit& u, int wr, int wc, int fr, int fq) const {
        const int row0 = u.pm * BM + wr * 64 + fr, col0 = u.pn * BM + wc * 32 + 8 * fq;
        fx64 sv[2][4];
#pragma unroll
        for (int ai = 0; ai < 2; ++ai)
#pragma unroll
            for (int m = 0; m < 4; ++m) sv[ai][m] = ssq[row0 + ai * HALF + m * 16];
#pragma unroll
        for (int ai = 0; ai < 2; ++ai)
#pragma unroll
            for (int m = 0; m < 4; ++m) { bf16_t* rowp = O + (size_t)(row0 + ai * HALF + m * 16) * ldc + col0;
                const float rs = fast_rsq((float)sv[ai][m] * (FX_SSQ_INV * invk) + EPS);
#pragma unroll
                for (int bj = 0; bj < 2; ++bj) { const f32x4 v0 = acc[ai][bj][m][0] * rs, v1 = acc[ai][bj][m][1] * rs;
                    u32x4 w; w.x = cvt_pk_bf16(v0[0], v0[1]); w.y = cvt_pk_bf16(v0[2], v0[3]); w.z = cvt_pk_bf16(v1[0], v1[1]); w.w = cvt_pk_bf16(v1[2], v1[3]);
                    *(u32x4*)(rowp + bj * HALF) = w; } }
    }
};
struct EpiPab {
    static constexpr bool NEXT_HOOK = false;
    static constexpr bool PERM = true, PERM_A = false, FP8 = false;
    const bf16_t* proj; bf16_t* merged;
    __device__ __forceinline__ void operator()(const f32x4 (&acc)[2][2][4][2], const Unit& u, int wr, int wc, int fr, int fq) const {
        const int row0 = u.pm * BM + wr * 64 + fr, col0 = u.pn * BM + wc * 32 + 8 * fq;
        const int gcol = (u.z ? PC_GB : PC_GA) + col0;
        const bool z1 = (u.z != 0);
        u32x4 gw[2][2][2], pw[2][2][2];
#define PAB_LOAD(bt, buf) do { _Pragma("unroll") for (int mm = 0; mm < 2; ++mm) { const size_t r = (size_t)(row0 + ((bt) >> 1) * HALF + (((bt) & 1) * 2 + mm) * 16); \
            _Pragma("unroll") for (int bj = 0; bj < 2; ++bj) { gw[buf][mm][bj] = *(const u32x4*)(proj + r * NPROJ + gcol + bj * HALF); \
                pw[buf][mm][bj] = (u32x4){0u, 0u, 0u, 0u}; if (z1) pw[buf][mm][bj] = *(const u32x4*)(merged + r * DM + col0 + bj * HALF); } } } while (0)
        PAB_LOAD(0, 0);
#pragma unroll
        for (int bt = 0; bt < 4; ++bt) {
            __builtin_amdgcn_sched_barrier(0);
            if (bt + 1 < 4) { if ((bt & 1) == 0) PAB_LOAD(bt + 1, 1); else PAB_LOAD(bt + 1, 0); }
            __builtin_amdgcn_sched_barrier(0);
            const int ai = bt >> 1, buf = bt & 1;
#pragma unroll
            for (int mm = 0; mm < 2; ++mm) { const int m = (bt & 1) * 2 + mm; const size_t r = (size_t)(row0 + ai * HALF + m * 16);
#pragma unroll
                for (int bj = 0; bj < 2; ++bj) {
                    const u32x4 g = gw[buf][mm][bj], p = pw[buf][mm][bj];
                    const f32x4 v0 = acc[ai][bj][m][0], v1 = acc[ai][bj][m][1];
                    float o[8];
                    o[0] = sigmoidf_(bf_lo(g.x)) * v0[0]; o[1] = sigmoidf_(bf_hi(g.x)) * v0[1]; o[2] = sigmoidf_(bf_lo(g.y)) * v0[2]; o[3] = sigmoidf_(bf_hi(g.y)) * v0[3];
                    o[4] = sigmoidf_(bf_lo(g.z)) * v1[0]; o[5] = sigmoidf_(bf_hi(g.z)) * v1[1]; o[6] = sigmoidf_(bf_lo(g.w)) * v1[2]; o[7] = sigmoidf_(bf_hi(g.w)) * v1[3];
                    if (z1) { o[0] += bf_lo(p.x); o[1] += bf_hi(p.x); o[2] += bf_lo(p.y); o[3] += bf_hi(p.y); o[4] += bf_lo(p.z); o[5] += bf_hi(p.z); o[6] += bf_lo(p.w); o[7] += bf_hi(p.w); }
                    u32x4 w; w.x = cvt_pk_bf16(o[0], o[1]); w.y = cvt_pk_bf16(o[2], o[3]); w.z = cvt_pk_bf16(o[4], o[5]); w.w = cvt_pk_bf16(o[6], o[7]);
                    *(u32x4*)(merged + r * DM + col0 + bj * HALF) = w; } }
        }
#undef PAB_LOAD
    }
};
struct EpiResid {
    static constexpr bool NEXT_HOOK = false;
    static constexpr bool PERM = false, PERM_A = false, FP8 = false;
    const float* xsrc; float* out; const float* gate;
    __device__ __forceinline__ void operator()(const f32x4 (&acc)[2][2][4][2], const Unit& u, int wr, int wc, int fr, int fq) const {
        const int row0 = u.pm * BM + wr * 64 + fr, col0 = u.pn * BM + wc * 32 + 4 * fq;
        const float* gp = gate + (size_t)(u.pm >> 3) * NADA + col0;
        f32x4 gv[2][2];
#pragma unroll
        for (int bj = 0; bj < 2; ++bj)
#pragma unroll
            for (int n = 0; n < 2; ++n) gv[bj][n] = *(const f32x4*)(gp + bj * HALF + n * 16);
#pragma unroll
        for (int ai = 0; ai < 2; ++ai)
#pragma unroll
            for (int m = 0; m < 4; ++m) { const size_t off = (size_t)(row0 + ai * HALF + m * 16) * DM + col0;
#pragma unroll
                for (int bj = 0; bj < 2; ++bj)
#pragma unroll
                    for (int n = 0; n < 2; ++n) { const f32x4 xv = *(const f32x4*)(xsrc + off + bj * HALF + n * 16);
                        *(f32x4*)(out + off + bj * HALF + n * 16) = xv + gv[bj][n] * acc[ai][bj][m][n]; }
                if (m & 1) asm volatile("" ::: "memory"); }
    }
};

struct EpiProjNorm {
    static constexpr bool NEXT_HOOK = false;
    static constexpr bool PERM = true, PERM_A = false, FP8 = true;
    bf16_t* O; int ldc; const fx64* ssq; const fx64* bias; int ldb; LAS float* tab; fx64* ssq_lat;
    __device__ __forceinline__ void operator()(const f32x4 (&acc)[2][2][4][2], const Unit& u, int wr, int wc, int fr, int fq) const {
        { const int t = (int)threadIdx.x;
          if (t < 256) tab[t] = fast_rsq((float)ssq[u.pm * BM + t] * (FX_SSQ_INV / DM) + EPS) * W8_INV;
          else tab[t] = (float)bias[(size_t)(u.pm >> 3) * ldb + u.pn * BM + (t - 256)] * FX_BIAS_INV;
          asm volatile("s_waitcnt lgkmcnt(0)" ::: "memory"); __builtin_amdgcn_s_barrier(); asm volatile("" ::: "memory"); }
        const int rl = wr * 64 + fr, cl = wc * 32 + 8 * fq;
        const int row0 = u.pm * BM + rl, col0 = u.pn * BM + cl;
        const bool lat = (u.pn * BM >= PC_MQL && u.pn * BM < PC_GA);
        float sqr[8];
#pragma unroll
        for (int ai = 0; ai < 2; ++ai)
#pragma unroll
            for (int m = 0; m < 4; ++m) { const int row = row0 + ai * HALF + m * 16; bf16_t* rowp = O + (size_t)row * ldc + col0;
                const float rs = tab[rl + ai * HALF + m * 16];
                float sq = 0.f;
#pragma unroll
                for (int bj = 0; bj < 2; ++bj) { const f32x4 b0 = *(const LAS f32x4*)(tab + 256 + cl + bj * HALF), b1 = *(const LAS f32x4*)(tab + 256 + cl + bj * HALF + 4);
                    const f32x4 v0 = acc[ai][bj][m][0] * rs + b0, v1 = acc[ai][bj][m][1] * rs + b1;
                    if (lat) sq += v0[0] * v0[0] + v0[1] * v0[1] + v0[2] * v0[2] + v0[3] * v0[3] + v1[0] * v1[0] + v1[1] * v1[1] + v1[2] * v1[2] + v1[3] * v1[3];
                    u32x4 w; w.x = cvt_pk_bf16(v0[0], v0[1]); w.y = cvt_pk_bf16(v0[2], v0[3]); w.z = cvt_pk_bf16(v1[0], v1[1]); w.w = cvt_pk_bf16(v1[2], v1[3]);
                    *(u32x4*)(rowp + bj * HALF) = w; }
                if (lat) { sq += swz_xor<16>(sq); sq = pair32_sum(sq); }
                sqr[ai * 4 + m] = sq; }
        if (lat && fq == 0) { fx64* sl = ssq_lat + (u.pn * BM >= PC_MKVL ? MROWS : 0);
#pragma unroll
            for (int j = 0; j < 8; ++j) fx_add(sl + row0 + (j >> 2) * HALF + (j & 3) * 16, (double)sqr[j] * (double)FX_SSQ); }
        asm volatile("" ::: "memory");
    }
};
struct EpiResidNorm {
    static constexpr bool NEXT_HOOK = false;
    static constexpr bool PERM = false, PERM_A = false, FP8 = false;
    const float* xsrc; float* out; const float* gate;
    const float* gn; const float* scn; bf16_t* hn; fx64* ssq; int h8;
    __device__ __forceinline__ void operator()(const f32x4 (&acc)[2][2][4][2], const Unit& u, int wr, int wc, int fr, int fq) const {
        const int row0 = u.pm * BM + wr * 64 + fr, col0 = u.pn * BM + wc * 32 + 4 * fq;
        const float* gp = gate + (size_t)(u.pm >> 3) * NADA + col0;
        f32x4 gv[2][2], gs[2][2];
#pragma unroll
        for (int bj = 0; bj < 2; ++bj)
#pragma unroll
            for (int n = 0; n < 2; ++n) { gv[bj][n] = *(const f32x4*)(gp + bj * HALF + n * 16);
                gs[bj][n] = hn ? *(const f32x4*)(gn + col0 + bj * HALF + n * 16) * (*(const f32x4*)(scn + (size_t)(u.pm >> 3) * NADA + col0 + bj * HALF + n * 16) + 1.0f) : (f32x4){0.f, 0.f, 0.f, 0.f}; }
        f32x4 xv[3][2][2];
        float sqr[8];
#define RN_LOAD(g, buf) do { const size_t off = (size_t)(row0 + ((g) >> 2) * HALF + ((g) & 3) * 16) * DM + col0; \
            _Pragma("unroll") for (int bj = 0; bj < 2; ++bj) _Pragma("unroll") for (int n = 0; n < 2; ++n) xv[buf][bj][n] = *(const f32x4*)(xsrc + off + bj * HALF + n * 16); } while (0)
        RN_LOAD(0, 0); RN_LOAD(1, 1);
#pragma unroll
        for (int g = 0; g < 8; ++g) {
            __builtin_amdgcn_sched_barrier(0);
            if (g + 2 < 8) { if ((g + 2) % 3 == 0) RN_LOAD(g + 2, 0); else if ((g + 2) % 3 == 1) RN_LOAD(g + 2, 1); else RN_LOAD(g + 2, 2); }
            __builtin_amdgcn_sched_barrier(0);
            const int ai = g >> 2, m = g & 3, buf = g % 3;
            const int row = row0 + ai * HALF + m * 16; const size_t off = (size_t)row * DM + col0;
            float sq = 0.f;
#pragma unroll
            for (int bj = 0; bj < 2; ++bj)
#pragma unroll
                for (int n = 0; n < 2; ++n) {
                    const f32x4 o = xv[buf][bj][n] + gv[bj][n] * acc[ai][bj][m][n];
                    *(f32x4*)(out + off + bj * HALF + n * 16) = o;
                    if (hn) { sq += o[0] * o[0] + o[1] * o[1] + o[2] * o[2] + o[3] * o[3];
                        const f32x4 hv = o * gs[bj][n];
                        if (h8) *(unsigned*)((unsigned char*)hn + off + bj * HALF + n * 16) = cvt_fp8x4(hv[0], hv[1], hv[2], hv[3]);
                        else { u32x2 w; w.x = cvt_pk_bf16(hv[0], hv[1]); w.y = cvt_pk_bf16(hv[2], hv[3]); *(u32x2*)(hn + off + bj * HALF + n * 16) = w; } } }
            if (hn) { sq += swz_xor<16>(sq); sq = pair32_sum(sq); }
            sqr[g] = sq;
        }
#undef RN_LOAD
        if (hn && fq == 0) {
#pragma unroll
            for (int j = 0; j < 8; ++j) fx_add(ssq + row0 + (j >> 2) * HALF + (j & 3) * 16, (double)sqr[j] * (double)FX_SSQ); }
    }
};

template <int CTRL> __device__ __forceinline__ float dpp_old_f(float oldv, float v) { return __int_as_float(__builtin_amdgcn_update_dpp(__float_as_int(oldv), __float_as_int(v), CTRL, 0xf, 0xf, false)); }
struct EpiUpConv {
    static constexpr bool NEXT_HOOK = true;
    static constexpr bool PERM = true, PERM_A = true, FP8 = false;
    const float* wconv; const float* bconv; bf16_t* act; float* uhead; float* utail; LAS float* xb; const fx64* ssq; const fx64* bias; LAS float* tab0; LAS float* ctab0; LAS float* tab1; LAS float* ctab1;
    __device__ __forceinline__ static int xidx(int ai, int rr, int wr, int wc, int bj, int n, int fq) { return ((((((ai * 2 + rr) * 2 + wr) * 4 + wc) * 2 + bj) * 2 + n) * 4 + fq) * 4; }
    __device__ __forceinline__ void tab_load(const Unit& uu, int t, fx64& v, float& c0, float& c1) const {
        v = (t < 256) ? ssq[uu.pm * BM + t] : bias[(size_t)(uu.pm >> 3) * NUP + uu.pn * BM + (t - 256)];
        { const int e = t, tap = e >> 8, half = (e >> 7) & 1, c = e & 127; c0 = (wconv + (size_t)tap * NUP)[uu.pn * HALF + half * DFF + c]; }
        { const int e = t + 512, tap = e >> 8, half = (e >> 7) & 1, c = e & 127; const float* sp = (tap < 3) ? (wconv + (size_t)tap * NUP) : bconv; c1 = sp[uu.pn * HALF + half * DFF + c]; } }
    __device__ __forceinline__ static void tab_store(LAS float* tb, LAS float* ct, int t, fx64 v, float c0, float c1) {
        if (t < 256) tb[t] = fast_rsq((float)v * (FX_SSQ_INV / DM) + EPS); else tb[t] = (float)v * FX_BIAS_INV;
        ct[t] = c0; ct[t + 512] = c1; }
    __device__ __forceinline__ void operator()(f32x4 (&acc)[2][2][4][2], const Unit& u, int wr, int wc, int fr, int fq, int ui, bool has_next, const Unit& nxt) const {
        LAS float* tab = (ui & 1) ? tab1 : tab0; LAS float* ctab = (ui & 1) ? ctab1 : ctab0;
        const int t = ((wr * 4 + wc) << 6) + (fq << 4) + fr;
        const int colp = u.pn * BM + wc * 32 + 8 * fq;
        const int ch0 = u.pn * HALF + wc * 32 + 8 * fq;
        {
            if (ui == 0) { fx64 v; float c0, c1; tab_load(u, t, v, c0, c1); tab_store(tab, ctab, t, v, c0, c1);
                asm volatile("s_waitcnt lgkmcnt(0)" ::: "memory"); __builtin_amdgcn_s_barrier(); asm volatile("" ::: "memory"); }
            f32x4 rs[2];
#pragma unroll
            for (int ai = 0; ai < 2; ++ai) rs[ai] = *(const LAS f32x4*)(tab + ai * HALF + wr * 64 + 4 * fr);
#pragma unroll
            for (int bj = 0; bj < 2; ++bj)
#pragma unroll
                for (int n = 0; n < 2; ++n) { const f32x4 bv = *(const LAS f32x4*)(tab + 256 + wc * 32 + 8 * fq + bj * HALF + 4 * n);
#pragma unroll
                    for (int ai = 0; ai < 2; ++ai)
#pragma unroll
                        for (int m = 0; m < 4; ++m) acc[ai][bj][m][n] = acc[ai][bj][m][n] * rs[ai][m] + bv; }
        }
        fx64 nv = 0; float nc0 = 0.f, nc1 = 0.f;
        if (has_next) tab_load(nxt, t, nv, nc0, nc1);
        if (fr == 15) {
#pragma unroll
            for (int ai = 0; ai < 2; ++ai)
#pragma unroll
                for (int bj = 0; bj < 2; ++bj)
#pragma unroll
                    for (int n = 0; n < 2; ++n) { *(LAS f32x4*)(xb + xidx(ai, 0, wr, wc, bj, n, fq)) = acc[ai][bj][2][n]; *(LAS f32x4*)(xb + xidx(ai, 1, wr, wc, bj, n, fq)) = acc[ai][bj][3][n]; }
            if (wr == 1) {
#pragma unroll
                for (int bj = 0; bj < 2; ++bj)
#pragma unroll
                    for (int n = 0; n < 2; ++n) { *(f32x4*)(utail + (size_t)(u.pm * 2 + 0) * NUP + colp + bj * HALF + 4 * n) = acc[1][bj][2][n]; *(f32x4*)(utail + (size_t)(u.pm * 2 + 1) * NUP + colp + bj * HALF + 4 * n) = acc[1][bj][3][n]; }
            }
        }
        if (fr == 0 && wr == 0) {
#pragma unroll
            for (int bj = 0; bj < 2; ++bj)
#pragma unroll
                for (int n = 0; n < 2; ++n) { *(f32x4*)(uhead + (size_t)(u.pm * 2 + 0) * NUP + colp + bj * HALF + 4 * n) = acc[0][bj][0][n]; *(f32x4*)(uhead + (size_t)(u.pm * 2 + 1) * NUP + colp + bj * HALF + 4 * n) = acc[0][bj][1][n]; }
        }
        asm volatile("s_waitcnt lgkmcnt(0)" ::: "memory"); __builtin_amdgcn_s_barrier(); asm volatile("" ::: "memory");
        const bool skip01 = (wr == 0) && (fr == 0) && ((u.pm & 7) != 0);
        const LAS float* cl = ctab + wc * 32 + 8 * fq;
        f32x4 cg[4];
#pragma unroll
        for (int it = 0; it < 8; ++it) {
            const int n = it >> 2, ai = (it >> 1) & 1, bj = it & 1;
            const f32x4 w0 = *(const LAS f32x4*)(cl + (0 * 2 + bj) * 128 + 4 * n), w1 = *(const LAS f32x4*)(cl + (1 * 2 + bj) * 128 + 4 * n), w2 = *(const LAS f32x4*)(cl + (2 * 2 + bj) * 128 + 4 * n), bb = *(const LAS f32x4*)(cl + (3 * 2 + bj) * 128 + 4 * n);
            f32x4 p1 = (f32x4){0.f, 0.f, 0.f, 0.f}, p2 = p1;
            if (wr == 1 || ai == 1) {
                const int sai = (wr == 1) ? ai : 0, swr = (wr == 1) ? 0 : 1;
                p2 = *(const LAS f32x4*)(xb + xidx(sai, 0, swr, wc, bj, n, fq)); p1 = *(const LAS f32x4*)(xb + xidx(sai, 1, swr, wc, bj, n, fq));
            }
            const f32x4 v0 = acc[ai][bj][0][n], v1 = acc[ai][bj][1][n], v2 = acc[ai][bj][2][n], v3 = acc[ai][bj][3][n];
            f32x4 s3, s2;
#pragma unroll
            for (int e = 0; e < 4; ++e) { s3[e] = dpp_old_f<0x111>(p1[e], v3[e]); s2[e] = dpp_old_f<0x111>(p2[e], v2[e]); }
#pragma unroll
            for (int m = 0; m < 4; ++m) {
                const f32x4 v = (m == 0) ? v0 : (m == 1) ? v1 : (m == 2) ? v2 : v3;
                const f32x4 q1 = (m == 0) ? s3 : (m == 1) ? v0 : (m == 2) ? v1 : v2;
                const f32x4 q2 = (m == 0) ? s2 : (m == 1) ? s3 : (m == 2) ? v0 : v1;
                const f32x4 cvv = bb + w0 * q2 + w1 * q1 + w2 * v;
                if (bj == 0) cg[m] = cvv;
                else {
                    float o[4];
#pragma unroll
                    for (int e = 0; e < 4; ++e) { const float g = cg[m][e]; o[e] = g * sigmoidf_(g) * cvv[e]; }
                    u32x2 ow; ow.x = cvt_pk_bf16(o[0], o[1]); ow.y = cvt_pk_bf16(o[2], o[3]);
                    const int row = u.pm * BM + ai * HALF + wr * 64 + 4 * fr + m;
                    if (!(skip01 && ai == 0 && m < 2)) *(u32x2*)(act + (size_t)row * DFF + ch0 + 4 * n) = ow;
                }
            }
        }
        if (has_next) tab_store((ui & 1) ? tab0 : tab1, (ui & 1) ? ctab0 : ctab1, t, nv, nc0, nc1);
    }
};
}

struct Args { const void* in[23]; float* out; unsigned char* ws; float inv_a[16]; float inv_i[8]; float inv_m[32]; int ph_lo, ph_hi; };
static_assert(sizeof(Args) == 23 * 8 + 16 + 56 * 4 + 8, "Args has no padding");

typedef const __attribute__((address_space(4))) struct Args* ArgsCP;
struct Frame {
    LAS unsigned char* lds; int tid, lane, wave, G, bid;
    unsigned char* ws; ArgsCP a;
};

__device__ __forceinline__ void sincos_d(double a, float& s, float& c) {
    const double q = __builtin_rint(a * 0.63661977236758134308);
    double r = __builtin_fma(-q, 1.57079632673412561417e+00, a);
    r = __builtin_fma(-q, 6.07710050650619224932e-11, r);
    const double r2 = r * r;
    double sp = -7.6471637318198164759e-13; sp = sp * r2 + 1.6059043836821614599e-10; sp = sp * r2 - 2.5052108385441718775e-08; sp = sp * r2 + 2.7557319223985890653e-06;
    sp = sp * r2 - 1.9841269841269841270e-04; sp = sp * r2 + 8.3333333333333333333e-03; sp = sp * r2 - 1.6666666666666666667e-01; const double sr = r + r * r2 * sp;
    double cp = 4.7794773323873852974e-14; cp = cp * r2 - 1.1470745597729724714e-11; cp = cp * r2 + 2.0876756987868098979e-09; cp = cp * r2 - 2.7557319223985890653e-07;
    cp = cp * r2 + 2.4801587301587301587e-05; cp = cp * r2 - 1.3888888888888888889e-03; cp = cp * r2 + 4.1666666666666666667e-02; cp = cp * r2 - 0.5; const double cr = 1.0 + r2 * cp;
    const int qi = ((int)q) & 3;
    const double sv = (qi == 0) ? sr : (qi == 1) ? cr : (qi == 2) ? -sr : -cr;
    const double cv = (qi == 0) ? cr : (qi == 1) ? -sr : (qi == 2) ? -cr : sr;
    s = (float)sv; c = (float)cv;
}

__device__ __forceinline__ int cmap_in(int n) {
    if (n < 2640) return n;
    if (n < 2704) return 3408 + (n - 2640);
    if (n < 2816) return -1;
    if (n < 3328) return 2640 + (n - 2816);
    if (n < 3584) return 3152 + (n - 3328);
    return 3472 + (n - 3584);
}
__device__ __forceinline__ int cmap_up(int n) { const int j = n >> 8, w = n & 255; return (w < 128) ? (128 * j + w) : (DFF + 128 * j + (w - 128)); }

struct TileDesc { const float* src; bf16_t* dst; const float* shift; fx64* bias; const float* gk; int ldsrc, K, k0, n0, mode, ldbias; float w8; };
__device__ __forceinline__ void tile_load(const Frame& F, const TileDesc& d, f32x4 (&v)[8], float& shv) {
    const int a = F.tid >> 5, n4 = F.tid & 31; const int n = d.n0 + 4 * n4;
    const int c = (d.mode == 0) ? n : (d.mode == 1) ? cmap_in(n) : cmap_up(n);
#pragma unroll
    for (int i = 0; i < 8; ++i) v[i] = (c >= 0) ? *(const f32x4*)(d.src + (size_t)(d.k0 + 8 * a + i) * d.ldsrc + c) : (f32x4){0.f, 0.f, 0.f, 0.f};
    shv = d.bias ? d.shift[(size_t)(F.tid >> 7) * NADA + d.k0 + (F.tid & 127)] : 0.f;
}
constexpr int TR_SH = 69632, TR_RED = 73728;
__device__ __forceinline__ void tile_to_lds(const Frame& F, const TileDesc& d, const f32x4 (&v)[8], float shv) {
    LAS unsigned char* O = F.lds;
    const int a = F.tid >> 5, n4 = F.tid & 31;
    if (d.w8 != 0.f) {
        const int pos = a ^ ((n4 & 7) << 1);
#pragma unroll
        for (int e = 0; e < 4; ++e) { u32x2 w; w.x = cvt_fp8x4(v[0][e] * d.w8, v[1][e] * d.w8, v[2][e] * d.w8, v[3][e] * d.w8); w.y = cvt_fp8x4(v[4][e] * d.w8, v[5][e] * d.w8, v[6][e] * d.w8, v[7][e] * d.w8);
            *(LAS u32x2*)(O + (4 * n4 + e) * 128 + pos * 8) = w; }
    } else {
        const int pos = a ^ (n4 & 15);
        f32x4 g0 = (f32x4){1.f, 1.f, 1.f, 1.f}, g1 = g0;
        if (d.gk) { g0 = *(const f32x4*)(d.gk + d.k0 + 8 * a); g1 = *(const f32x4*)(d.gk + d.k0 + 8 * a + 4); }
#pragma unroll
        for (int e = 0; e < 4; ++e) { u32x4 w; w.x = cvt_pk_bf16(v[0][e] * g0[0], v[1][e] * g0[1]); w.y = cvt_pk_bf16(v[2][e] * g0[2], v[3][e] * g0[3]); w.z = cvt_pk_bf16(v[4][e] * g1[0], v[5][e] * g1[1]); w.w = cvt_pk_bf16(v[6][e] * g1[2], v[7][e] * g1[3]);
            *(LAS u32x4*)(O + (4 * n4 + e) * 256 + pos * 16) = w; }
    }
    if (d.bias) ((LAS float*)(F.lds + TR_SH))[F.tid] = shv;
}
__device__ __forceinline__ void tile_bias(const Frame& F, const TileDesc& d, const f32x4 (&v)[8], float (&pb)[16]) {
#pragma unroll
    for (int x = 0; x < 16; ++x) pb[x] = 0.f;
    if (d.bias) { const LAS float* SH = (const LAS float*)(F.lds + TR_SH); const int a = F.tid >> 5;
#pragma unroll
        for (int b = 0; b < 4; ++b) { const f32x4 s0 = *(const LAS f32x4*)(SH + b * 128 + 8 * a), s1 = *(const LAS f32x4*)(SH + b * 128 + 8 * a + 4);
#pragma unroll
            for (int e = 0; e < 4; ++e) pb[b * 4 + e] = v[0][e] * s0[0] + v[1][e] * s0[1] + v[2][e] * s0[2] + v[3][e] * s0[3] + v[4][e] * s1[0] + v[5][e] * s1[1] + v[6][e] * s1[2] + v[7][e] * s1[3]; } }
}
__device__ __forceinline__ void tile_finish(const Frame& F, const TileDesc& d, float (&pb)[16]) {
    const LAS unsigned char* O = F.lds; LAS float* RED = (LAS float*)(F.lds + TR_RED);
    if (d.bias) {
#pragma unroll
        for (int x = 0; x < 16; ++x) pb[x] = pair32_sum(pb[x]);
        if (F.lane < 32) {
#pragma unroll
            for (int b = 0; b < 4; ++b) *(LAS f32x4*)(RED + (F.wave * 4 + b) * 128 + 4 * F.lane) = (f32x4){pb[b * 4 + 0], pb[b * 4 + 1], pb[b * 4 + 2], pb[b * 4 + 3]}; }
    }
    if (d.w8 != 0.f) {
#pragma unroll
        for (int p = 0; p < 2; ++p) { const int n = 64 * p + (F.tid >> 3), c16 = F.tid & 7; const int m = c16 ^ ((n >> 2) & 7);
            const u32x4 w = *(const LAS u32x4*)(O + n * 128 + m * 16);
            *(u32x4*)((unsigned char*)d.dst + (size_t)(d.n0 + n) * d.K + d.k0 + 16 * c16) = w; }
    } else {
#pragma unroll
        for (int p = 0; p < 4; ++p) { const int n = 32 * p + (F.tid >> 4), c = F.tid & 15; const int pos = c ^ ((n >> 2) & 15);
            const u32x4 w = *(const LAS u32x4*)(O + n * 256 + pos * 16);
            *(u32x4*)(d.dst + (size_t)(d.n0 + n) * d.K + d.k0 + 8 * c) = w; }
    }
    if (d.bias) {
        __syncthreads();
        const int b = F.tid >> 7, n = F.tid & 127;
        float sum = 0.f;
#pragma unroll
        for (int w = 0; w < 8; ++w) sum += RED[(w * 4 + b) * 128 + n];
        fx_add(d.bias + (size_t)b * d.ldbias + d.n0 + n, (double)sum * FX_BIAS);
    }
}

constexpr int TR_IN = 960, TR_MQ = 48, TR_MKV = 32, TR_PA = 128, TR_PB = 128, TR_WO = 256, TR_UP = 1408, TR_DN = 704;
constexpr int TR_C1 = TR_IN, TR_C2 = TR_C1 + TR_MQ, TR_C3 = TR_C2 + TR_MKV, TR_C4 = TR_C3 + TR_PA, TR_C5 = TR_C4 + TR_PB, TR_C6 = TR_C5 + TR_WO, TR_C7 = TR_C6 + TR_UP, TR_C8 = TR_C7 + TR_DN;
__device__ __forceinline__ TileDesc tr_make(const Frame& F, const int l, const int r) {
    ArgsCP ap = F.a; unsigned char* ws = F.ws;
    const float* modl = (const float*)(ws + WS_MOD) + (size_t)l * NBATCH * NADA;
    fx64* bias_in = (fx64*)(ws + WS_BIAS); fx64* bias_up = (fx64*)(ws + WS_BIAS_UP);
    TileDesc d; d.shift = nullptr; d.bias = nullptr; d.gk = nullptr; d.ldbias = 0; d.mode = 0; d.w8 = 0.f;
    if (r < TR_C1) { const int ti = r; d.src = (const float*)ap->in[7] + (size_t)l * DM * IN_DIM; d.ldsrc = IN_DIM; d.K = DM; d.dst = (bf16_t*)(ws + WS_WIN + (size_t)l * NPROJ * DM); d.w8 = W8_SCALE; d.k0 = (ti / 60) * 128; d.n0 = (ti % 60) * 128; d.mode = 1; d.shift = modl; d.bias = bias_in + (size_t)l * NBATCH * NPROJ; d.ldbias = NPROJ; }
    else if (r < TR_C2) { const int ti = r - TR_C1; d.src = (const float*)ap->in[11] + (size_t)l * 512 * 1536; d.ldsrc = 1536; d.K = 512; d.dst = (bf16_t*)(ws + WS_WMQ) + (size_t)l * 1536 * 512; d.k0 = (ti / 12) * 128; d.n0 = (ti % 12) * 128; d.gk = (const float*)ap->in[10] + l * 512; }
    else if (r < TR_C3) { const int ti = r - TR_C2; d.src = (const float*)ap->in[13] + (size_t)l * 256 * 2048; d.ldsrc = 2048; d.K = 256; d.dst = (bf16_t*)(ws + WS_WMKV) + (size_t)l * 2048 * 256; d.k0 = (ti / 16) * 128; d.n0 = (ti % 16) * 128; d.gk = (const float*)ap->in[12] + l * 256; }
    else if (r < TR_C4) { const int ti = r - TR_C3; d.src = (const float*)ap->in[16] + (size_t)l * 1024 * 2048; d.ldsrc = 2048; d.K = 1024; d.dst = (bf16_t*)(ws + WS_WPAB) + (size_t)l * 4096 * 1024; d.k0 = (ti / 16) * 128; d.n0 = (ti % 16) * 128; }
    else if (r < TR_C5) { const int ti = r - TR_C4; d.src = (const float*)ap->in[17] + (size_t)l * 1024 * 2048; d.ldsrc = 2048; d.K = 1024; d.dst = (bf16_t*)(ws + WS_WPAB) + (size_t)l * 4096 * 1024 + (size_t)2048 * 1024; d.k0 = (ti / 16) * 128; d.n0 = (ti % 16) * 128; }
    else if (r < TR_C6) { const int ti = r - TR_C5; d.src = (const float*)ap->in[18] + (size_t)l * 2048 * 2048; d.ldsrc = 2048; d.K = 2048; d.dst = (bf16_t*)(ws + WS_WO) + (size_t)l * 2048 * 2048; d.k0 = (ti / 16) * 128; d.n0 = (ti % 16) * 128; }
    else if (r < TR_C7) { const int ti = r - TR_C6; d.src = (const float*)ap->in[19] + (size_t)l * DM * NUP; d.ldsrc = NUP; d.K = DM; d.dst = (bf16_t*)(ws + WS_WUP) + (size_t)l * NUP * DM; d.k0 = (ti / 88) * 128; d.n0 = (ti % 88) * 128; d.mode = 2; d.shift = modl + 3 * DM; d.bias = bias_up + (size_t)l * NBATCH * NUP; d.ldbias = NUP; }
    else { const int ti = r - TR_C7; d.src = (const float*)ap->in[22] + (size_t)l * DFF * DM; d.ldsrc = DM; d.K = DFF; d.dst = (bf16_t*)(ws + WS_WDN) + (size_t)l * DM * DFF; d.k0 = (ti / 16) * 128; d.n0 = (ti % 16) * 128; }
    return d;
}
template <class Map>
__device__ __forceinline__ void tr_run(const Frame& F, const int n, const Map& map) {
    int k = 0;
    bool hasA = 0 < n, hasB = 1 < n;
    TileDesc dA, dB; f32x4 vA[8], vB[8]; float sA = 0.f, sB = 0.f;
    if (hasA) { int l, r; map(0, l, r); dA = tr_make(F, l, r); tile_load(F, dA, vA, sA); }
    if (hasB) { int l, r; map(1, l, r); dB = tr_make(F, l, r); tile_load(F, dB, vB, sB); }
#pragma unroll 1
    while (hasA) {
        __syncthreads();
        tile_to_lds(F, dA, vA, sA);
        __syncthreads();
        { const TileDesc dc = dA; hasA = k + 2 < n; float pb[16]; tile_bias(F, dc, vA, pb);
          if (hasA) { int l, r; map(k + 2, l, r); dA = tr_make(F, l, r); tile_load(F, dA, vA, sA); }
          tile_finish(F, dc, pb); }
        if (!hasB) break;
        __syncthreads();
        tile_to_lds(F, dB, vB, sB);
        __syncthreads();
        { const TileDesc dc = dB; hasB = k + 3 < n; float pb[16]; tile_bias(F, dc, vB, pb);
          if (hasB) { int l, r; map(k + 3, l, r); dB = tr_make(F, l, r); tile_load(F, dB, vB, sB); }
          tile_finish(F, dc, pb); }
        k += 2;
    }
    __syncthreads();
}
constexpr int LATE_UP = 7, LATE_IN = 4;
__device__ __forceinline__ int late_up_tiles(int G) { const int rem = ((MROWS / 256) * (NUP / 256)) % G; if (rem == 0) return 0; const int t = (G - rem) * LATE_UP; return t < TR_UP ? t : TR_UP; }
__device__ __forceinline__ int late_in_tiles(int G) { const int rem = ((MROWS / 256) * (NPROJ / 256)) % G; if (rem == 0) return 0; const int t = (G - rem) * LATE_IN, left = TR_UP - late_up_tiles(G); return t < left ? t : left; }
struct TrMapPrologue { int bid, G, late;
    __device__ __forceinline__ void operator()(int k, int& l, int& r) const { const int j = bid + k * G, early = TR_C8 - late;
        if (j < TR_C8) { l = 0; r = j; } else { const int jj = j - TR_C8; l = 1 + jj / early; r = jj % early; if (r >= TR_C6) r += late; } } };
struct TrMapLate { int l1, first, stride;
    __device__ __forceinline__ void operator()(int k, int& l, int& r) const { l = l1; r = TR_C6 + first + k * stride; } };
__device__ __forceinline__ void tr_late(const Frame& F, int l1, int ntiles_phase, int base, int count, int per) {
    const int rem = ntiles_phase % F.G;
    if (rem == 0 || F.bid < rem || count <= 0) return;
    const int nshort = F.G - rem, first = F.bid - rem;
    int n = (count - first + nshort - 1) / nshort; if (n > per) n = per; if (n <= 0) return;
    const TrMapLate map{l1, base + first, nshort};
    tr_run(F, n, map);
}

__device__ __forceinline__ void p0a_prologue(const Frame& F) {
    ArgsCP ap = F.a;
    unsigned char* ws = F.ws;
    {
        LAS float* CAct = (LAS float*)F.lds;
        LAS float* RED = (LAS float*)(F.lds + 32768);
        const float* c = (const float*)ap->in[1];
        for (int i = F.tid; i < NBATCH * DM; i += 512) { const float x = c[i]; CAct[i] = x * sigmoidf_(x); }
        __syncthreads();
        const float* w_ada = (const float*)ap->in[5]; const float* b_ada = (const float*)ap->in[6];
        float* mod = (float*)(ws + WS_MOD);
        const int rg = F.lane >> 4, cq = F.lane & 15;
        for (int it = F.bid; it < DEPTH * (NADA / 64); it += F.G) {
            const int l = it / (NADA / 64), n0 = (it % (NADA / 64)) * 64;
            const float* wp = w_ada + (size_t)l * DM * NADA + n0 + 4 * cq;
            const int kb = F.wave * 256 + rg * 64;
            f32x4 acc[4];
#pragma unroll
            for (int b = 0; b < 4; ++b) acc[b] = (f32x4){0.f, 0.f, 0.f, 0.f};
            for (int i0 = 0; i0 < 64; i0 += 16) {
                f32x4 wv[16];
#pragma unroll
                for (int i = 0; i < 16; ++i) wv[i] = *(const f32x4*)(wp + (size_t)(kb + i0 + i) * NADA);
#pragma unroll
                for (int i = 0; i < 16; ++i) {
#pragma unroll
                    for (int b = 0; b < 4; ++b) acc[b] += CAct[b * DM + kb + i0 + i] * wv[i]; }
            }
#pragma unroll
            for (int b = 0; b < 4; ++b)
#pragma unroll
                for (int j = 0; j < 4; ++j) { float v = acc[b][j]; v += swz_xor<16>(v); v = pair32_sum(v); acc[b][j] = v; }
            if (rg == 0) {
#pragma unroll
                for (int b = 0; b < 4; ++b) *(LAS f32x4*)(RED + (F.wave * 4 + b) * 64 + 4 * cq) = acc[b]; }
            __syncthreads();
            if (F.tid < 256) { const int b = F.tid >> 6, col = F.tid & 63; float s = b_ada[(size_t)l * NADA + n0 + col];
#pragma unroll
                for (int w = 0; w < 8; ++w) s += RED[(w * 4 + b) * 64 + col];
                mod[((size_t)l * NBATCH + b) * NADA + n0 + col] = s; }
            __syncthreads();
        }
    }
    {
        const int* pos = (const int*)ap->in[2];
        float* CA = (float*)(ws + WS_ROPE); float* SA = CA + MROWS * 16; float* CI = SA + MROWS * 16; float* SI = CI + MROWS * 8; float* CM = SI + MROWS * 8; float* SM = CM + MROWS * 32;
        for (int i = F.bid * 512 + F.tid; i < MROWS * 56; i += F.G * 512) {
            const int r = i / 56, j = i % 56;
            const float p = (float)pos[r];
            float inv; float* cd; float* sd;
            if (j < 16) { inv = ap->inv_a[j]; cd = CA + r * 16 + j; sd = SA + r * 16 + j; }
            else if (j < 24) { inv = ap->inv_i[j - 16]; cd = CI + r * 8 + (j - 16); sd = SI + r * 8 + (j - 16); }
            else { inv = ap->inv_m[j - 24]; cd = CM + r * 32 + (j - 24); sd = SM + r * 32 + (j - 24); }
            const float ang = p * inv;
            float s, c; sincos_d((double)ang, s, c);
            *cd = c; *sd = s;
        }
    }
}

__device__ __forceinline__ void p0b_prologue(const Frame& F) {
    ArgsCP ap = F.a;
    unsigned char* ws = F.ws;
    const float* mod = (const float*)(ws + WS_MOD);
    {
        const float* x = (const float*)ap->in[0]; const float* g = (const float*)ap->in[3];
        unsigned char* h8 = ws + WS_H8; fx64* ssq = (fx64*)(ws + WS_SSQ);
        const int stride = F.G * 8;
        f32x4 gv[8];
#pragma unroll
        for (int i = 0; i < 8; ++i) gv[i] = *(const f32x4*)(g + (i * 64 + F.lane) * 4);
        for (int row0 = F.bid * 8 + F.wave; row0 < MROWS; row0 += 4 * stride) {
            f32x4 v[4][8];
#pragma unroll
            for (int k = 0; k < 4; ++k) { const int row = row0 + k * stride;
                if (row < MROWS) {
#pragma unroll
                    for (int i = 0; i < 8; ++i) v[k][i] = *(const f32x4*)(x + (size_t)row * DM + (i * 64 + F.lane) * 4); } }
#pragma unroll
            for (int k = 0; k < 4; ++k) { const int row = row0 + k * stride;
                if (row < MROWS) {
                    const float* mp = mod + (size_t)(row >> 11) * NADA + DM;
                    f32x4 sc[8];
#pragma unroll
                    for (int i = 0; i < 8; ++i) sc[i] = *(const f32x4*)(mp + (i * 64 + F.lane) * 4);
                    __builtin_amdgcn_sched_barrier(0);
                    float ss = 0.f;
#pragma unroll
                    for (int i = 0; i < 8; ++i) ss += v[k][i][0] * v[k][i][0] + v[k][i][1] * v[k][i][1] + v[k][i][2] * v[k][i][2] + v[k][i][3] * v[k][i][3];
                    ss = wave_sum(ss);
                    if (F.lane == 0) ssq[row] = (fx64)__builtin_rint((double)ss * (double)FX_SSQ);
#pragma unroll
                    for (int i = 0; i < 8; ++i) { const int c = (i * 64 + F.lane) * 4;
                        const f32x4 y = v[k][i] * gv[i] * (sc[i] + 1.0f);
                        *(unsigned*)(h8 + (size_t)row * DM + c) = cvt_fp8x4(y[0], y[1], y[2], y[3]); }
                } }
        }
    }
    {
        const int late = late_up_tiles(F.G) + late_in_tiles(F.G);
        const int NT = TR_C8 + (DEPTH - 1) * (TR_C8 - late);
        const TrMapPrologue map{F.bid, F.G, late};
        tr_run(F, (NT - F.bid + F.G - 1) / F.G, map);
        __syncthreads();
    }
}

__device__ __forceinline__ void phase_norm(const Frame& F, const float* x, const float* g, const float* modl  , int sh_off, int sc_off, bf16_t* h) {
    const int stride = F.G * 8;
    for (int row0 = F.bid * 8 + F.wave; row0 < MROWS; row0 += 4 * stride) {
        f32x4 v[4][8];
#pragma unroll
        for (int k = 0; k < 4; ++k) { const int row = row0 + k * stride;
            if (row < MROWS) {
#pragma unroll
                for (int i = 0; i < 8; ++i) v[k][i] = *(const f32x4*)(x + (size_t)row * DM + (i * 64 + F.lane) * 4); } }
#pragma unroll
        for (int k = 0; k < 4; ++k) { const int row = row0 + k * stride;
            if (row < MROWS) {
                const int b = row >> 11;
                float ss = 0.f;
#pragma unroll
                for (int i = 0; i < 8; ++i) ss += v[k][i][0] * v[k][i][0] + v[k][i][1] * v[k][i][1] + v[k][i][2] * v[k][i][2] + v[k][i][3] * v[k][i][3];
                ss = wave_sum(ss);
                const float rs = fast_rsq(ss * (1.0f / DM) + EPS);
                const float* mp = modl + (size_t)b * NADA;
#pragma unroll
                for (int i = 0; i < 8; ++i) { const int c = (i * 64 + F.lane) * 4;
                    const f32x4 gv = *(const f32x4*)(g + c), sc = *(const f32x4*)(mp + sc_off + c), sh = *(const f32x4*)(mp + sh_off + c);
                    const f32x4 y = (v[k][i] * rs) * gv * (sc + 1.0f) + sh;
                    u32x2 w; w.x = cvt_pk_bf16(y[0], y[1]); w.y = cvt_pk_bf16(y[2], y[3]);
                    *(u32x2*)(h + (size_t)row * DM + c) = w; }
            } }
    }
}

__device__ __forceinline__ void vt_load(const Frame& F, const bf16_t* src  , int lds_, u32x4& a0, u32x4& a1) {
    const int sl = F.tid >> 3, dq = F.tid & 7;
    a0 = *(const u32x4*)(src + (size_t)sl * lds_ + dq * 16); a1 = *(const u32x4*)(src + (size_t)sl * lds_ + dq * 16 + 8);
}
__device__ __forceinline__ void vt_finish(const Frame& F, const u32x4 a0, const u32x4 a1, bf16_t* dst  ) {
    LAS bf16_t* T = (LAS bf16_t*)F.lds;
    const int sl = F.tid >> 3, dq = F.tid & 7;
    __syncthreads();
    *(LAS u32x4*)(T + sl * 136 + dq * 16) = a0; *(LAS u32x4*)(T + sl * 136 + dq * 16 + 8) = a1;
    __syncthreads();
    const int d = F.tid >> 2, sq = F.tid & 3;
    unsigned w[8];
#pragma unroll
    for (int i = 0; i < 8; ++i) { const int p = 2 * i, sa = (p & 3) | ((p & 4) << 1) | ((p & 8) >> 1);
        const unsigned lo = T[(sq * 16 + sa) * 136 + d], hi = T[(sq * 16 + sa + 1) * 136 + d]; w[i] = lo | (hi << 16); }
    bf16_t* dp = dst + (size_t)d * SEQ + sq * 16;
    *(u32x4*)dp = (u32x4){w[0], w[1], w[2], w[3]}; *(u32x4*)(dp + 8) = (u32x4){w[4], w[5], w[6], w[7]};
}
__device__ __forceinline__ void vt_tile(const Frame& F, const bf16_t* src, int lds_, bf16_t* dst) { u32x4 a0, a1; vt_load(F, src, lds_, a0, a1); vt_finish(F, a0, a1, dst); }

__device__ __forceinline__ void phase_post1(const Frame& F, int l) {
    ArgsCP ap = F.a; unsigned char* ws = F.ws;
    const bf16_t* proj = (const bf16_t*)(ws + WS_PROJ);
    bf16_t* QA = (bf16_t*)(ws + WS_QA); bf16_t* KA = (bf16_t*)(ws + WS_KA); bf16_t* QI = (bf16_t*)(ws + WS_QI); bf16_t* KI = (bf16_t*)(ws + WS_KI);
    float* WI = (float*)(ws + WS_WI);
    const float* CA = (const float*)(ws + WS_ROPE); const float* SA = CA + MROWS * 16; const float* CI = SA + MROWS * 16; const float* SI = CI + MROWS * 8;
    const float* g_qa = (const float*)ap->in[8] + l * 128; const float* g_ka = (const float*)ap->in[9] + l * 128;
    const int L = F.lane;
    const float qscale = 0.08838834764831845f * LOG2E;
    const float gq0 = g_qa[2 * L], gq1 = g_qa[2 * L + 1], gk0 = g_ka[2 * L], gk1 = g_ka[2 * L + 1];
    const int Lh = L & 31;
#define P1_LOAD(R, r_) do { const int rr_ = (r_); const bf16_t* p = proj + (size_t)rr_ * NPROJ; \
        _Pragma("unroll") for (int hh = 0; hh < 10; ++hh) R.wqk[hh] = *(const unsigned*)(p + hh * 128 + 2 * L); \
        _Pragma("unroll") for (int ch = 0; ch < 9; ++ch) { R.wqi[ch] = 0u; if (ch < 8 || L < 32) R.wqi[ch] = *(const unsigned*)(p + PC_QI + ch * 128 + 2 * L); }       \
        R.c0 = 0.f; R.c1 = 0.f; R.s0 = 0.f; R.s1 = 0.f; \
        if (L < 16) { const int dd = 2 * (L & 7); R.c0 = CA[rr_ * 16 + dd]; R.c1 = CA[rr_ * 16 + dd + 1]; R.s0 = SA[rr_ * 16 + dd]; R.s1 = SA[rr_ * 16 + dd + 1]; } \
        R.ci0 = 0.f; R.ci1 = 0.f; R.si0 = 0.f; R.si1 = 0.f; \
        if (Lh < 8) { const int dd = 2 * (Lh & 3); R.ci0 = CI[rr_ * 8 + dd]; R.ci1 = CI[rr_ * 8 + dd + 1]; R.si0 = SI[rr_ * 8 + dd]; R.si1 = SI[rr_ * 8 + dd + 1]; } \
        R.wi = 0; if (L < 16) R.wi = p[PC_WI + L]; } while (0)
#define P1_ROW(R, r_) do { const int r = (r_); \
          \
        { const float c0 = R.c0, c1 = R.c1, s0 = R.s0, s1 = R.s1; \
        _Pragma("unroll") for (int hh = 0; hh < 10; ++hh) { \
            const unsigned w = R.wqk[hh]; \
            const float a0 = bf_lo(w), a1 = bf_hi(w); \
            const float ss = wave_sum(a0 * a0 + a1 * a1); \
            const float rs = fast_rsq(ss * (1.0f / 128.0f) + EPS); \
            float y0 = a0 * rs * (hh < 8 ? gq0 : gk0), y1 = a1 * rs * (hh < 8 ? gq1 : gk1); \
            const float o0 = swz_xor<8>(y0), o1 = swz_xor<8>(y1); \
            if (L < 8) { y0 = y0 * c0 - o0 * s0; y1 = y1 * c1 - o1 * s1; } \
            else if (L < 16) { y0 = y0 * c0 + o0 * s0; y1 = y1 * c1 + o1 * s1; } \
            if (hh < 8) *(unsigned*)(QA + (size_t)r * 1024 + hh * 128 + 2 * L) = cvt_pk_bf16(y0 * qscale, y1 * qscale); \
            else *(unsigned*)(KA + (size_t)r * 256 + (hh - 8) * 128 + 2 * L) = cvt_pk_bf16(y0, y1); \
        } } \
          \
        { const float ci0 = R.ci0, ci1 = R.ci1, si0 = R.si0, si1 = R.si1; \
        _Pragma("unroll") for (int ch = 0; ch < 9; ++ch) { \
            const unsigned w = R.wqi[ch]; \
            float y0 = bf_lo(w), y1 = bf_hi(w); \
            const float o0 = swz_xor<4>(y0), o1 = swz_xor<4>(y1); \
            if (Lh < 4) { y0 = y0 * ci0 - o0 * si0; y1 = y1 * ci1 - o1 * si1; } \
            else if (Lh < 8) { y0 = y0 * ci0 + o0 * si0; y1 = y1 * ci1 + o1 * si1; } \
              \
              \
            const int fo = (Lh >> 4) * 512 + (((Lh >> 2) & 3) * 16 + (r & 15)) * 8 + 2 * (Lh & 3); \
            if (ch < 8) *(unsigned*)(QI + (size_t)(r & ~15) * 1024 + (ch * 2 + (L >> 5)) * 1024 + fo) = cvt_pk_bf16(y0, y1); \
            else if (L < 32) *(unsigned*)(KI + (size_t)(r & ~15) * 64 + fo) = cvt_pk_bf16(y0, y1); \
        } } \
          \
        if (L < 16) WI[(size_t)r * 16 + L] = bf1(R.wi) * 0.03125f; \
        } while (0)
    {
        struct P1Row { unsigned wqk[10], wqi[9]; float c0, c1, s0, s1, ci0, ci1, si0, si1; bf16_t wi; };
        const int step = F.G * 8; int r0 = F.bid * 8 + F.wave;
        if (r0 < MROWS) {
            P1Row A, B;
            P1_LOAD(A, r0);
#pragma unroll 1
            for (;;) {
                const int rb = r0 + step; const bool hb = rb < MROWS;
                __builtin_amdgcn_sched_barrier(0);
                P1_LOAD(B, hb ? rb : r0);
                __builtin_amdgcn_sched_barrier(0);
                P1_ROW(A, r0);
                if (!hb) break;
                const int ra = rb + step; const bool ha = ra < MROWS;
                __builtin_amdgcn_sched_barrier(0);
                P1_LOAD(A, ha ? ra : rb);
                __builtin_amdgcn_sched_barrier(0);
                P1_ROW(B, rb);
                if (!ha) break;
                r0 = ra;
            }
        }
    }
#undef P1_LOAD
#undef P1_ROW
    bf16_t* VAT = (bf16_t*)(ws + WS_VAT);
    for (int it = F.bid; it < NBATCH * 2 * (SEQ / 64); it += F.G) {
        const int sb = it % (SEQ / 64), g = (it / (SEQ / 64)) & 1, b = it / (2 * (SEQ / 64));
        vt_tile(F, proj + (size_t)(b * SEQ + sb * 64) * NPROJ + PC_VA + g * 128, NPROJ, VAT + (size_t)(b * 2 + g) * 128 * SEQ + sb * 64);
    }
    __syncthreads();
}

__device__ __forceinline__ void phase_post2(const Frame& F, int l) {
    ArgsCP ap = F.a; unsigned char* ws = F.ws;
    const bf16_t* proj = (const bf16_t*)(ws + WS_PROJ); const bf16_t* MQ = (const bf16_t*)(ws + WS_MQ); const bf16_t* MKV = (const bf16_t*)(ws + WS_MKV);
    bf16_t* QM = (bf16_t*)(ws + WS_QM); bf16_t* KM = (bf16_t*)(ws + WS_KM);
    const float* CM = (const float*)(ws + WS_ROPE) + MROWS * 48; const float* SM = CM + MROWS * 32;
    const float* g_qm = (const float*)ap->in[14] + l * 192; const float* g_km = (const float*)ap->in[15] + l * 192;
    const int L = F.lane;
    const float qscale = 0.07216878364870322f * LOG2E;
    const int Lr = L & 31, Lc = L & 15;
    const float gqn0 = g_qm[2 * L], gqn1 = g_qm[2 * L + 1], gqr0 = g_qm[128 + 2 * Lr], gqr1 = g_qm[128 + 2 * Lr + 1];
    const float gkn0 = g_km[2 * L], gkn1 = g_km[2 * L + 1], gkr0 = g_km[128 + 2 * Lr], gkr1 = g_km[128 + 2 * Lr + 1];
#define P2_LOAD(R, r_) do { const int rr_ = (r_); \
        R.c0 = CM[rr_ * 32 + 2 * Lc]; R.c1 = CM[rr_ * 32 + 2 * Lc + 1]; R.s0 = SM[rr_ * 32 + 2 * Lc]; R.s1 = SM[rr_ * 32 + 2 * Lc + 1]; \
        R.kr = *(const unsigned*)(proj + (size_t)rr_ * NPROJ + PC_MKR + 2 * Lr); \
        _Pragma("unroll") for (int h = 0; h < 8; ++h) { const bf16_t* qp = MQ + (size_t)rr_ * 1536 + h * 192; const bf16_t* kp = MKV + (size_t)rr_ * 2048 + h * 256; \
            R.qn[h] = *(const unsigned*)(qp + 2 * L); R.qr[h] = *(const unsigned*)(qp + 128 + 2 * Lr); R.kn[h] = *(const unsigned*)(kp + 2 * L); } } while (0)
#define P2_HEAD(wn_, wr_, gn0_, gn1_, gr0_, gr1_, sc_, dst_) do { \
        const float a0 = bf_lo(wn_), a1 = bf_hi(wn_); const float b0 = (L < 32) ? bf_lo(wr_) : 0.f, b1 = (L < 32) ? bf_hi(wr_) : 0.f; \
        const float ss = wave_sum(a0 * a0 + a1 * a1 + b0 * b0 + b1 * b1); \
        const float rs = fast_rsq(ss * (1.0f / 192.0f) + EPS); \
        const float y0 = a0 * rs * gn0_, y1 = a1 * rs * gn1_; float z0 = b0 * rs * gr0_, z1 = b1 * rs * gr1_; \
        const float o0 = swz_xor<16>(z0), o1 = swz_xor<16>(z1); \
        if (L < 16) { z0 = z0 * c0 - o0 * s0; z1 = z1 * c1 - o1 * s1; } else { z0 = z0 * c0 + o0 * s0; z1 = z1 * c1 + o1 * s1; } \
        bf16_t* dp = (dst_); \
        *(unsigned*)(dp + 2 * L) = cvt_pk_bf16(y0 * (sc_), y1 * (sc_)); \
        if (L < 32) *(unsigned*)(dp + 128 + 2 * L) = cvt_pk_bf16(z0 * (sc_), z1 * (sc_)); } while (0)
#define P2_ROW(R, r_) do { const int r = (r_); const float c0 = R.c0, c1 = R.c1, s0 = R.s0, s1 = R.s1; \
        _Pragma("unroll") for (int h = 0; h < 8; ++h) { \
            P2_HEAD(R.qn[h], R.qr[h], gqn0, gqn1, gqr0, gqr1, qscale, QM + (size_t)r * 1536 + h * 192);            \
            P2_HEAD(R.kn[h], R.kr, gkn0, gkn1, gkr0, gkr1, 1.0f, KM + (size_t)r * 1536 + h * 192);                  \
        } } while (0)
    {
        struct P2Row { unsigned qn[8], qr[8], kn[8]; unsigned kr; float c0, c1, s0, s1; };
        const int step = F.G * 8; int r0 = F.bid * 8 + F.wave;
        if (r0 < MROWS) {
            P2Row A, B;
            P2_LOAD(A, r0);
#pragma unroll 1
            for (;;) {
                const int rb = r0 + step; const bool hb = rb < MROWS;
                __builtin_amdgcn_sched_barrier(0);
                P2_LOAD(B, hb ? rb : r0);
                __builtin_amdgcn_sched_barrier(0);
                P2_ROW(A, r0);
                if (!hb) break;
                const int ra = rb + step; const bool ha = ra < MROWS;
                __builtin_amdgcn_sched_barrier(0);
                P2_LOAD(A, ha ? ra : rb);
                __builtin_amdgcn_sched_barrier(0);
                P2_ROW(B, rb);
                if (!ha) break;
                r0 = ra;
            }
        }
    }
#undef P2_LOAD
#undef P2_HEAD
#undef P2_ROW
    bf16_t* VMT = (bf16_t*)(ws + WS_VMT);
    {
        constexpr int NVT = NBATCH * 8 * (SEQ / 64);
#define VMT_SRC(it_) (MKV + (size_t)(((it_) / (8 * (SEQ / 64))) * SEQ + ((it_) % (SEQ / 64)) * 64) * 2048 + (((it_) / (SEQ / 64)) & 7) * 256 + 128)
        int it = F.bid;
        if (it < NVT) {
            u32x4 a0, a1; vt_load(F, VMT_SRC(it), 2048, a0, a1);
#pragma unroll 1
            for (; it < NVT; it += F.G) {
                const int nx = (it + F.G < NVT) ? it + F.G : it;
                u32x4 n0, n1; vt_load(F, VMT_SRC(nx), 2048, n0, n1);
                const int sb = it % (SEQ / 64), h = (it / (SEQ / 64)) & 7, b = it / (8 * (SEQ / 64));
                vt_finish(F, a0, a1, VMT + (size_t)(b * 8 + h) * 128 * SEQ + sb * 64);
                a0 = n0; a1 = n1;
            }
        }
#undef VMT_SRC
    }
    __syncthreads();
}

__device__ __forceinline__ float fma_scalar(float a, float b, float c) { float d; asm("v_fma_f32 %0, %1, %2, %3" : "=v"(d) : "v"(a), "v"(b), "v"(c)); return d; }
constexpr int SC_STRIDE = 2052, RD = 4;
template <int NJ>
__device__ __forceinline__ void idx_select(const Frame& F, LAS float* SC, const int t0, const size_t row0, unsigned* MASK) {
    const int L = F.lane;
    {
        const int qrA = F.wave * 2, qrB = qrA + 1, tA = t0 + qrA, tB = t0 + qrB;
        unsigned keyA[NJ], keyB[NJ];
#pragma unroll
        for (int j = 0; j < NJ; ++j) { const int s = j * 64 + L;
            unsigned ua = __float_as_uint(SC[qrA * SC_STRIDE + s]), ub = __float_as_uint(SC[qrB * SC_STRIDE + s]);
            ua = (ua & 0x80000000u) ? ~ua : (ua | 0x80000000u); ub = (ub & 0x80000000u) ? ~ub : (ub | 0x80000000u);
            keyA[j] = (s <= tA) ? ua : 0u; keyB[j] = (s <= tB) ? ub : 0u; }
#define IDX_WAVE_TOTAL(c) (c += __builtin_amdgcn_update_dpp(0, c, 0x128, 0xf, 0xf, true), c += __builtin_amdgcn_update_dpp(0, c, 0x124, 0xf, 0xf, true), c += __builtin_amdgcn_update_dpp(0, c, 0x122, 0xf, 0xf, true), \
        c += __builtin_amdgcn_update_dpp(0, c, 0x121, 0xf, 0xf, true), __builtin_amdgcn_readlane(c, 0) + __builtin_amdgcn_readlane(c, 16) + __builtin_amdgcn_readlane(c, 32) + __builtin_amdgcn_readlane(c, 48))
        unsigned TA = 1u, TB = 1u; bool actA = (tA >= 256), actB = (tB >= 256);
        if (actA) TA = 0u;
        if (actB) TB = 0u;
#pragma unroll 1
        for (int bit = 31; bit >= 0 && (actA || actB); --bit) {
            const unsigned cA = __builtin_amdgcn_readfirstlane(TA | (1u << bit)), cB = __builtin_amdgcn_readfirstlane(TB | (1u << bit));
            int nA = 0, nB = 0;
#pragma unroll
            for (int j = 0; j < NJ; ++j) { nA += (keyA[j] >= cA) ? 1 : 0; nB += (keyB[j] >= cB) ? 1 : 0; }
            const int totA = IDX_WAVE_TOTAL(nA), totB = IDX_WAVE_TOTAL(nB);
            if (actA) { if (totA >= 256) TA = cA; if (totA == 256) actA = false; }
            if (actB) { if (totB >= 256) TB = cB; if (totB == 256) actB = false; }
        }
#pragma unroll 1
        for (int qq = 0; qq < 2; ++qq) {
            const unsigned T = qq ? TB : TA; const int t = qq ? tB : tA, qr = qq ? qrB : qrA;
            int need = 1 << 30;
            if (t >= 256) { int gt = 0;
#pragma unroll
                for (int j = 0; j < NJ; ++j) gt += __builtin_popcountll(__ballot((qq ? keyB[j] : keyA[j]) > T));
                need = 256 - gt; }
            int run = 0; unsigned long long mymask = 0ull;
#pragma unroll
            for (int j = 0; j < NJ; ++j) {
                const unsigned kj = qq ? keyB[j] : keyA[j];
                const unsigned long long eq = __ballot(kj == T);
                const int rank = run + (int)__builtin_amdgcn_mbcnt_hi((unsigned)(eq >> 32), __builtin_amdgcn_mbcnt_lo((unsigned)eq, 0u));
                const bool sel = (kj > T) || (kj == T && rank < need);
                run += __builtin_popcountll(eq);
                const unsigned long long m = __ballot(sel);
                if (L == j) mymask = m;
            }
            if (L < 32) *(unsigned long long*)(MASK + (row0 + qr) * 64 + 2 * L) = mymask;
        }
#undef IDX_WAVE_TOTAL
    }
}
__device__ __forceinline__ void idx_unit(const Frame& F, int b, int tb) {
    unsigned char* ws = F.ws;
    const bf16_t* QI = (const bf16_t*)(ws + WS_QI); const bf16_t* KI = (const bf16_t*)(ws + WS_KI); const float* WI = (const float*)(ws + WS_WI);
    unsigned* MASK = (unsigned*)(ws + WS_MASK);
    LAS float* SC = (LAS float*)F.lds;
    const int L = F.lane, q = L & 15, hq = L >> 4;
    const int t0 = tb * 16; const size_t row0 = (size_t)b * SEQ + t0;
    __syncthreads();
    const int nkt = tb + 1;
    const bf16_t* kbase = KI + (size_t)b * SEQ * 64 + L * 8;
    const int nmy = (nkt - F.wave + 7) >> 3;
#ifndef IDX_REP_SCORE
#define IDX_REP_SCORE 1
#endif
#ifndef IDX_REP_SEL
#define IDX_REP_SEL 1
#endif
#pragma unroll 1
    for (int hp = 0; hp < IDX_REP_SCORE; ++hp) {
        bf16x8 qf[16][2]; float wv[16];
#pragma unroll
        for (int hh = 0; hh < 16; ++hh) {
#pragma unroll
            for (int ks = 0; ks < 2; ++ks) qf[hh][ks] = *(const bf16x8*)(QI + row0 * 1024 + hh * 1024 + ks * 512 + L * 8); }
        {
#pragma unroll
          for (int k4 = 0; k4 < 4; ++k4) { const f32x4 w0 = *(const f32x4*)(WI + (row0 + q) * 16 + 4 * k4); wv[4 * k4 + 0] = w0[0]; wv[4 * k4 + 1] = w0[1]; wv[4 * k4 + 2] = w0[2]; wv[4 * k4 + 3] = w0[3]; } }
        __builtin_amdgcn_sched_barrier(0);
        if (nmy > 0) {
            const int lastk = nmy - 1;
            bf16x8 kr[RD][2];
#pragma unroll
            for (int s8 = 0; s8 < RD; ++s8) { const int ic = s8 < lastk ? s8 : lastk; const bf16_t* kp = kbase + (size_t)(F.wave + 8 * ic) * 16 * 64; kr[s8][0] = *(const bf16x8*)kp; kr[s8][1] = *(const bf16x8*)(kp + 512); }
#pragma unroll 1
            for (int base = 0; base < nmy; base += RD) {
#pragma unroll
                for (int s8 = 0; s8 < RD; ++s8) {
                    const int i = base + s8;
                    if (i < nmy) {
                        const int kt = F.wave + 8 * i;
                        LAS f32x4* sp = (LAS f32x4*)(SC + q * SC_STRIDE + kt * 16 + 4 * hq);
                        f32x4 sc = (f32x4){0.f, 0.f, 0.f, 0.f};
#pragma unroll
                        for (int hh = 0; hh < 16; ++hh) {
                            f32x4 d = __builtin_amdgcn_mfma_f32_16x16x32_bf16(kr[s8][0], qf[hh][0], (f32x4){0.f, 0.f, 0.f, 0.f}, 0, 0, 0);
                            d = __builtin_amdgcn_mfma_f32_16x16x32_bf16(kr[s8][1], qf[hh][1], d, 0, 0, 0);
#pragma unroll
                            for (int j = 0; j < 4; ++j) { const int di = __float_as_int(d[j]); sc[j] = fma_scalar(wv[hh], __int_as_float(di > 0 ? di : 0), sc[j]); }
                        }
                        *sp = sc;
                    }
                    __builtin_amdgcn_sched_barrier(0);
                    { const int ic = (i + RD) < lastk ? (i + RD) : lastk; const bf16_t* kp = kbase + (size_t)(F.wave + 8 * ic) * 16 * 64; kr[s8][0] = *(const bf16x8*)kp; kr[s8][1] = *(const bf16x8*)(kp + 512); }
                    __builtin_amdgcn_sched_barrier(0);
                }
            }
        }
    }
    __syncthreads();
    {
        const int njv = (t0 + 16 + 63) >> 6;
        if (njv <= 8) idx_select<8>(F, SC, t0, row0, MASK);
        else if (njv <= 16) idx_select<16>(F, SC, t0, row0, MASK);
        else if (njv <= 24) idx_select<24>(F, SC, t0, row0, MASK);
        else idx_select<32>(F, SC, t0, row0, MASK);
    }
}
__device__ __forceinline__ void phase_idx(const Frame& F) {
    for (int u = F.bid; u < 256; u += F.G) { const int b = u >> 6, i = u & 63; idx_unit(F, b, i); idx_unit(F, b, 127 - i); }
    __syncthreads();
}

#ifndef ATT_PROBE
#define ATT_PROBE 0
#endif
#ifndef ATT_PROBE_OFS
#define ATT_PROBE_OFS 0
#endif
#ifndef ATT_PROBE_BID
#define ATT_PROBE_BID 0
#endif
#ifndef ATT_PROBE_TID
#define ATT_PROBE_TID 0
#endif
template <int DQK, bool DSA>
__device__ __forceinline__ void attn_unit(const Frame& F, const bf16_t* Q, int ldq, const bf16_t* Kg, int ldk, const bf16_t* Vt, const unsigned* maskb, bf16_t* O, int ldo, int q0) {
    constexpr int NST = DQK / 16;
    constexpr int KA_BYTES = 64 * 256, KB_BYTES = (DQK == 192) ? 64 * 128 : 0, V_OFF = KA_BYTES + KB_BYTES, STAGE = V_OFF + 128 * 128;
    static_assert(3 * STAGE <= 131072, "three attention stages fit the phase scratch");
    int L = F.lane; asm volatile("" : "+v"(L));
    const int r = L & 31, hf = L >> 5, w = F.wave;
    const int qw0 = q0 + 32 * w, tq = qw0 + r;
    const int ntiles = (q0 + 256) / 64;
    const int lkA = r * 256 + ((((r & 15) ^ hf)) << 4), lkB = r * 128 + ((hf ^ ((r >> 1) & 7)) << 4);
#define ATT_KADDR(sbo, kh, st) (((st) < 8) ? (F.lds + (((sbo) + (kh) * 8192 + lkA) ^ ((st) << 5))) : (F.lds + (((sbo) + KA_BYTES + (kh) * 4096 + lkB) ^ ((2 * (st) - 16) << 4))))
#define ATT_VADDR(sbo, kh, s2, dt) (F.lds + ((((sbo) + V_OFF + lkB) ^ ((4 * (kh) + 2 * (s2)) << 4)) + (dt) * 4096))
    auto issue = [&](int kt, int buf) {
        int Li = L; asm volatile("" : "+v"(Li));
        LAS unsigned char* sb = F.lds + buf * STAGE;
        const char* kb = (const char*)Kg + (size_t)kt * 64 * ldk * 2; const char* vb = (const char*)Vt + (size_t)kt * 128;
#pragma unroll
        for (int i = 0; i < 2; ++i) { const int chunk = w + 8 * i, row = chunk * 4 + (Li >> 4), slot = Li & 15, piece = slot ^ (row & 15);
            __builtin_amdgcn_global_load_lds((const unsigned*)(kb + (unsigned)(row * ldk + piece * 8) * 2u), (LAS unsigned*)(sb + chunk * 1024), 16, 0, 0); }
        if (DQK == 192) { const int row = w * 8 + (Li >> 3), slot = Li & 7, piece = 16 + (slot ^ ((row >> 1) & 7));
            __builtin_amdgcn_global_load_lds((const unsigned*)(kb + (unsigned)(row * ldk + piece * 8) * 2u), (LAS unsigned*)(sb + KA_BYTES + w * 1024), 16, 0, 0); }
#pragma unroll
        for (int i = 0; i < 2; ++i) { const int chunk = w + 8 * i, row = chunk * 8 + (Li >> 3), slot = Li & 7, piece = slot ^ ((row >> 1) & 7);
            __builtin_amdgcn_global_load_lds((const unsigned*)(vb + (unsigned)(row * SEQ + piece * 8) * 2u), (LAS unsigned*)(sb + V_OFF + chunk * 1024), 16, 0, 0); }
    };
    bf16x8 qf[NST];
    f32x16 oacc[4];
    f32x16 sacc[2];
    float lsum = 0.f;
    f32x16 negm;
#pragma unroll
    for (int i = 0; i < 16; ++i) negm[i] = 0.f;
    constexpr int PFD = 4;
#define ATT_QK(sbo) do { \
        _Pragma("unroll") for (int kh = 0; kh < 2; ++kh) { \
            sacc[kh] = negm; \
            _Pragma("unroll") for (int st = 0; st < NST; ++st) \
                sacc[kh] = __builtin_amdgcn_mfma_f32_32x32x16_bf16(*(const LAS bf16x8*)ATT_KADDR(sbo, kh, st), qf[st], sacc[kh], 0, 0, 0); } \
        __builtin_amdgcn_sched_group_barrier(0x100, PFD, 0); \
        _Pragma("unroll") for (int x = 0; x < 2 * NST - PFD; ++x) { __builtin_amdgcn_sched_group_barrier(0x008, 1, 0); __builtin_amdgcn_sched_group_barrier(0x100, 1, 0); } \
        __builtin_amdgcn_sched_group_barrier(0x008, PFD, 0); } while (0)

    __syncthreads();
#if ATT_PROBE
    unsigned long long pr_t0 = __builtin_amdgcn_s_memtime(), pr_w = 0ull; unsigned pr_n = 0u;
#endif
    u32x2 mw = (u32x2){0u, 0u};
    if (DSA) mw = *(const u32x2*)(maskb + (size_t)tq * 64);
    issue(0, 0);
    if (ntiles > 1) issue(1, 1);
#pragma unroll
    for (int st = 0; st < NST; ++st) qf[st] = *(const bf16x8*)(Q + (size_t)tq * ldq + st * 16 + hf * 8);
#pragma unroll
    for (int dt = 0; dt < 4; ++dt)
#pragma unroll
        for (int i = 0; i < 16; ++i) oacc[dt][i] = 0.f;
    asm volatile("s_waitcnt vmcnt(0)" ::: "memory");
    __syncthreads();
    const bool late = (w >= 4);
    const int wlim = (qw0 + 31) >> 6;
    if (late) ATT_QK(0);
#pragma clang loop unroll(disable)
    for (int kt = 0; kt < ntiles; ++kt) {
#if ATT_PROBE
        const unsigned long long pr_a = __builtin_amdgcn_s_memtime();
#endif
        if (kt > 0) {
#if ATT_PROBE == 2
            __syncthreads();
#else
            asm volatile("s_waitcnt vmcnt(0)" ::: "memory");
#endif
#if ATT_PROBE
            const unsigned long long pr_b = __builtin_amdgcn_s_memtime(); pr_w += pr_b - pr_a;
#endif
#if ATT_PROBE == 2
            asm volatile("s_waitcnt vmcnt(0)" ::: "memory");
#else
            __syncthreads();
#endif
        }
        const u32x2 mcur = mw;
        if (DSA && kt + 1 < ntiles) mw = *(const u32x2*)(maskb + (size_t)tq * 64 + (kt + 1) * 2);
        if (kt + 2 < ntiles) issue(kt + 2, (kt + 2) % 3);
        const int sbc = (kt % 3) * STAGE;
#if ATT_PROBE == 5
        __builtin_amdgcn_sched_barrier(0); const unsigned long long pr_q = __builtin_amdgcn_s_memtime(); __builtin_amdgcn_sched_barrier(0);
#endif
        if (!late && kt <= wlim) ATT_QK(sbc);
#if ATT_PROBE == 5
        if (!late && kt <= wlim) { __builtin_amdgcn_sched_barrier(0); asm volatile("" :: "v"(sacc[1][15])); pr_w += __builtin_amdgcn_s_memtime() - pr_q; pr_n += 1; __builtin_amdgcn_sched_barrier(0); }
#endif
        if (kt <= wlim) {
            if (!DSA && kt * 64 + 63 > qw0) { const int lim = tq - kt * 64 - 4 * hf;
#pragma unroll
                for (int i = 0; i < 16; ++i) { const int ko = (i & 3) + 8 * (i >> 2);
                    sacc[0][i] = (ko <= lim) ? sacc[0][i] : -INFINITY; sacc[1][i] = (ko + 32 <= lim) ? sacc[1][i] : -INFINITY; } }
#if ATT_PROBE == 3
            __builtin_amdgcn_sched_barrier(0); const unsigned long long pr_c = __builtin_amdgcn_s_memtime(); __builtin_amdgcn_sched_barrier(0);
#endif
            float mx = sacc[0][0];
#pragma unroll
            for (int i = 1; i < 16; ++i) mx = fmaxf(mx, sacc[0][i]);
#pragma unroll
            for (int i = 0; i < 16; ++i) mx = fmaxf(mx, sacc[1][i]);
            mx = pair32_max(mx);
            const bool grew = (kt == 0) || (mx > 8.0f);
            if (__builtin_amdgcn_ballot_w64(grew) != 0ull) {
                const float d = grew ? mx : 0.f;
                const float alpha = (kt == 0) ? 0.f : fast_exp2(-d);
#pragma unroll
                for (int i = 0; i < 16; ++i) { sacc[0][i] -= d; sacc[1][i] -= d; negm[i] -= d; }
                lsum *= alpha;
#pragma unroll
                for (int dt = 0; dt < 4; ++dt)
#pragma unroll
                    for (int i = 0; i < 16; ++i) oacc[dt][i] *= alpha;
            }
            float ps = 0.f;
            if (DSA) {
                const unsigned m0 = mcur.x >> (4 * hf), m1 = mcur.y >> (4 * hf);
#pragma unroll
                for (int i = 0; i < 16; ++i) { const int kb = (i & 3) + 8 * (i >> 2);
                    const float p0 = __int_as_float(__float_as_int(fast_exp2(sacc[0][i])) & __builtin_amdgcn_sbfe((int)m0, kb, 1)), p1 = __int_as_float(__float_as_int(fast_exp2(sacc[1][i])) & __builtin_amdgcn_sbfe((int)m1, kb, 1));
                    sacc[0][i] = p0; sacc[1][i] = p1; ps += p0 + p1; }
            } else {
#pragma unroll
                for (int kh = 0; kh < 2; ++kh)
#pragma unroll
                    for (int i = 0; i < 16; ++i) { const float pv = fast_exp2(sacc[kh][i]); sacc[kh][i] = pv; ps += pv; }
            }
            lsum += ps;
            bf16x8 pf[2][2];
#pragma unroll
            for (int kh = 0; kh < 2; ++kh)
#pragma unroll
                for (int s2 = 0; s2 < 2; ++s2) { u32x4 pw;
                    pw.x = cvt_pk_bf16(sacc[kh][8 * s2 + 0], sacc[kh][8 * s2 + 1]); pw.y = cvt_pk_bf16(sacc[kh][8 * s2 + 2], sacc[kh][8 * s2 + 3]);
                    pw.z = cvt_pk_bf16(sacc[kh][8 * s2 + 4], sacc[kh][8 * s2 + 5]); pw.w = cvt_pk_bf16(sacc[kh][8 * s2 + 6], sacc[kh][8 * s2 + 7]);
                    pf[kh][s2] = __builtin_bit_cast(bf16x8, pw); }
#if ATT_PROBE == 3
            __builtin_amdgcn_sched_barrier(0); asm volatile("" :: "v"(pf[1][1])); pr_w += __builtin_amdgcn_s_memtime() - pr_c; __builtin_amdgcn_sched_barrier(0);
#endif
#pragma unroll
            for (int dt = 0; dt < 4; ++dt)
#pragma unroll
                for (int kh = 0; kh < 2; ++kh)
#pragma unroll
                    for (int s2 = 0; s2 < 2; ++s2)
                        oacc[dt] = __builtin_amdgcn_mfma_f32_32x32x16_bf16(*(const LAS bf16x8*)ATT_VADDR(sbc, kh, s2, dt), pf[kh][s2], oacc[dt], 0, 0, 0);
            __builtin_amdgcn_sched_group_barrier(0x100, PFD, 1);
#pragma unroll
            for (int x = 0; x < 16 - PFD; ++x) { __builtin_amdgcn_sched_group_barrier(0x008, 1, 1); __builtin_amdgcn_sched_group_barrier(0x100, 1, 1); }
            __builtin_amdgcn_sched_group_barrier(0x008, PFD, 1);
        }
        if (late && kt + 1 <= wlim) ATT_QK(((kt + 1) % 3) * STAGE);
    }
#undef ATT_QK
#undef ATT_KADDR
#undef ATT_VADDR
#if ATT_PROBE
    if (F.tid == ATT_PROBE_TID) { volatile LAS unsigned* MS = (volatile LAS unsigned*)(F.lds + LDS_MISC); MS[4] += (unsigned)pr_w; MS[5] += (unsigned)(__builtin_amdgcn_s_memtime() - pr_t0); MS[6] += pr_n; }
#endif
    __builtin_amdgcn_s_setprio(0);
    const float ltot = pair32_sum(lsum);
    const float inv = fast_rcp(ltot);
    bf16_t* op = O + (size_t)tq * ldo + 4 * hf;
#pragma unroll
    for (int dt = 0; dt < 4; ++dt)
#pragma unroll
        for (int g4 = 0; g4 < 4; ++g4) { u32x2 ow; ow.x = cvt_pk_bf16(oacc[dt][4 * g4 + 0] * inv, oacc[dt][4 * g4 + 1] * inv); ow.y = cvt_pk_bf16(oacc[dt][4 * g4 + 2] * inv, oacc[dt][4 * g4 + 3] * inv);
            *(u32x2*)(op + dt * 32 + g4 * 8) = ow; }
}

#ifndef ATT_ENABLE_MLA
#define ATT_ENABLE_MLA 1
#endif
#ifndef ATT_ENABLE_DSA
#define ATT_ENABLE_DSA 1
#endif
__device__ __forceinline__ void phase_attn(const Frame& F) {
    unsigned char* ws = F.ws;
    const bf16_t* QA = (const bf16_t*)(ws + WS_QA); const bf16_t* KA = (const bf16_t*)(ws + WS_KA); const bf16_t* VAT = (const bf16_t*)(ws + WS_VAT);
    const bf16_t* QM = (const bf16_t*)(ws + WS_QM); const bf16_t* KM = (const bf16_t*)(ws + WS_KM); const bf16_t* VMT = (const bf16_t*)(ws + WS_VMT);
    const unsigned* MASK = (const unsigned*)(ws + WS_MASK); bf16_t* OAB = (bf16_t*)(ws + WS_OAB);
    for (int u0 = F.bid; u0 < 256; u0 += F.G) {
        const int u = (F.G == 256) ? ((u0 & 7) * 32 + (u0 >> 3)) : u0;
        const int b = u >> 6, h = (u >> 3) & 7, qb = u & 7;
        const size_t rb = (size_t)b * SEQ;
        if (ATT_ENABLE_DSA) attn_unit<128, true>(F, QA + rb * 1024 + h * 128, 1024, KA + rb * 256 + (h >> 2) * 128, 256, VAT + (size_t)(b * 2 + (h >> 2)) * 128 * SEQ, MASK + rb * 64, OAB + rb * DM + h * 128, DM, qb * 256);
        if (ATT_ENABLE_MLA) attn_unit<192, false>(F, QM + rb * 1536 + h * 192, 1536, KM + rb * 1536 + h * 192, 1536, VMT + (size_t)(b * 8 + h) * 128 * SEQ, nullptr, OAB + rb * DM + 1024 + h * 128, DM, (7 - qb) * 256);
    }
    __syncthreads();
}

__device__ __forceinline__ void phase_conv(const Frame& F, int l) {
    ArgsCP ap = F.a; unsigned char* ws = F.ws;
    const bf16_t* U = (const bf16_t*)(ws + WS_U); bf16_t* ACT = (bf16_t*)(ws + WS_ACT);
    const float* wconv = (const float*)ap->in[20] + (size_t)l * 3 * NUP; const float* bconv = (const float*)ap->in[21] + (size_t)l * NUP;
    const int cg = F.tid & 15, rs = F.tid >> 4;
    for (int it = F.bid; it < 32 * 44; it += F.G) {
        const int j = it % 44, pm = it / 44;
        const int ch = 128 * j + 8 * cg;
        const int row0 = pm * 256 + rs * 8;
        float wg[3][8], wvv[3][8], bg[8], bv[8];
#pragma unroll
        for (int k = 0; k < 3; ++k) { const f32x4 x0 = *(const f32x4*)(wconv + (size_t)k * NUP + ch), x1 = *(const f32x4*)(wconv + (size_t)k * NUP + ch + 4), y0 = *(const f32x4*)(wconv + (size_t)k * NUP + DFF + ch), y1 = *(const f32x4*)(wconv + (size_t)k * NUP + DFF + ch + 4);
#pragma unroll
            for (int e = 0; e < 4; ++e) { wg[k][e] = x0[e]; wg[k][4 + e] = x1[e]; wvv[k][e] = y0[e]; wvv[k][4 + e] = y1[e]; } }
        { const f32x4 x0 = *(const f32x4*)(bconv + ch), x1 = *(const f32x4*)(bconv + ch + 4), y0 = *(const f32x4*)(bconv + DFF + ch), y1 = *(const f32x4*)(bconv + DFF + ch + 4);
#pragma unroll
            for (int e = 0; e < 4; ++e) { bg[e] = x0[e]; bg[4 + e] = x1[e]; bv[e] = y0[e]; bv[4 + e] = y1[e]; } }
        const bf16_t* up = U + (size_t)row0 * NUP + 256 * j + 8 * cg;
        float g2[8], g1[8], v2[8], v1[8];
        const bool has_prev = (row0 & (SEQ - 1)) != 0;
#pragma unroll
        for (int e = 0; e < 8; ++e) { g2[e] = 0.f; g1[e] = 0.f; v2[e] = 0.f; v1[e] = 0.f; }
        if (has_prev) {
            const u32x4 a2 = *(const u32x4*)(up - 2 * (size_t)NUP), a1 = *(const u32x4*)(up - (size_t)NUP), c2 = *(const u32x4*)(up - 2 * (size_t)NUP + 128), c1 = *(const u32x4*)(up - (size_t)NUP + 128);
            g2[0] = bf_lo(a2.x); g2[1] = bf_hi(a2.x); g2[2] = bf_lo(a2.y); g2[3] = bf_hi(a2.y); g2[4] = bf_lo(a2.z); g2[5] = bf_hi(a2.z); g2[6] = bf_lo(a2.w); g2[7] = bf_hi(a2.w);
            g1[0] = bf_lo(a1.x); g1[1] = bf_hi(a1.x); g1[2] = bf_lo(a1.y); g1[3] = bf_hi(a1.y); g1[4] = bf_lo(a1.z); g1[5] = bf_hi(a1.z); g1[6] = bf_lo(a1.w); g1[7] = bf_hi(a1.w);
            v2[0] = bf_lo(c2.x); v2[1] = bf_hi(c2.x); v2[2] = bf_lo(c2.y); v2[3] = bf_hi(c2.y); v2[4] = bf_lo(c2.z); v2[5] = bf_hi(c2.z); v2[6] = bf_lo(c2.w); v2[7] = bf_hi(c2.w);
            v1[0] = bf_lo(c1.x); v1[1] = bf_hi(c1.x); v1[2] = bf_lo(c1.y); v1[3] = bf_hi(c1.y); v1[4] = bf_lo(c1.z); v1[5] = bf_hi(c1.z); v1[6] = bf_lo(c1.w); v1[7] = bf_hi(c1.w);
        }
        u32x4 gin[8], vin[8];
#pragma unroll
        for (int i = 0; i < 8; ++i) { gin[i] = *(const u32x4*)(up + (size_t)i * NUP); vin[i] = *(const u32x4*)(up + (size_t)i * NUP + 128); }
#pragma unroll
        for (int i = 0; i < 8; ++i) {
            float g0[8], v0[8], o[8];
            g0[0] = bf_lo(gin[i].x); g0[1] = bf_hi(gin[i].x); g0[2] = bf_lo(gin[i].y); g0[3] = bf_hi(gin[i].y); g0[4] = bf_lo(gin[i].z); g0[5] = bf_hi(gin[i].z); g0[6] = bf_lo(gin[i].w); g0[7] = bf_hi(gin[i].w);
            v0[0] = bf_lo(vin[i].x); v0[1] = bf_hi(vin[i].x); v0[2] = bf_lo(vin[i].y); v0[3] = bf_hi(vin[i].y); v0[4] = bf_lo(vin[i].z); v0[5] = bf_hi(vin[i].z); v0[6] = bf_lo(vin[i].w); v0[7] = bf_hi(vin[i].w);
#pragma unroll
            for (int e = 0; e < 8; ++e) {
                const float gc = bg[e] + wg[0][e] * g2[e] + wg[1][e] * g1[e] + wg[2][e] * g0[e];
                const float vc = bv[e] + wvv[0][e] * v2[e] + wvv[1][e] * v1[e] + wvv[2][e] * v0[e];
                o[e] = gc * sigmoidf_(gc) * vc;
                g2[e] = g1[e]; g1[e] = g0[e]; v2[e] = v1[e]; v1[e] = v0[e];
            }
            u32x4 ow; ow.x = cvt_pk_bf16(o[0], o[1]); ow.y = cvt_pk_bf16(o[2], o[3]); ow.z = cvt_pk_bf16(o[4], o[5]); ow.w = cvt_pk_bf16(o[6], o[7]);
            *(u32x4*)(ACT + (size_t)(row0 + i) * DFF + ch) = ow;
        }
    }
}

__device__ __forceinline__ void conv_fixup(const Frame& F, int l, int pm) {
    if ((pm & 7) == 0) return;
    ArgsCP ap = F.a; unsigned char* ws = F.ws;
    const float* wconv = (const float*)ap->in[20] + (size_t)l * 3 * NUP; const float* bconv = (const float*)ap->in[21] + (size_t)l * NUP;
    const float* UH = (const float*)(ws + WS_UHEAD) + (size_t)pm * 2 * NUP; const float* UT = (const float*)(ws + WS_UTAIL) + (size_t)(pm - 1) * 2 * NUP;
    bf16_t* ACT = (bf16_t*)(ws + WS_ACT);
    f32x4 t0[3][2], t1[3][2], h0[3][2], h1[3][2], w0[3][2], w1[3][2], w2[3][2], bb[3][2];
#pragma unroll
    for (int j = 0; j < 3; ++j) { const int cq = F.tid + 512 * j; const int c2 = (cq < DFF / 4) ? cq : 0;
        const int ch = c2 * 4, colp = (ch >> 7) * 256 + (ch & 127);
#pragma unroll
        for (int bj = 0; bj < 2; ++bj) { const int cp = colp + bj * 128, cw = ch + bj * DFF;
            t0[j][bj] = *(const f32x4*)(UT + cp); t1[j][bj] = *(const f32x4*)(UT + (size_t)NUP + cp); h0[j][bj] = *(const f32x4*)(UH + cp); h1[j][bj] = *(const f32x4*)(UH + (size_t)NUP + cp);
            w0[j][bj] = *(const f32x4*)(wconv + cw); w1[j][bj] = *(const f32x4*)(wconv + (size_t)NUP + cw); w2[j][bj] = *(const f32x4*)(wconv + (size_t)2 * NUP + cw); bb[j][bj] = *(const f32x4*)(bconv + cw); } }
#pragma unroll
    for (int j = 0; j < 3; ++j) { const int cq = F.tid + 512 * j;
        if (cq < DFF / 4) { const int ch = cq * 4;
#pragma unroll
            for (int rr = 0; rr < 2; ++rr) {
                f32x4 cv[2];
#pragma unroll
                for (int bj = 0; bj < 2; ++bj) cv[bj] = bb[j][bj] + w0[j][bj] * (rr ? t1[j][bj] : t0[j][bj]) + w1[j][bj] * (rr ? h0[j][bj] : t1[j][bj]) + w2[j][bj] * (rr ? h1[j][bj] : h0[j][bj]);
                f32x4 o;
#pragma unroll
                for (int e = 0; e < 4; ++e) { const float g = cv[0][e]; o[e] = g * sigmoidf_(g) * cv[1][e]; }
                u32x2 ow; ow.x = cvt_pk_bf16(o[0], o[1]); ow.y = cvt_pk_bf16(o[2], o[3]);
                *(u32x2*)(ACT + (size_t)(pm * 256 + rr) * DFF + ch) = ow; } } }
}

typedef ArgsCP ArgsP;
__device__ __forceinline__ Frame make_frame() {
    Frame F;
    int tid = threadIdx.x; asm volatile("" : "+v"(tid));
    int bid = blockIdx.x, G = gridDim.x; asm volatile("" : "+s"(bid), "+s"(G));
    ArgsP ap = (ArgsP)__builtin_amdgcn_kernarg_segment_ptr(); asm volatile("" : "+s"(ap));
    extern __shared__ __attribute__((aligned(16))) unsigned char lds_raw[];
    F.lds = (LAS unsigned char*)lds_raw;
    F.tid = tid; F.lane = tid & 63; F.wave = __builtin_amdgcn_readfirstlane(tid >> 6); F.G = G; F.bid = bid;
    F.a = ap; F.ws = ap->ws;
    return F;
}

__global__ void __launch_bounds__(512, 2) fwd_kernel(Args args) {
    extern __shared__ __attribute__((aligned(16))) unsigned char lds_raw[];
    volatile LAS unsigned* MISC = (volatile LAS unsigned*)((LAS unsigned char*)lds_raw + LDS_MISC);
    if (threadIdx.x < 16) MISC[threadIdx.x] = 0u;
    __syncthreads();
    const int lo = args.ph_lo, hi = args.ph_hi;
    XcdBarrier bar; bar.bar = (unsigned*)(args.ws + WS_CTL) + 4096; bar.x = 0; bar.st = MISC;
    if (hi - lo > 1) bar = xcd_barrier_post((unsigned*)(args.ws + WS_CTL) + 4096, MISC);
#ifndef ONLY_PHASE
#define ONLY_PHASE -1
#endif
#define PH_EN(p) (ONLY_PHASE < 0 || ONLY_PHASE == (p))
#ifndef REP_MASK
#define REP_MASK 0
#endif
#define REPEAT(bit) _Pragma("unroll 1") for (int _rep = 0; _rep < (((REP_MASK >> (bit)) & 1) ? 2 : 1); ++_rep)
#define IN(k) (lo <= (k) && (k) < hi)
#ifndef BAR_REP
#define BAR_REP 1
#endif
#define SEAM(k) do { if (IN(k) && IN((k) + 1)) { _Pragma("unroll 1") for (int _br = 0; _br < BAR_REP; ++_br) { XcdBarrier b2 = bar; asm volatile("" : "+s"(b2.bar), "+s"(b2.x)); xcd_barrier(b2); } } } while (0)

    if (PH_EN(100) && IN(0)) { const Frame F = make_frame(); p0a_prologue(F); }
    SEAM(0);
    if (PH_EN(101) && IN(1)) REPEAT(0) { const Frame F = make_frame(); p0b_prologue(F); }
    SEAM(1);

#pragma unroll 1
    for (int l = 0; l < DEPTH; ++l) {
        const int pb = 2 + l * NPH_LAYER;
        if (PH_EN(0) && IN(pb + 0)) REPEAT(1) { const Frame F = make_frame(); unsigned char* ws = F.ws;
            pg8::Gemm g{(const bf16_t*)(ws + WS_H8), (const bf16_t*)(ws + WS_WIN + (size_t)l * NPROJ * DM), DM / 2, DM / 2, DM / 2, 0, 0};
            pg8::StaticOrder S; S.init(MROWS, NPROJ, F.G, F.bid);
            pg8::EpiProjNorm E{(bf16_t*)(ws + WS_PROJ), NPROJ, (const fx64*)(ws + WS_SSQ) + (size_t)(l * 2 + 0) * MROWS, (const fx64*)(ws + WS_BIAS) + (size_t)l * NBATCH * NPROJ, NPROJ, (LAS float*)(F.lds + LDS_TAB), (fx64*)(ws + WS_SSQ_LAT) + (size_t)l * 2 * MROWS};
            pg8::gemm_phase(F.lds, F.tid, g, S, E);
        }
        if (PH_EN(0) && IN(pb + 0) && l + 1 < DEPTH) { const Frame F = make_frame(); tr_late(F, l + 1, (MROWS / 256) * (NPROJ / 256), late_up_tiles(F.G), late_in_tiles(F.G), LATE_IN); }
        SEAM(pb + 0);
        if (PH_EN(1) && IN(pb + 1)) {
#pragma unroll 1
            for (int s1 = 0; s1 < 2; ++s1) {
                const Frame F0 = make_frame();
                if ((((F0.bid >> 3) ^ s1) & 1) == 0) {
                    { const Frame F = make_frame(); unsigned char* ws = F.ws; const fx64* sl = (const fx64*)(ws + WS_SSQ_LAT) + (size_t)l * 2 * MROWS;
                      pg8::Gemm g{(const bf16_t*)(ws + WS_PROJ) + PC_MQL, (const bf16_t*)(ws + WS_WMQ) + (size_t)l * 1536 * 512, NPROJ, 512, 512, 0, 0};
                      pg8::StaticOrder S; S.init(MROWS, 1536, F.G, F.bid); pg8::EpiStoreBf16 E{(bf16_t*)(ws + WS_MQ), 1536, sl, 1.0f / 512.0f}; pg8::gemm_phase(F.lds, F.tid, g, S, E); }
                    { const Frame F = make_frame(); unsigned char* ws = F.ws; const fx64* sl = (const fx64*)(ws + WS_SSQ_LAT) + (size_t)l * 2 * MROWS + MROWS;
                      pg8::Gemm g{(const bf16_t*)(ws + WS_PROJ) + PC_MKVL, (const bf16_t*)(ws + WS_WMKV) + (size_t)l * 2048 * 256, NPROJ, 256, 256, 0, 0};
                      pg8::StaticOrder S; S.init(MROWS, 2048, F.G, F.bid); pg8::EpiStoreBf16 E{(bf16_t*)(ws + WS_MKV), 2048, sl, 1.0f / 256.0f}; pg8::gemm_phase(F.lds, F.tid, g, S, E); }
                } else { const Frame F = make_frame(); phase_post1(F, l); }
            }
        }
        SEAM(pb + 1);
        if (PH_EN(2) && IN(pb + 2)) {
#pragma unroll 1
            for (int s2 = 0; s2 < 2; ++s2) { const Frame F = make_frame();
                if ((((F.bid >> 3) ^ s2) & 1) == 0) phase_post2(F, l); else phase_idx(F); }
        }
        SEAM(pb + 2);
        if (PH_EN(3) && IN(pb + 3)) REPEAT(2) { const Frame F = make_frame(); phase_attn(F); }
        SEAM(pb + 3);
        if (PH_EN(4) && IN(pb + 4)) { const Frame F = make_frame(); unsigned char* ws = F.ws;
            pg8::Gemm g{(const bf16_t*)(ws + WS_OAB), (const bf16_t*)(ws + WS_WPAB) + (size_t)l * 4096 * 1024, DM, 1024, 1024, (size_t)1024 * 2, (size_t)2048 * 1024 * 2};
            pg8::PairOrder S; S.s.init(MROWS, DM, F.G, F.bid);
            pg8::EpiPab E{(const bf16_t*)(ws + WS_PROJ), (bf16_t*)(ws + WS_MERGED)};
            pg8::gemm_phase(F.lds, F.tid, g, S, E);
        }
        SEAM(pb + 4);
        if (PH_EN(5) && IN(pb + 5)) { const Frame F = make_frame(); unsigned char* ws = F.ws;
            const float* xin = (l == 0) ? (const float*)F.a->in[0] : (const float*)F.a->out;
            const float* modl = (const float*)(ws + WS_MOD) + (size_t)l * NBATCH * NADA;
            pg8::Gemm g{(const bf16_t*)(ws + WS_MERGED), (const bf16_t*)(ws + WS_WO) + (size_t)l * DM * DM, DM, DM, DM, 0, 0};
            pg8::StaticOrder S; S.init(MROWS, DM, F.G, F.bid);
            pg8::EpiResidNorm E{xin, F.a->out, modl + 2 * DM, (const float*)F.a->in[4] + l * DM, modl + 4 * DM, (bf16_t*)(ws + WS_H), (fx64*)(ws + WS_SSQ) + (size_t)(l * 2 + 1) * MROWS, 0};
            pg8::gemm_phase(F.lds, F.tid, g, S, E);
        }
        SEAM(pb + 5);
        if (PH_EN(6) && IN(pb + 6)) { const Frame F = make_frame(); unsigned char* ws = F.ws;
            pg8::Gemm g{(const bf16_t*)(ws + WS_H), (const bf16_t*)(ws + WS_WUP) + (size_t)l * NUP * DM, DM, DM, DM, 0, 0};
            pg8::StaticOrder S; S.init(MROWS, NUP, F.G, F.bid);
            pg8::EpiUpConv E{(const float*)F.a->in[20] + (size_t)l * 3 * NUP, (const float*)F.a->in[21] + (size_t)l * NUP, (bf16_t*)(ws + WS_ACT), (float*)(ws + WS_UHEAD), (float*)(ws + WS_UTAIL), (LAS float*)(F.lds + LDS_XB),
                               (const fx64*)(ws + WS_SSQ) + (size_t)(l * 2 + 1) * MROWS, (const fx64*)(ws + WS_BIAS_UP) + (size_t)l * NBATCH * NUP, (LAS float*)(F.lds + LDS_TAB), (LAS float*)(F.lds + LDS_CTAB), (LAS float*)(F.lds + LDS_TAB2), (LAS float*)(F.lds + LDS_CTAB2)};
            pg8::gemm_phase(F.lds, F.tid, g, S, E);
            if (l + 1 < DEPTH) tr_late(F, l + 1, (MROWS / 256) * (NUP / 256), 0, late_up_tiles(F.G), LATE_UP);
        }
        SEAM(pb + 6);
        if (PH_EN(7) && IN(pb + 7)) { const Frame F = make_frame(); unsigned char* ws = F.ws;
            pg8::StaticOrder S; S.init(MROWS, DM, F.G, F.bid);
            { pg8::Unit uu; for (int i = 0; S.next(i, uu); ++i) conv_fixup(F, l, uu.pm); }
            asm volatile("s_waitcnt vmcnt(0)" ::: "memory"); __syncthreads();
            const float* modl = (const float*)(ws + WS_MOD) + (size_t)l * NBATCH * NADA;
            const bool more = (l + 1 < DEPTH);
            pg8::Gemm g{(const bf16_t*)(ws + WS_ACT), (const bf16_t*)(ws + WS_WDN) + (size_t)l * DM * DFF, DFF, DFF, DFF, 0, 0};
            pg8::EpiResidNorm E{F.a->out, F.a->out, modl + 5 * DM, (const float*)F.a->in[3] + (l + 1) * DM, modl + NBATCH * NADA + DM, more ? (bf16_t*)(ws + WS_H8) : (bf16_t*)nullptr, (fx64*)(ws + WS_SSQ) + (size_t)((l + 1) * 2 + 0) * MROWS, 1};
            pg8::gemm_phase(F.lds, F.tid, g, S, E);
        }
        SEAM(pb + 7);
    }
#if ATT_PROBE
    { XcdBarrier b2 = bar; xcd_barrier(b2);
      if (blockIdx.x == ATT_PROBE_BID && threadIdx.x == ATT_PROBE_TID) { volatile LAS unsigned* MS = (volatile LAS unsigned*)((LAS unsigned char*)lds_raw + LDS_MISC); args.out[0] = (ATT_PROBE == 4) ? 1000.0f * (float)((int)((float)MS[5] / (4.0f * 36.0f * 100.0f) + ATT_PROBE_OFS) / 5 * 5) : (ATT_PROBE == 5) ? 1000.0f * (float)((int)((float)MS[4] / (float)MS[6] / 10.0f + ATT_PROBE_OFS) / 5 * 5) : 1000.0f * (float)(((int)(100.0f * (float)MS[4] / (float)MS[5]) + ATT_PROBE_OFS) / 10 * 10); } }
#endif
#undef IN
#undef SEAM
}

extern "C" void kernel_launch(void* const* d_in, const int* in_sizes, int n_in, void* d_out, int out_size, void* d_ws, size_t ws_size, hipStream_t stream) {
    static int grid = 0;
    if (grid == 0) {
        if (n_in != 23 || out_size != MROWS * DM || ws_size < WS_END) { fprintf(stderr, "kernel_launch: unexpected problem (n_in %d, out %d, ws %zu < %zu)\n", n_in, out_size, ws_size, (size_t)WS_END); grid = -1; return; }
        int dev = 0, cus = 0, per_cu = 0;
        if (hipGetDevice(&dev) != hipSuccess || hipDeviceGetAttribute(&cus, hipDeviceAttributeMultiprocessorCount, dev) != hipSuccess) { grid = -1; return; }
        if (hipFuncSetAttribute((const void*)fwd_kernel, hipFuncAttributeMaxDynamicSharedMemorySize, LDS_BYTES) != hipSuccess) { fprintf(stderr, "kernel_launch: hipFuncSetAttribute failed\n"); grid = -1; return; }
        if (hipOccupancyMaxActiveBlocksPerMultiprocessor(&per_cu, (const void*)fwd_kernel, 512, LDS_BYTES) != hipSuccess || per_cu < 1) { fprintf(stderr, "kernel_launch: occupancy query says %d\n", per_cu); }
        (void)hipGetLastError();
        grid = cus;
    }
    if (grid < 0) return;
    (void)in_sizes;
    (void)hipMemsetAsync((char*)d_ws + WS_CTL, 0, CTL_ZERO_BYTES, stream);
    (void)hipMemsetAsync((char*)d_ws + WS_BIAS, 0, BIAS_ZERO_BYTES, stream);
    Args a{};
    for (int i = 0; i < 23; ++i) a.in[i] = d_in[i];
    a.out = (float*)d_out; a.ws = (unsigned char*)d_ws;
    for (int i = 0; i < 16; ++i) a.inv_a[i] = (float)pow(500000.0, -(double)(2 * i) / 32.0);
    for (int i = 0; i < 8; ++i) a.inv_i[i] = (float)pow(500000.0, -(double)(2 * i) / 16.0);
    for (int i = 0; i < 32; ++i) a.inv_m[i] = (float)pow(500000.0, -(double)(2 * i) / 64.0);
#if MK_ONE_LAUNCH
    a.ph_lo = 0; a.ph_hi = NPHASES;
    hipLaunchKernelGGL(fwd_kernel, dim3(grid), dim3(512), LDS_BYTES, stream, a);
#else
    for (int p = 0; p < NPHASES; ++p) { a.ph_lo = p; a.ph_hi = p + 1; hipLaunchKernelGGL(fwd_kernel, dim3(grid), dim3(512), LDS_BYTES, stream, a); }
#endif
}
```
